# Optimizing an MI355X kernel written in HIP

```python
import math
import jax
import jax.numpy as jnp
from jax import lax
import numpy as np

D_MODEL = 1024
BATCH = 4
SEQ = 4096
DEPTH = 2
DEC_BATCH = 32
DEC_SEQ = 1
PAST_LEN = 8192
PAGE_SIZE = 128

N_BRANCH = 4
BRANCH_WIDTH = D_MODEL // N_BRANCH
S5_WIDTH = BRANCH_WIDTH
S5_GROUP = 16
S5_GROUPS = S5_WIDTH // S5_GROUP
S5_P = 64
GLA_HEADS = 4
GLA_DK = BRANCH_WIDTH // GLA_HEADS
GLA_DV = BRANCH_WIDTH // GLA_HEADS
GLA_RANK = 16
GLA_TAU = 16.0
GLA_CHUNK = 64
GDN_HEADS = 4
GDN_DK = BRANCH_WIDTH // GDN_HEADS
GDN_DV = BRANCH_WIDTH // GDN_HEADS
GDN_CONV = 4
GDN_CHUNK = 64
GDN_QKV = GDN_HEADS * (2 * GDN_DK + GDN_DV)
MOBA_HEADS = 4
MOBA_HD = BRANCH_WIDTH // MOBA_HEADS
MOBA_BLOCK = 256
MOBA_TOPK = 3
MOBA_QCHUNK = 32
ROT_DIM = MOBA_HD // 4
ROPE_THETA = 500000.0
D_FF = 4 * D_MODEL
EPS = 1e-6
NEG = -1e30

IN_SPLITS = (
    S5_WIDTH,
    GLA_HEADS * GLA_DK, GLA_HEADS * GLA_DK, GLA_HEADS * GLA_DV,
    GLA_RANK, GLA_HEADS * GLA_DV,
    GDN_HEADS * GDN_DK, GDN_HEADS * GDN_DK, GDN_HEADS * GDN_DV,
    GDN_HEADS, GDN_HEADS, GDN_HEADS * GDN_DV,
    MOBA_HEADS * MOBA_HD, MOBA_HEADS * MOBA_HD, MOBA_HEADS * MOBA_HD,
)
D_IN = sum(IN_SPLITS)

kernel_name = 'hybrid_s5_gla_gdn_moba_step'


def _rms(x, g):
    xf = x.astype(jnp.float32)
    y = xf * lax.rsqrt(jnp.mean(xf * xf, axis=-1, keepdims=True) + EPS)
    return (y * g.astype(jnp.float32)).astype(x.dtype)


def _l2n(x):
    return x * lax.rsqrt(jnp.sum(x * x, axis=-1, keepdims=True) + EPS)


def _rope(x, pos):
    f32 = jnp.float32
    half = ROT_DIM // 2
    inv = ROPE_THETA ** (-jnp.arange(half, dtype=f32) / half)
    ang = pos.astype(f32)[:, None] * inv[None, :]
    cos = jnp.cos(ang)[None, :, None, :]
    sin = jnp.sin(ang)[None, :, None, :]
    xr = x[..., :ROT_DIM].astype(f32)
    x1, x2 = xr[..., :half], xr[..., half:]
    rot = jnp.concatenate([x1 * cos - x2 * sin, x2 * cos + x1 * sin], axis=-1).astype(x.dtype)
    return jnp.concatenate([rot, x[..., ROT_DIM:]], axis=-1)


def _to_chunks(x, c):
    b, L = x.shape[:2]
    n = -(-L // c)
    x = jnp.pad(x, [(0, 0), (0, n * c - L)] + [(0, 0)] * (x.ndim - 2))
    x = x.reshape((b, n, c) + x.shape[2:])
    return x.transpose((1, 0, 3, 2) + tuple(range(4, x.ndim)))


def _from_chunks(o, L):
    n, b, h, c, d = o.shape
    return o.transpose(1, 0, 3, 2, 4).reshape(b, n * c, h, d)[:, :L]


def _s5(u, h0_re, h0_im, p):
    f32 = jnp.float32
    b, L, _ = u.shape
    uf = u.astype(f32)
    ug = uf.reshape(b, L, S5_GROUPS, S5_GROUP)
    dt = jnp.exp(p['s5_log_dt'].astype(f32))[:, None]
    ar = p['s5_a_re'].astype(f32)
    ai = p['s5_a_im'].astype(f32)
    mag = jnp.exp(ar * dt)
    abar_re = mag * jnp.cos(ai * dt)
    abar_im = mag * jnp.sin(ai * dt)
    den = ar * ar + ai * ai
    nr = abar_re - 1.0
    f_re = (nr * ar + abar_im * ai) / den
    f_im = (abar_im * ar - nr * ai) / den
    br = p['s5_b_re'].astype(f32)
    bi = p['s5_b_im'].astype(f32)
    bbar_re = f_re[..., None] * br - f_im[..., None] * bi
    bbar_im = f_re[..., None] * bi + f_im[..., None] * br
    x_re = jnp.einsum('blgc,gpc->blgp', ug, bbar_re)
    x_im = jnp.einsum('blgc,gpc->blgp', ug, bbar_im)
    h0r = h0_re.astype(f32)
    h0i = h0_im.astype(f32)
    x_re = x_re.at[:, 0].add(abar_re * h0r - abar_im * h0i)
    x_im = x_im.at[:, 0].add(abar_re * h0i + abar_im * h0r)
    a_re = jnp.broadcast_to(abar_re, x_re.shape)
    a_im = jnp.broadcast_to(abar_im, x_im.shape)

    def combine(e1, e2):
        a1r, a1i, b1r, b1i = e1
        a2r, a2i, b2r, b2i = e2
        return (a2r * a1r - a2i * a1i, a2r * a1i + a2i * a1r,
                a2r * b1r - a2i * b1i + b2r, a2r * b1i + a2i * b1r + b2i)

    _, _, hr, hi = lax.associative_scan(combine, (a_re, a_im, x_re, x_im), axis=1)
    y = (jnp.einsum('blgp,gcp->blgc', hr, p['s5_c_re'].astype(f32))
         - jnp.einsum('blgp,gcp->blgc', hi, p['s5_c_im'].astype(f32)))
    y = y.reshape(b, L, S5_WIDTH) + p['s5_d'].astype(f32) * uf
    y = jax.nn.gelu(y)
    y = y * jax.nn.sigmoid(y @ p['s5_w_glu'].astype(f32) + p['s5_b_glu'].astype(f32))
    return y.astype(u.dtype), hr[:, -1], hi[:, -1]


def _gla_chunked(q, k, v, log_a, s0):
    L = q.shape[1]
    c = min(GLA_CHUNK, L)
    qc, kc, vc, gc = (_to_chunks(t, c) for t in (q, k, v, log_a))
    tri = jnp.tril(jnp.ones((c, c), dtype=bool))

    def step(S, inp):
        qi, ki, vi, gi = inp
        bcum = jnp.cumsum(gi, axis=2)
        diff = bcum[:, :, :, None, :] - bcum[:, :, None, :, :]
        decay = jnp.exp(jnp.where(tri[:, :, None], diff, -jnp.inf))
        att = jnp.einsum('bhid,bhjd,bhijd->bhij', qi, ki, decay)
        o = (jnp.einsum('bhij,bhjv->bhiv', att, vi)
             + jnp.einsum('bhid,bhdv->bhiv', qi * jnp.exp(bcum), S))
        blast = bcum[:, :, -1:]
        S = (jnp.exp(blast[:, :, 0])[..., None] * S
             + jnp.einsum('bhjd,bhjv->bhdv', ki * jnp.exp(blast - bcum), vi))
        return S, o

    S, o = lax.scan(step, s0, (qc, kc, vc, gc))
    return _from_chunks(o, L), S


def _gdn_chunked(q, k, v, beta, g, s0):
    L = q.shape[1]
    c = min(GDN_CHUNK, L)
    qc, kc, vc = (_to_chunks(t, c) for t in (q, k, v))
    bc = _to_chunks(beta, c)
    gc = _to_chunks(g, c)
    incl = jnp.tril(jnp.ones((c, c), dtype=bool))
    strict = jnp.tril(jnp.ones((c, c), dtype=bool), -1)
    eye = jnp.eye(c, dtype=jnp.float32)

    def step(S, inp):
        qi, ki, vi, bi, gi = inp
        gcum = jnp.cumsum(gi, axis=-1)
        dec = jnp.exp(jnp.where(incl, gcum[..., :, None] - gcum[..., None, :], -jnp.inf))
        gam = jnp.exp(gcum)[..., None]
        kk = jnp.einsum('bhid,bhjd->bhij', ki, ki)
        m = jnp.where(strict, dec * kk * bi[..., None, :], 0.0) + eye
        rhs = vi - gam * jnp.einsum('bhid,bhdv->bhiv', ki, S)
        u = lax.linalg.triangular_solve(m, rhs, left_side=True, lower=True, unit_diagonal=True)
        qk = jnp.einsum('bhid,bhjd->bhij', qi, ki)
        o = (gam * jnp.einsum('bhid,bhdv->bhiv', qi, S)
             + jnp.einsum('bhij,bhjv->bhiv', dec * qk * bi[..., None, :], u))
        glast = gcum[..., -1:]
        w = jnp.exp(glast - gcum) * bi
        S = jnp.exp(glast)[..., None] * S + jnp.einsum('bhjd,bhjv->bhdv', ki * w[..., None], u)
        return S, o

    S, o = lax.scan(step, s0, (qc, kc, vc, bc, gc))
    return _from_chunks(o, L), S


def _moba(q, k_all, v_all, pos0):
    f32 = jnp.float32
    b, Lq, H, hd = q.shape
    T = k_all.shape[1]
    nb = -(-T // MOBA_BLOCK)
    padk = [(0, 0), (0, nb * MOBA_BLOCK - T), (0, 0), (0, 0)]
    kb = jnp.pad(k_all, padk).reshape(b, nb, MOBA_BLOCK, H, hd).transpose(0, 3, 1, 2, 4)
    vb = jnp.pad(v_all, padk).reshape(b, nb, MOBA_BLOCK, H, hd).transpose(0, 3, 1, 2, 4)
    kmean = jnp.mean(kb.astype(f32), axis=3)
    topk = min(MOBA_TOPK, nb)
    qc = min(MOBA_QCHUNK, Lq)
    nq = -(-Lq // qc)
    qt = jnp.pad(q, [(0, 0), (0, nq * qc - Lq), (0, 0), (0, 0)])
    qt = qt.reshape(b, nq, qc, H, hd).transpose(1, 0, 3, 2, 4)
    qpos = (pos0 + jnp.arange(nq * qc, dtype=jnp.int32)).reshape(nq, qc)
    bidx = jnp.arange(b)[:, None, None, None]
    hidx = jnp.arange(H)[None, :, None, None]
    boffs = jnp.arange(MOBA_BLOCK, dtype=jnp.int32)
    blk_ids = jnp.arange(nb, dtype=jnp.int32)
    scale = hd ** -0.5

    def attend(args):
        qi, pi = args
        qf = qi.astype(f32)
        own = pi // MOBA_BLOCK
        gate = jnp.einsum('bhqd,bhnd->bhqn', qf, kmean)
        gate = jnp.where(blk_ids[None, :] < own[:, None], gate, NEG)
        _, sel = lax.top_k(gate, topk)
        sel_ok = sel < own[:, None]
        own_b = jnp.broadcast_to(own[:, None], (b, H, qc, 1))
        blocks = jnp.concatenate([sel, own_b], axis=-1)
        kg = kb[bidx, hidx, blocks].astype(f32)
        vg = vb[bidx, hidx, blocks].astype(f32)
        kpos = blocks[..., None] * MOBA_BLOCK + boffs
        ok = (jnp.concatenate([sel_ok, jnp.ones_like(sel_ok[..., :1])], axis=-1)[..., None]
              & (kpos <= pi[:, None, None]))
        logits = jnp.einsum('bhqd,bhqnkd->bhqnk', qf, kg) * scale
        logits = jnp.where(ok, logits, -jnp.inf).reshape(b, H, qc, -1)
        w = jax.nn.softmax(logits, axis=-1).reshape(ok.shape)
        return jnp.einsum('bhqnk,bhqnkd->bhqd', w, vg)

    o = lax.map(attend, (qt, qpos))
    return o.transpose(1, 0, 3, 2, 4).reshape(b, nq * qc, H, hd)[:, :Lq].astype(q.dtype)


def _layer(x, pos0, past_k, past_v, s5_re0, s5_im0, gla0, gdn0, conv0, p):
    f32 = jnp.float32
    b, L, _ = x.shape
    pos = pos0 + jnp.arange(L, dtype=jnp.int32)
    h = _rms(x, p['ln1_g'])
    proj = h @ p['w_in']
    (s5_u, a_q, a_k, a_v, a_lr, a_r, d_q, d_k, d_v, d_b, d_a, d_z,
     m_q, m_k, m_v) = jnp.split(proj, np.cumsum(IN_SPLITS)[:-1].tolist(), axis=-1)

    y_a, s5_re, s5_im = _s5(s5_u, s5_re0, s5_im0, p)

    q = a_q.astype(f32).reshape(b, L, GLA_HEADS, GLA_DK) * GLA_DK ** -0.5
    k = a_k.astype(f32).reshape(b, L, GLA_HEADS, GLA_DK)
    v = a_v.astype(f32).reshape(b, L, GLA_HEADS, GLA_DV)
    log_a = jax.nn.log_sigmoid((a_lr @ p['gla_w_gate'] + p['gla_b_gate']).astype(f32)) / GLA_TAU
    o, gla_s = _gla_chunked(q, k, v, log_a.reshape(b, L, GLA_HEADS, GLA_DK), gla0.astype(f32))
    gate_r = jax.nn.silu(a_r.astype(f32)).reshape(b, L, GLA_HEADS, GLA_DV)
    y_b = (_rms(o, p['gla_norm']) * gate_r).reshape(b, L, GLA_HEADS * GLA_DV).astype(x.dtype)

    qkv_in = jnp.concatenate([d_q, d_k, d_v], axis=-1)
    qkv_pad = jnp.concatenate([conv0.astype(qkv_in.dtype), qkv_in], axis=1)
    qkv = lax.conv_general_dilated(qkv_pad, p['gdn_conv_w'][:, None, :].astype(qkv_pad.dtype),
                                   (1,), 'VALID', dimension_numbers=('NWC', 'WIO', 'NWC'),
                                   feature_group_count=GDN_QKV)
    qkv = jax.nn.silu(qkv.astype(f32))
    gq, gk, gv = jnp.split(qkv, [GDN_HEADS * GDN_DK, 2 * GDN_HEADS * GDN_DK], axis=-1)
    gq = _l2n(gq.reshape(b, L, GDN_HEADS, GDN_DK)) * GDN_DK ** -0.5
    gk = _l2n(gk.reshape(b, L, GDN_HEADS, GDN_DK))
    gv = gv.reshape(b, L, GDN_HEADS, GDN_DV)
    beta = jax.nn.sigmoid(d_b.astype(f32))
    g = -jnp.exp(p['gdn_a_log'].astype(f32)) * jax.nn.softplus(d_a.astype(f32) + p['gdn_dt_bias'].astype(f32))
    o, gdn_s = _gdn_chunked(gq, gk, gv, beta, g, gdn0.astype(f32))
    gate_z = jax.nn.silu(d_z.astype(f32)).reshape(b, L, GDN_HEADS, GDN_DV)
    y_c = (_rms(o, p['gdn_norm']) * gate_z).reshape(b, L, GDN_HEADS * GDN_DV).astype(x.dtype)
    new_conv = qkv_pad[:, -(GDN_CONV - 1):]

    mq = _rope(_rms(m_q.reshape(b, L, MOBA_HEADS, MOBA_HD), p['moba_q_norm']), pos)
    mk = _rope(_rms(m_k.reshape(b, L, MOBA_HEADS, MOBA_HD), p['moba_k_norm']), pos)
    mv = m_v.reshape(b, L, MOBA_HEADS, MOBA_HD)
    if past_k is None:
        k_all, v_all = mk, mv
    else:
        k_all = jnp.concatenate([past_k.astype(mk.dtype), mk], axis=1)
        v_all = jnp.concatenate([past_v.astype(mv.dtype), mv], axis=1)
    y_d = _moba(mq, k_all, v_all, pos0).reshape(b, L, MOBA_HEADS * MOBA_HD)

    gates = jax.nn.sigmoid((h @ p['w_gate']).astype(f32)).reshape(b, L, N_BRANCH, D_MODEL)
    merged = (gates[:, :, 0] * (y_a @ p['w_br_s5']) + gates[:, :, 1] * (y_b @ p['w_br_gla'])
              + gates[:, :, 2] * (y_c @ p['w_br_gdn']) + gates[:, :, 3] * (y_d @ p['w_br_moba']))
    x = x + merged.astype(x.dtype) @ p['w_out']

    z = _rms(x, p['ln2_g']) @ p['w_ff1']
    x = x + jnp.square(jax.nn.relu(z)) @ p['w_ff2']
    dt = x.dtype
    return x, (mk, mv, s5_re.astype(dt), s5_im.astype(dt), gla_s.astype(dt),
               gdn_s.astype(dt), new_conv.astype(dt))


def _stack_states(states):
    return [jnp.stack([s[i] for s in states]) for i in range(len(states[0]))]


def setup_inputs(seed: int = 0) -> dict:
    key = jax.random.key(seed)
    ks = iter(jax.random.split(key, 64))
    f32 = jnp.float32

    def nrm(shape, scale):
        return jax.random.normal(next(ks), shape, f32) * scale

    def gain(shape):
        return 1.0 + nrm(shape, 0.01)

    n_pages = PAST_LEN // PAGE_SIZE
    n_used = DEC_BATCH * n_pages
    n_pool = n_used + n_used // 4
    page_table = jax.random.permutation(next(ks), n_pool)[:n_used].reshape(DEC_BATCH, n_pages).astype(jnp.int32)
    gdn_dt = jnp.exp(jax.random.uniform(next(ks), (DEPTH, GDN_HEADS), f32, math.log(1e-3), math.log(1e-1)))
    return {
        'x_prompt': nrm((BATCH, SEQ, D_MODEL), 1.0),
        'x_sample': nrm((DEC_BATCH, DEC_SEQ, D_MODEL), 1.0),
        'cache_moba_k': nrm((DEPTH, n_pool, PAGE_SIZE, MOBA_HEADS, MOBA_HD), 1.0),
        'cache_moba_v': nrm((DEPTH, n_pool, PAGE_SIZE, MOBA_HEADS, MOBA_HD), 1.0),
        'page_table': page_table,
        'state_s5_re': nrm((DEPTH, DEC_BATCH, S5_GROUPS, S5_P), 0.1),
        'state_s5_im': nrm((DEPTH, DEC_BATCH, S5_GROUPS, S5_P), 0.1),
        'state_gla': nrm((DEPTH, DEC_BATCH, GLA_HEADS, GLA_DK, GLA_DV), 0.3),
        'state_gdn': nrm((DEPTH, DEC_BATCH, GDN_HEADS, GDN_DK, GDN_DV), 0.3),
        'state_gdn_conv': nrm((DEPTH, DEC_BATCH, GDN_CONV - 1, GDN_QKV), 1.0),
        'ln1_g': gain((DEPTH, D_MODEL)),
        'w_in': nrm((DEPTH, D_MODEL, D_IN), D_MODEL ** -0.5),
        's5_a_re': -0.5 + nrm((DEPTH, S5_GROUPS, S5_P), 0.01),
        's5_a_im': jnp.pi * jnp.arange(S5_P, dtype=f32) + nrm((DEPTH, S5_GROUPS, S5_P), 0.01),
        's5_log_dt': jax.random.uniform(next(ks), (DEPTH, S5_GROUPS), f32, math.log(1e-3), math.log(1e-1)),
        's5_b_re': nrm((DEPTH, S5_GROUPS, S5_P, S5_GROUP), S5_GROUP ** -0.5),
        's5_b_im': nrm((DEPTH, S5_GROUPS, S5_P, S5_GROUP), S5_GROUP ** -0.5),
        's5_c_re': nrm((DEPTH, S5_GROUPS, S5_GROUP, S5_P), S5_P ** -0.5),
        's5_c_im': nrm((DEPTH, S5_GROUPS, S5_GROUP, S5_P), S5_P ** -0.5),
        's5_d': nrm((DEPTH, S5_WIDTH), 1.0),
        's5_w_glu': nrm((DEPTH, S5_WIDTH, S5_WIDTH), S5_WIDTH ** -0.5),
        's5_b_glu': nrm((DEPTH, S5_WIDTH), 0.02),
        'gla_w_gate': nrm((DEPTH, GLA_RANK, GLA_HEADS * GLA_DK), GLA_RANK ** -0.5),
        'gla_b_gate': nrm((DEPTH, GLA_HEADS * GLA_DK), 0.1),
        'gla_norm': gain((DEPTH, GLA_DV)),
        'gdn_conv_w': nrm((DEPTH, GDN_CONV, GDN_QKV), GDN_CONV ** -0.5),
        'gdn_a_log': jnp.log(jax.random.uniform(next(ks), (DEPTH, GDN_HEADS), f32, 1.0, 16.0)),
        'gdn_dt_bias': gdn_dt + jnp.log(-jnp.expm1(-gdn_dt)),
        'gdn_norm': gain((DEPTH, GDN_DV)),
        'moba_q_norm': gain((DEPTH, MOBA_HD)),
        'moba_k_norm': gain((DEPTH, MOBA_HD)),
        'w_gate': nrm((DEPTH, D_MODEL, N_BRANCH * D_MODEL), D_MODEL ** -0.5),
        'w_br_s5': nrm((DEPTH, S5_WIDTH, D_MODEL), S5_WIDTH ** -0.5),
        'w_br_gla': nrm((DEPTH, GLA_HEADS * GLA_DV, D_MODEL), (GLA_HEADS * GLA_DV) ** -0.5),
        'w_br_gdn': nrm((DEPTH, GDN_HEADS * GDN_DV, D_MODEL), (GDN_HEADS * GDN_DV) ** -0.5),
        'w_br_moba': nrm((DEPTH, MOBA_HEADS * MOBA_HD, D_MODEL), (MOBA_HEADS * MOBA_HD) ** -0.5),
        'w_out': nrm((DEPTH, D_MODEL, D_MODEL), D_MODEL ** -0.5),
        'ln2_g': gain((DEPTH, D_MODEL)),
        'w_ff1': nrm((DEPTH, D_MODEL, D_FF), D_MODEL ** -0.5),
        'w_ff2': nrm((DEPTH, D_FF, D_MODEL), D_FF ** -0.5),
    }


def reference(x_prompt, x_sample, cache_moba_k, cache_moba_v, page_table,
              state_s5_re, state_s5_im, state_gla, state_gdn, state_gdn_conv,
              ln1_g, w_in, s5_a_re, s5_a_im, s5_log_dt, s5_b_re, s5_b_im, s5_c_re, s5_c_im,
              s5_d, s5_w_glu, s5_b_glu, gla_w_gate, gla_b_gate, gla_norm,
              gdn_conv_w, gdn_a_log, gdn_dt_bias, gdn_norm, moba_q_norm, moba_k_norm,
              w_gate, w_br_s5, w_br_gla, w_br_gdn, w_br_moba, w_out, ln2_g, w_ff1, w_ff2):
    layers = [dict(ln1_g=ln1_g[l], w_in=w_in[l], s5_a_re=s5_a_re[l], s5_a_im=s5_a_im[l],
                   s5_log_dt=s5_log_dt[l], s5_b_re=s5_b_re[l], s5_b_im=s5_b_im[l],
                   s5_c_re=s5_c_re[l], s5_c_im=s5_c_im[l], s5_d=s5_d[l], s5_w_glu=s5_w_glu[l],
                   s5_b_glu=s5_b_glu[l], gla_w_gate=gla_w_gate[l], gla_b_gate=gla_b_gate[l],
                   gla_norm=gla_norm[l], gdn_conv_w=gdn_conv_w[l], gdn_a_log=gdn_a_log[l],
                   gdn_dt_bias=gdn_dt_bias[l], gdn_norm=gdn_norm[l], moba_q_norm=moba_q_norm[l],
                   moba_k_norm=moba_k_norm[l], w_gate=w_gate[l], w_br_s5=w_br_s5[l],
                   w_br_gla=w_br_gla[l], w_br_gdn=w_br_gdn[l], w_br_moba=w_br_moba[l],
                   w_out=w_out[l], ln2_g=ln2_g[l], w_ff1=w_ff1[l], w_ff2=w_ff2[l])
              for l in range(DEPTH)]
    bp = x_prompt.shape[0]
    bs = x_sample.shape[0]
    n_pages = page_table.shape[1]
    past_len = n_pages * PAGE_SIZE
    dt = x_prompt.dtype

    xp = x_prompt
    p_states = []
    for l in range(DEPTH):
        xp, st = _layer(xp, 0, None, None,
                        jnp.zeros((bp, S5_GROUPS, S5_P), dt), jnp.zeros((bp, S5_GROUPS, S5_P), dt),
                        jnp.zeros((bp, GLA_HEADS, GLA_DK, GLA_DV), dt),
                        jnp.zeros((bp, GDN_HEADS, GDN_DK, GDN_DV), dt),
                        jnp.zeros((bp, GDN_CONV - 1, GDN_QKV), dt), layers[l])
        p_states.append(st)

    xs = x_sample
    s_states = []
    for l in range(DEPTH):
        past_k = cache_moba_k[l][page_table].reshape(bs, past_len, MOBA_HEADS, MOBA_HD)
        past_v = cache_moba_v[l][page_table].reshape(bs, past_len, MOBA_HEADS, MOBA_HD)
        xs, st = _layer(xs, past_len, past_k, past_v, state_s5_re[l], state_s5_im[l],
                        state_gla[l], state_gdn[l], state_gdn_conv[l], layers[l])
        s_states.append(st)

    p_moba_k, p_moba_v, p_s5_re, p_s5_im, p_gla, p_gdn, p_gdn_conv = _stack_states(p_states)
    s_moba_k, s_moba_v, s_s5_re, s_s5_im, s_gla, s_gdn, s_gdn_conv = _stack_states(s_states)
    y_prompt = xp
    y_sample = xs
    return (y_prompt, y_sample, p_moba_k, p_moba_v, p_s5_re, p_s5_im, p_gla, p_gdn, p_gdn_conv,
            s_moba_k, s_moba_v, s_s5_re, s_s5_im, s_gla, s_gdn, s_gdn_conv)
```

```cpp
#include <hip/hip_runtime.h>
#include <cstdio>
#include <cstdint>
namespace pg8 {
#define PG8_LAS __attribute__((address_space(3)))
typedef unsigned short bf16_t;
typedef short bf16x8 __attribute__((ext_vector_type(8)));
typedef float f32x4 __attribute__((ext_vector_type(4)));
typedef unsigned u32x4 __attribute__((ext_vector_type(4)));
constexpr int BM = 256, BK = 64, HALF = 128, HTB = HALF * BK * 2  , STAGE_BYTES = 8 * HTB, NXCD = 8, WGM = 8;

__host__ __device__ __forceinline__ int lds_byte(int r, int c) { const int st = (r >> 4) * 2 + (c >> 5), rr = r & 15, cc = c & 31, ob = rr * 64 + cc * 2; return st * 1024 + (ob ^ (((ob >> 9) & 1) << 5)); }
__host__ __device__ __forceinline__ void stage_rc(int b, int& R, int& C) { const int st = b / 1024, sb = b % 1024, swz = sb ^ (((sb >> 9) & 1) << 5); R = (st >> 1) * 16 + swz / 64; C = (st & 1) * 32 + (swz % 64) / 2; }
__host__ __device__ __forceinline__ int perm32(int rho) { const int n = rho >> 4, i = rho & 15; return 8 * (i >> 2) + 4 * n + (i & 3); }

struct Unit { int pm, pn; };
struct Gemm { const bf16_t* A; const bf16_t* Bt; int M, N, K; };

struct StaticOrder {
    int nM, nN, nwg, G, c;
    __host__ __device__ void init(int M, int N, int G_, int c_) { nM = M / BM; nN = N / BM; nwg = nM * nN; G = G_; c = c_; }
    __host__ __device__ bool next(int i, Unit& u) const {
        const long L = (long)i * G + c; if (L >= nwg) return false;
        int wgid = (int)L; { const int q = nwg / NXCD, r = nwg % NXCD, xcd = wgid % NXCD, off = wgid / NXCD; wgid = (xcd < r ? xcd * (q + 1) : r * (q + 1) + (xcd - r) * q) + off; }
        const int nig = WGM * nN, gid = wgid / nig, fm = gid * WGM, gsz = (nM - fm) < WGM ? (nM - fm) : WGM;
        u.pm = fm + ((wgid % nig) % gsz); u.pn = (wgid % nig) / gsz; return true;
    }
    __device__ __forceinline__ void a_ready(const Unit&) const {}
    __device__ __forceinline__ void done(const Unit&) const {}
};
struct CountedOrder : StaticOrder {
    const unsigned* ready; unsigned need; unsigned* tmo;
    __device__ __forceinline__ void a_ready(const Unit& u) const {
        if (threadIdx.x < 64) {
            const unsigned long long t0 = __builtin_amdgcn_s_memrealtime(); unsigned polls = 0;
            while ((unsigned)__builtin_amdgcn_readfirstlane(__hip_atomic_load(ready + 64 * u.pm, __ATOMIC_RELAXED, __HIP_MEMORY_SCOPE_AGENT)) < need) {
                if ((++polls & 255u) == 0u && __builtin_amdgcn_readfirstlane(__hip_atomic_load(tmo, __ATOMIC_RELAXED, __HIP_MEMORY_SCOPE_AGENT)) != 0u) break;
                if (__builtin_amdgcn_s_memrealtime() - t0 > 2000000ull) {
                    if (threadIdx.x == 0) { unsigned expect = 0u; __hip_atomic_compare_exchange_strong(tmo + 1, &expect, 0x600u | (unsigned)(u.pm & 0xff), __ATOMIC_RELAXED, __ATOMIC_RELAXED, __HIP_MEMORY_SCOPE_AGENT); __hip_atomic_store(tmo, 1u, __ATOMIC_RELAXED, __HIP_MEMORY_SCOPE_AGENT); }
                    break; }
                __builtin_amdgcn_s_sleep(2); }
            __builtin_amdgcn_fence(__ATOMIC_ACQUIRE, "agent");
            asm volatile("s_waitcnt vmcnt(0)" ::: "memory");
        }
#if !defined(BROKEN_HOOK_NO_BARRIER)
        asm volatile("" ::: "memory"); __builtin_amdgcn_s_barrier(); asm volatile("" ::: "memory");
#endif
    }
};

__device__ __forceinline__ unsigned cvt_pk_bf16(float lo, float hi) { unsigned r; asm volatile("v_cvt_pk_bf16_f32 %0, %1, %2" : "=v"(r) : "v"(lo), "v"(hi)); return r; }
typedef float f32x2 __attribute__((ext_vector_type(2)));
__device__ __forceinline__ f32x2 gelu_pk(f32x2 v) {
    const f32x2 av = __builtin_elementwise_abs(v), d = av * 0.2316418882f + 1.0f;
    f32x2 t; t.x = __builtin_amdgcn_rcpf(d.x); t.y = __builtin_amdgcn_rcpf(d.y);
    f32x2 q = t * 0.5307027145f + (-0.7265760135f); q = q * t + 0.7107068705f; q = q * t + (-0.142248368f); q = q * t + 0.127414796f; q = q * t;
    const f32x2 s = (v * v) * (-0.72134752044f);
    f32x2 e; e.x = __builtin_amdgcn_exp2f(s.x); e.y = __builtin_amdgcn_exp2f(s.y);
    const f32x2 m = v * (q * e), r = v - m;
    f32x2 o; o.x = v.x < 0.f ? m.x : r.x; o.y = v.y < 0.f ? m.y : r.y; return o;
}

struct EpiF32 {
    static constexpr bool PERM = false, AFTER_DRAIN = false;
    float* C; int ldc; const float* bias;
    __device__ __forceinline__ void operator()(const f32x4 (&acc)[2][2][4][2], const Unit& u, int wr, int wc, int fr, int fq) const {
        const int row0 = u.pm * BM + wr * 64 + fr, col0 = u.pn * BM + wc * 32 + 4 * fq;
        f32x4 bv[2][2];
#pragma unroll
        for (int bj = 0; bj < 2; ++bj)
#pragma unroll
            for (int n = 0; n < 2; ++n) bv[bj][n] = bias ? *(const f32x4*)(bias + col0 + bj * HALF + n * 16) : (f32x4){0.f, 0.f, 0.f, 0.f};
#pragma unroll
        for (int ai = 0; ai < 2; ++ai)
#pragma unroll
            for (int m = 0; m < 4; ++m) { float* rowp = C + (size_t)(row0 + ai * HALF + m * 16) * ldc + col0;
#pragma unroll
                for (int bj = 0; bj < 2; ++bj)
#pragma unroll
                    for (int n = 0; n < 2; ++n) *(f32x4*)(rowp + bj * HALF + n * 16) = acc[ai][bj][m][n] + bv[bj][n]; }
    }
};
template <int ACT  > struct EpiBf16 {
    static constexpr bool PERM = true, AFTER_DRAIN = false;
    bf16_t* O; int ldc; const float* bias; int split_cols; size_t split_stride;
    __device__ __forceinline__ void operator()(const f32x4 (&acc)[2][2][4][2], const Unit& u, int wr, int wc, int fr, int fq) const {
        const int row0 = u.pm * BM + wr * 64 + fr; int colt = u.pn * BM; bf16_t* base = O;
        if (split_cols) { const int t = colt / split_cols; base += (size_t)t * split_stride; colt -= t * split_cols; }
        const int col0 = colt + wc * 32 + 8 * fq, bcol0 = u.pn * BM + wc * 32 + 8 * fq;
        f32x4 bv[2][2];
#pragma unroll
        for (int bj = 0; bj < 2; ++bj)
#pragma unroll
            for (int n = 0; n < 2; ++n) bv[bj][n] = bias ? *(const f32x4*)(bias + bcol0 + bj * HALF + 4 * n) : (f32x4){0.f, 0.f, 0.f, 0.f};
#pragma unroll
        for (int ai = 0; ai < 2; ++ai)
#pragma unroll
            for (int m = 0; m < 4; ++m) { bf16_t* rowp = base + (size_t)(row0 + ai * HALF + m * 16) * ldc + col0;
#pragma unroll
                for (int bj = 0; bj < 2; ++bj) { f32x4 v0 = acc[ai][bj][m][0] + bv[bj][0], v1 = acc[ai][bj][m][1] + bv[bj][1];
                    if (ACT == 1) { f32x2 a = gelu_pk((f32x2){v0[0], v0[1]}), b = gelu_pk((f32x2){v0[2], v0[3]}), c = gelu_pk((f32x2){v1[0], v1[1]}), d = gelu_pk((f32x2){v1[2], v1[3]});
                        v0 = (f32x4){a.x, a.y, b.x, b.y}; v1 = (f32x4){c.x, c.y, d.x, d.y}; }
                    if (ACT == 2) {
#pragma unroll
                        for (int j = 0; j < 4; ++j) { v0[j] = 0.5f * v0[j] * (1.0f + erff(v0[j] * 0.70710678f)); v1[j] = 0.5f * v1[j] * (1.0f + erff(v1[j] * 0.70710678f)); } }
                    u32x4 w; w.x = cvt_pk_bf16(v0[0], v0[1]); w.y = cvt_pk_bf16(v0[2], v0[3]); w.z = cvt_pk_bf16(v1[0], v1[1]); w.w = cvt_pk_bf16(v1[2], v1[3]);
                    *(u32x4*)(rowp + bj * HALF) = w; } }
    }
};

struct PanelStats {
    unsigned* xbuf;
    unsigned* cnt;
    unsigned* tmo;
    int ntn; float eps;
    unsigned code;
    __device__ __forceinline__ bool run(const f32x4 (&v)[2][2][4][2], const Unit& u, int wr, int wc, int fr, int fq, PG8_LAS unsigned char* lds, int wid, int lane) const {
        typedef float f32x2v __attribute__((ext_vector_type(2)));
        PG8_LAS f32x2v* P = (PG8_LAS f32x2v*)lds;
        PG8_LAS f32x2v* S = (PG8_LAS f32x2v*)(lds + 8192);
        PG8_LAS unsigned* flag = (PG8_LAS unsigned*)(lds + 8192 + 2048);
#pragma unroll
        for (int ai = 0; ai < 2; ++ai)
#pragma unroll
            for (int m = 0; m < 4; ++m) {
                float s = 0.f;
#pragma unroll
                for (int bj = 0; bj < 2; ++bj)
#pragma unroll
                    for (int n = 0; n < 2; ++n) { const f32x4 x = v[ai][bj][m][n]; s += (x[0] + x[1]) + (x[2] + x[3]); }
                s += __shfl_xor(s, 16); s += __shfl_xor(s, 32);
                const float mw = s * (1.0f / 64.0f); float q = 0.f;
#pragma unroll
                for (int bj = 0; bj < 2; ++bj)
#pragma unroll
                    for (int n = 0; n < 2; ++n) { const f32x4 d = v[ai][bj][m][n] - mw; q += (d[0] * d[0] + d[1] * d[1]) + (d[2] * d[2] + d[3] * d[3]); }
                q += __shfl_xor(q, 16); q += __shfl_xor(q, 32);
                if (fq == 0) P[(ai * HALF + wr * 64 + m * 16 + fr) * 4 + wc] = (f32x2v){mw, q};
            }
        asm volatile("s_waitcnt lgkmcnt(0)" ::: "memory"); __builtin_amdgcn_s_barrier(); asm volatile("" ::: "memory");
#if defined(BROKEN_NO_WAIT)
        if (blockIdx.x >= 64) { const long long t0 = clock64(); while (clock64() - t0 < 60000) __builtin_amdgcn_s_sleep(8); }
#endif
        const int row = wid * 32 + (lane & 31);
        if (lane < 32) {
            const f32x2v a = P[row * 4 + 0], b = P[row * 4 + 1], c = P[row * 4 + 2], d = P[row * 4 + 3];
            const float mt = (a.x + b.x + c.x + d.x) * 0.25f;
            const float da = a.x - mt, db = b.x - mt, dc = c.x - mt, dd = d.x - mt;
            const float m2 = (a.y + b.y) + (c.y + d.y) + 64.0f * ((da * da + db * db) + (dc * dc + dd * dd));
            unsigned long long* slot = (unsigned long long*)xbuf + ((size_t)(u.pm * BM + row) * 4 + u.pn);
            __hip_atomic_store(slot, ((unsigned long long)__float_as_uint(m2) << 32) | __float_as_uint(mt), __ATOMIC_RELAXED, __HIP_MEMORY_SCOPE_AGENT);
        }
        asm volatile("s_waitcnt vmcnt(0)" ::: "memory");
        if (lane == 0) __hip_atomic_fetch_add(cnt + 64 * u.pm, 1u, __ATOMIC_RELAXED, __HIP_MEMORY_SCOPE_AGENT);
        if (wid == 0) {
            bool dead = false; const unsigned long long t0 = __builtin_amdgcn_s_memrealtime(); const unsigned want = 8u * (unsigned)ntn;
            for (;;) {
#if defined(BROKEN_NO_WAIT)
                break;
#endif
                if ((unsigned)__builtin_amdgcn_readfirstlane(__hip_atomic_load(cnt + 64 * u.pm, __ATOMIC_RELAXED, __HIP_MEMORY_SCOPE_AGENT)) >= want) break;
                if (__builtin_amdgcn_s_memrealtime() - t0 > 2000000ull) {
                    if (lane == 0) { unsigned expect = 0u; __hip_atomic_compare_exchange_strong(tmo + 1, &expect, code | (unsigned)(u.pm & 0xff), __ATOMIC_RELAXED, __ATOMIC_RELAXED, __HIP_MEMORY_SCOPE_AGENT);
                                     __hip_atomic_store(tmo, 1u, __ATOMIC_RELAXED, __HIP_MEMORY_SCOPE_AGENT); }
                    dead = true; break; }
                __builtin_amdgcn_s_sleep(2);
            }
            __builtin_amdgcn_fence(__ATOMIC_ACQUIRE, "agent");
            if (lane == 0) flag[0] = dead ? 1u : 0u;
        }
        asm volatile("s_waitcnt vmcnt(0) lgkmcnt(0)" ::: "memory"); __builtin_amdgcn_s_barrier(); asm volatile("" ::: "memory");
        const bool bad = flag[0] != 0u;
        if (lane < 32) {
            const unsigned long long* slot = (const unsigned long long*)xbuf + (size_t)(u.pm * BM + row) * 4; float mt[4], m2[4]; float ms = 0.f;
#pragma unroll
            for (int t = 0; t < 4; ++t) { if (t < ntn) { const unsigned long long w = __hip_atomic_load(slot + t, __ATOMIC_RELAXED, __HIP_MEMORY_SCOPE_AGENT); mt[t] = __uint_as_float((unsigned)w); m2[t] = __uint_as_float((unsigned)(w >> 32)); } else { mt[t] = 0.f; m2[t] = 0.f; } ms += mt[t]; }
            const float mean = ms / (float)ntn; float q = 0.f;
#pragma unroll
            for (int t = 0; t < 4; ++t) if (t < ntn) { const float dm = mt[t] - mean; q += m2[t] + 256.0f * dm * dm; }
            S[row] = (f32x2v){mean, 1.0f / sqrtf(q / (256.0f * (float)ntn) + eps)};
        }
        asm volatile("s_waitcnt lgkmcnt(0)" ::: "memory"); __builtin_amdgcn_s_barrier(); asm volatile("" ::: "memory");
        return bad;
    }
};
struct EpiLnRes {
    static constexpr bool PERM = false, AFTER_DRAIN = true;
    const float* base; float* out; int ldc; const float* bias; PanelStats st; unsigned poison;
    __device__ __forceinline__ void refuse(size_t i0, size_t stride, int M, int N) const { const float q = __builtin_nanf(""); for (size_t i = i0; i < (size_t)M * N; i += stride) out[(i / N) * ldc + i % N] = q;
        if (i0 == 0) { unsigned expect = 0u; __hip_atomic_compare_exchange_strong(st.tmo + 1, &expect, 0x7f0u, __ATOMIC_RELAXED, __ATOMIC_RELAXED, __HIP_MEMORY_SCOPE_AGENT); __hip_atomic_store(st.tmo, 1u, __ATOMIC_RELAXED, __HIP_MEMORY_SCOPE_AGENT); } }
    __device__ __forceinline__ void fused(f32x4 (&acc)[2][2][4][2], const Unit& u, int wr, int wc, int fr, int fq, PG8_LAS unsigned char* lds, int wid, int lane) const {
        typedef float f32x2v __attribute__((ext_vector_type(2)));
        const PG8_LAS f32x2v* S = (const PG8_LAS f32x2v*)(lds + 8192);
        const int col0 = u.pn * BM + wc * 32 + 4 * fq;
#pragma unroll
        for (int bj = 0; bj < 2; ++bj)
#pragma unroll
            for (int n = 0; n < 2; ++n) { const f32x4 bv = bias ? *(const f32x4*)(bias + col0 + bj * HALF + n * 16) : (f32x4){0.f, 0.f, 0.f, 0.f};
#pragma unroll
                for (int ai = 0; ai < 2; ++ai)
#pragma unroll
                    for (int m = 0; m < 4; ++m) acc[ai][bj][m][n] += bv; }
        const bool bad = st.run(acc, u, wr, wc, fr, fq, lds, wid, lane) || poison != 0u;
        const float qnan = __builtin_nanf("");
#pragma unroll
        for (int ai = 0; ai < 2; ++ai)
#pragma unroll
            for (int m = 0; m < 4; ++m) { const int r = ai * HALF + wr * 64 + m * 16 + fr; const f32x2v sr = S[r]; const size_t off = (size_t)(u.pm * BM + r) * ldc + col0;
#pragma unroll
                for (int bj = 0; bj < 2; ++bj)
#pragma unroll
                    for (int n = 0; n < 2; ++n) { const f32x4 bs = *(const f32x4*)(base + off + bj * HALF + n * 16); f32x4 o = bs + (acc[ai][bj][m][n] - sr.x) * sr.y;
                        if (bad) o = (f32x4){qnan, qnan, qnan, qnan}; *(f32x4*)(out + off + bj * HALF + n * 16) = o; }
                asm volatile("" ::: "memory"); }
    }
};
struct EpiLnResLn {
    static constexpr bool PERM = false, AFTER_DRAIN = true;
    const float* base; float* out; bf16_t* xn; int ldc; const float* bias; PanelStats st1, st2; unsigned poison;
    __device__ __forceinline__ void refuse(size_t i0, size_t stride, int M, int N) const { const float q = __builtin_nanf(""); for (size_t i = i0; i < (size_t)M * N; i += stride) { const size_t o = (i / N) * ldc + i % N; out[o] = q; xn[o] = (bf16_t)0x7fc0u; }
        if (i0 == 0) { unsigned expect = 0u; __hip_atomic_compare_exchange_strong(st1.tmo + 1, &expect, 0x7f0u, __ATOMIC_RELAXED, __ATOMIC_RELAXED, __HIP_MEMORY_SCOPE_AGENT); __hip_atomic_store(st1.tmo, 1u, __ATOMIC_RELAXED, __HIP_MEMORY_SCOPE_AGENT); } }
    __device__ __forceinline__ void fused(f32x4 (&acc)[2][2][4][2], const Unit& u, int wr, int wc, int fr, int fq, PG8_LAS unsigned char* lds, int wid, int lane) const {
        typedef float f32x2v __attribute__((ext_vector_type(2))); typedef unsigned u32x2v __attribute__((ext_vector_type(2)));
        const PG8_LAS f32x2v* S = (const PG8_LAS f32x2v*)(lds + 8192);
        const int col0 = u.pn * BM + wc * 32 + 4 * fq;
#pragma unroll
        for (int bj = 0; bj < 2; ++bj)
#pragma unroll
            for (int n = 0; n < 2; ++n) { const f32x4 bv = bias ? *(const f32x4*)(bias + col0 + bj * HALF + n * 16) : (f32x4){0.f, 0.f, 0.f, 0.f};
#pragma unroll
                for (int ai = 0; ai < 2; ++ai)
#pragma unroll
                    for (int m = 0; m < 4; ++m) acc[ai][bj][m][n] += bv; }
        bool bad = st1.run(acc, u, wr, wc, fr, fq, lds, wid, lane) || poison != 0u;
        const float qnan = __builtin_nanf("");
#pragma unroll
        for (int ai = 0; ai < 2; ++ai)
#pragma unroll
            for (int m = 0; m < 4; ++m) { const int r = ai * HALF + wr * 64 + m * 16 + fr; const f32x2v sr = S[r]; const size_t off = (size_t)(u.pm * BM + r) * ldc + col0;
#pragma unroll
                for (int bj = 0; bj < 2; ++bj)
#pragma unroll
                    for (int n = 0; n < 2; ++n) { const f32x4 bs = *(const f32x4*)(base + off + bj * HALF + n * 16); acc[ai][bj][m][n] = bs + (acc[ai][bj][m][n] - sr.x) * sr.y; }
                asm volatile("" : "+v"(acc[ai][0][m][0]), "+v"(acc[ai][0][m][1]), "+v"(acc[ai][1][m][0]), "+v"(acc[ai][1][m][1]));
                if (m & 1) asm volatile("" ::: "memory"); }
        const bool bad1 = bad;
        bad = st2.run(acc, u, wr, wc, fr, fq, lds, wid, lane) || bad;
#pragma unroll
        for (int ai = 0; ai < 2; ++ai)
#pragma unroll
            for (int m = 0; m < 4; ++m) { const int r = ai * HALF + wr * 64 + m * 16 + fr; const f32x2v sr = S[r]; const size_t off = (size_t)(u.pm * BM + r) * ldc + col0;
#pragma unroll
                for (int bj = 0; bj < 2; ++bj)
#pragma unroll
                    for (int n = 0; n < 2; ++n) { const f32x4 x1 = acc[ai][bj][m][n]; *(f32x4*)(out + off + bj * HALF + n * 16) = bad1 ? (f32x4){qnan, qnan, qnan, qnan} : x1;
                        const f32x4 o = (x1 - sr.x) * sr.y; u32x2v w; w.x = cvt_pk_bf16(o[0], o[1]); w.y = cvt_pk_bf16(o[2], o[3]);
                        if (bad) { w.x = 0x7fc07fc0u; w.y = 0x7fc07fc0u; } *(u32x2v*)(xn + off + bj * HALF + n * 16) = w; }
                asm volatile("" ::: "memory"); }
    }
};

template <class Epi, class Sched, bool STAMP = false>
__device__ __forceinline__ void gemm_phase(PG8_LAS unsigned char* lds, const Gemm g, const Sched& S, const Epi& E, unsigned long long* stamps) {
    int tid_o = threadIdx.x; asm volatile("" : "+v"(tid_o));
    const int tid = tid_o, wid = __builtin_amdgcn_readfirstlane(tid >> 6), lane = tid & 63, wr = wid >> 2, wc = wid & 3, fr = lane & 15, fq = lane >> 4;
    const int K = g.K, nt = K / BK;
    int ts_lo = 0, ts_hi = 0, nts = 0; const unsigned long long rt_entry = STAMP ? (unsigned long long)wall_clock64() : 0ull;
#define PG8_STAMP() do { if (STAMP && wid == 0 && nts < 64) { const unsigned long long _c = (unsigned long long)clock64(); \
        ts_lo = (lane == nts) ? (int)(unsigned)_c : ts_lo; ts_hi = (lane == nts) ? (int)(unsigned)(_c >> 32) : ts_hi; ++nts; } } while (0)
    PG8_STAMP();
    unsigned voffA[2], voffB[2];
#pragma unroll
    for (int i = 0; i < 2; ++i) { int R, C; stage_rc(tid * 16 + i * 8192, R, C); const int Rb = Epi::PERM ? ((R & ~31) + perm32(R & 31)) : R;
        voffA[i] = (unsigned)(R * K + C) * 2u; voffB[i] = (unsigned)(Rb * K + C) * 2u; }
    const size_t kstep = (size_t)(BK * 2);
    const size_t hstep = (size_t)HALF * K * 2;
    const size_t tstep = 2 * hstep;
    const unsigned ldsw = (unsigned)wid * 1024u;
    const int aoff = lds_byte(wr * 64 + fr, fq * 8), boff = lds_byte(wc * 32 + fr, fq * 8);
#define PG8_SA(b, h) (((b) * 2 + (h)) * HTB)
#define PG8_SB(b, h) ((4 + (b) * 2 + (h)) * HTB)
#define PG8_STAGE(bufoff, gbase, voff) do { _Pragma("unroll") for (int _i = 0; _i < 2; ++_i) \
        __builtin_amdgcn_global_load_lds((const unsigned*)((const char*)(gbase) + (voff)[_i]), (PG8_LAS unsigned*)(lds + (bufoff) + ldsw + _i * 8192), 16, 0, 0); } while (0)
#define PG8_LDA(dst, b, h) do { _Pragma("unroll") for (int m = 0; m < 4; ++m) _Pragma("unroll") for (int k = 0; k < 2; ++k) dst[m][k] = *(const PG8_LAS bf16x8*)(lds + PG8_SA(b, h) + aoff + m * 2048 + k * 1024); } while (0)
#define PG8_LDB(dst, b, h) do { _Pragma("unroll") for (int n = 0; n < 2; ++n) _Pragma("unroll") for (int k = 0; k < 2; ++k) dst[n][k] = *(const PG8_LAS bf16x8*)(lds + PG8_SB(b, h) + boff + n * 2048 + k * 1024); } while (0)
#define PG8_MMA(ai, bj, At, Bt) do { __builtin_amdgcn_s_setprio(1); _Pragma("unroll") for (int m = 0; m < 4; ++m) _Pragma("unroll") for (int n = 0; n < 2; ++n) _Pragma("unroll") for (int k = 0; k < 2; ++k) \
        acc[ai][bj][m][n] = __builtin_amdgcn_mfma_f32_16x16x32_bf16(Bt[n][k], At[m][k], acc[ai][bj][m][n], 0, 0, 0); __builtin_amdgcn_s_setprio(0); } while (0)
#define PG8_WAIT_V(n) asm volatile("s_waitcnt vmcnt(" #n ")" ::: "memory")
#define PG8_WAIT_L(n) asm volatile("s_waitcnt lgkmcnt(" #n ")" ::: "memory")
#define PG8_BAR __builtin_amdgcn_s_barrier()
#define PG8_SCHED __builtin_amdgcn_sched_barrier(0)
    Unit cur, nxt; int ui = 0;
    if (!S.next(0, cur)) return;
    f32x4 acc[2][2][4][2];
#pragma unroll
    for (int a = 0; a < 2; ++a)
#pragma unroll
        for (int b = 0; b < 2; ++b)
#pragma unroll
            for (int m = 0; m < 4; ++m)
#pragma unroll
                for (int n = 0; n < 2; ++n) acc[a][b][m][n] = (f32x4){0.f, 0.f, 0.f, 0.f};
    bf16x8 At[4][2], B0[2][2], B1[2][2];
    const char* cA = (const char*)g.A + (size_t)cur.pm * tstep; const char* cB = (const char*)g.Bt + (size_t)cur.pn * tstep;
    S.a_ready(cur);
    PG8_STAGE(PG8_SB(0, 0), cB, voffB); PG8_STAGE(PG8_SA(0, 0), cA, voffA); PG8_STAGE(PG8_SB(0, 1), cB + hstep, voffB); PG8_STAGE(PG8_SA(0, 1), cA + hstep, voffA);
    if (wr == 1) PG8_BAR;
    PG8_WAIT_V(4); PG8_BAR;
    PG8_STAGE(PG8_SB(1, 0), cB + kstep, voffB); PG8_STAGE(PG8_SA(1, 0), cA + kstep, voffA); PG8_STAGE(PG8_SB(1, 1), cB + hstep + kstep, voffB);
    PG8_WAIT_V(6); PG8_BAR;
    PG8_STAMP();
    for (;;) {
        const bool has_next = S.next(ui + 1, nxt);
        const char* nA = has_next ? (const char*)g.A + (size_t)nxt.pm * tstep : cA; const char* nB = has_next ? (const char*)g.Bt + (size_t)nxt.pn * tstep : cB;
        for (int t = 0; t < nt; t += 2) {
            const bool last = (t == nt - 2);
            const char* a1 = cA + (size_t)(t + 1) * kstep;
            const char* a2 = last ? nA : cA + (size_t)(t + 2) * kstep; const char* b2 = last ? nB : cB + (size_t)(t + 2) * kstep;
            const char* a3 = a2 + kstep; const char* b3 = b2 + kstep;
            if (last && has_next) S.a_ready(nxt);
            PG8_LDB(B0, 0, 0); PG8_SCHED; PG8_LDA(At, 0, 0); PG8_STAGE(PG8_SA(1, 1), a1 + hstep, voffA);
            PG8_WAIT_L(8); PG8_BAR; PG8_WAIT_L(0); PG8_MMA(0, 0, At, B0); PG8_BAR; PG8_SCHED;
            PG8_LDB(B1, 0, 1); PG8_STAGE(PG8_SB(0, 0), b2, voffB);
            PG8_BAR; PG8_WAIT_L(0); PG8_MMA(0, 1, At, B1); PG8_BAR;
            PG8_LDA(At, 0, 1); PG8_STAGE(PG8_SA(0, 0), a2, voffA);
            PG8_BAR; PG8_WAIT_L(0); PG8_MMA(1, 0, At, B0); PG8_BAR; PG8_SCHED;
            PG8_STAGE(PG8_SB(0, 1), b2 + hstep, voffB);
            PG8_WAIT_V(6); PG8_BAR; PG8_MMA(1, 1, At, B1); PG8_BAR;
            PG8_LDB(B0, 1, 0); PG8_SCHED; PG8_LDA(At, 1, 0); PG8_STAGE(PG8_SA(0, 1), a2 + hstep, voffA);
            PG8_WAIT_L(8); PG8_BAR; PG8_WAIT_L(0); PG8_MMA(0, 0, At, B0); PG8_BAR; PG8_SCHED;
            PG8_LDB(B1, 1, 1); PG8_STAGE(PG8_SB(1, 0), b3, voffB);
            PG8_BAR; PG8_WAIT_L(0); PG8_MMA(0, 1, At, B1); PG8_BAR;
            PG8_LDA(At, 1, 1); PG8_STAGE(PG8_SA(1, 0), a3, voffA);
            PG8_BAR; PG8_WAIT_L(0); PG8_MMA(1, 0, At, B0); PG8_BAR; PG8_SCHED;
            PG8_STAGE(PG8_SB(1, 1), b3 + hstep, voffB);
            PG8_WAIT_V(6); PG8_BAR; PG8_MMA(1, 1, At, B1); PG8_BAR;
        }
        PG8_STAMP();
        if constexpr (!Epi::AFTER_DRAIN) { E(acc, cur, wr, wc, fr, fq); S.done(cur); }
        PG8_STAMP();
        if (!has_next) break;
#pragma unroll
        for (int a = 0; a < 2; ++a)
#pragma unroll
            for (int b = 0; b < 2; ++b)
#pragma unroll
                for (int m = 0; m < 4; ++m)
#pragma unroll
                    for (int n = 0; n < 2; ++n) acc[a][b][m][n] = (f32x4){0.f, 0.f, 0.f, 0.f};
        cur = nxt; cA = nA; cB = nB; ++ui;
    }
    PG8_WAIT_V(0);
    if (wr == 0) PG8_BAR;
    PG8_BAR;
    if constexpr (Epi::AFTER_DRAIN) { E.fused(acc, cur, wr, wc, fr, fq, lds, wid, lane); S.done(cur); }
    PG8_STAMP();
    if (STAMP && wid == 0) { stamps[lane] = lane < nts ? (((unsigned long long)(unsigned)ts_hi << 32) | (unsigned)ts_lo) : 0ull;
        if (lane == 62) stamps[62] = rt_entry; if (lane == 63) stamps[63] = (unsigned long long)wall_clock64(); }
#undef PG8_STAMP
#undef PG8_SA
#undef PG8_SB
#undef PG8_STAGE
#undef PG8_LDA
#undef PG8_LDB
#undef PG8_MMA
#undef PG8_WAIT_V
#undef PG8_WAIT_L
#undef PG8_BAR
#undef PG8_SCHED
}
}
#define XB_TMO      128
#define XB_XCNT(j)  (256  + 64 * (j))
#define XB_XSUB(j)  (1280 + 64 * (j))
#define XB_XGEN(j)  (2304 + 64 * (j))
#define XB_TOP      3328
#define XB_TOPGEN   3392
#define XCD_BAR_WORDS 3456
#define XB_SPIN_CAP (1u << 22)
#define LAS __attribute__((address_space(3)))

__device__ __forceinline__ unsigned xb_ld(unsigned* p)              { return __hip_atomic_load(p, __ATOMIC_RELAXED, __HIP_MEMORY_SCOPE_AGENT); }
__device__ __forceinline__ unsigned xb_add(unsigned* p, unsigned v) { return __hip_atomic_fetch_add(p, v, __ATOMIC_RELAXED, __HIP_MEMORY_SCOPE_AGENT); }
__device__ __forceinline__ unsigned xb_xcc_id() { return (unsigned)__builtin_amdgcn_s_getreg((3 << 11) | 20) & 0xFu; }
#define XB_SPIN(cond, bar) do { unsigned _sp = 0; while (cond) { __builtin_amdgcn_s_sleep(1); \
    if ((++_sp & 255u) == 0u) { if (xb_ld(&(bar)[XB_TMO])) break; if (_sp > XB_SPIN_CAP) { atomicAdd(&(bar)[XB_TMO], 1u); break; } } } } while (0)

struct XcdBarrier {
    unsigned* bar; unsigned x;
    volatile LAS unsigned* st;
};

__device__ __forceinline__ XcdBarrier xcd_barrier_post(unsigned* bar, volatile LAS unsigned* st) {
    XcdBarrier b; b.bar = bar; b.x = xb_xcc_id(); b.st = st;
    if (threadIdx.x == 0) (void)xb_add(&bar[XB_XCNT(b.x)], 1u);
    return b;
}
__device__ __forceinline__ void xcd_barrier_complete(unsigned* bar, unsigned x, unsigned& nloc, unsigned& nx) {
    const unsigned G = gridDim.x * gridDim.y * gridDim.z;
    unsigned sum, cnt, mine, sp = 0u;
    for (;;) {
        sum = 0u; cnt = 0u; mine = 0u;
#pragma unroll
        for (unsigned j = 0; j < 16; ++j) { const unsigned c = xb_ld(&bar[XB_XCNT(j)]); sum += c; cnt += (c > 0u) ? 1u : 0u; mine = (j == x) ? c : mine; }
        if (sum == G) break;
        __builtin_amdgcn_s_sleep(1);
        if ((++sp & 255u) == 0u) { if (xb_ld(&bar[XB_TMO])) break; if (sp > XB_SPIN_CAP) { atomicAdd(&bar[XB_TMO], 1u); break; } }
    }
    nloc = mine > 0u ? mine : 1u; nx = cnt > 0u ? cnt : 1u;
}

__device__ __forceinline__ void xcd_barrier(const XcdBarrier& b) {
    asm volatile("s_waitcnt vmcnt(0)" ::: "memory");
    __syncthreads();
    if (threadIdx.x == 0) {
        unsigned* bar = b.bar;
        __builtin_amdgcn_s_waitcnt(0);
        unsigned nloc = b.st[0], nx = b.st[1];
        if (nloc == 0u) { xcd_barrier_complete(bar, b.x, nloc, nx); b.st[0] = nloc; b.st[1] = nx; }
        const unsigned old = xb_add(&bar[XB_XSUB(b.x)], 1u);
        const unsigned gen = old / nloc;
        if (old + 1u == (gen + 1u) * nloc) {
            __builtin_amdgcn_fence(__ATOMIC_RELEASE, "agent");
            asm volatile("s_waitcnt vmcnt(0)" ::: "memory");
            const unsigned og = xb_add(&bar[XB_TOP], 1u);
            const unsigned tg = og / nx;
            if (og + 1u == (tg + 1u) * nx) xb_add(&bar[XB_TOPGEN], 1u);
            else XB_SPIN(xb_ld(&bar[XB_TOPGEN]) == tg, bar);
            __builtin_amdgcn_fence(__ATOMIC_ACQUIRE, "agent");
            xb_add(&bar[XB_XGEN(b.x)], 1u);
            asm volatile("s_waitcnt vmcnt(0)" ::: "memory");
        } else {
            XB_SPIN(xb_ld(&bar[XB_XGEN(b.x)]) == gen, bar);
            __builtin_amdgcn_fence(__ATOMIC_ACQUIRE, "agent");
            asm volatile("s_waitcnt vmcnt(0)" ::: "memory");
        }
    }
    __syncthreads();
}

#define DI __device__ __forceinline__
typedef unsigned short bf16;
typedef float f32x4 __attribute__((ext_vector_type(4)));
typedef unsigned u32x4 __attribute__((ext_vector_type(4)));
typedef unsigned u32x2 __attribute__((ext_vector_type(2)));

constexpr int D = 1024, NB = 4, SEQ = 4096, MP = NB * SEQ, SB = 32, MR = MP + SB, MPAD = MP + 256;
constexpr int PAST = 8192, NPOOL = 2560;
constexpr int NP = 3328, DFF = 4096, NGATE = 4096, BW = 256;
constexpr int C_S5U = 0, C_AQ = 256, C_AK = 512, C_AV = 768, C_AR = 1024, C_DQ = 1280, C_DK = 1536, C_DV = 1792, C_DZ = 2048, C_MQ = 2304, C_MK = 2560, C_MV = 2816, C_LR = 3072, C_DB = 3088, C_DA = 3092;
constexpr size_t O_YP = 0, O_YS = O_YP + (size_t)MP * D, O_PMK = O_YS + (size_t)SB * D, O_PMV = O_PMK + (size_t)2 * MP * 256, O_PS5R = O_PMV + (size_t)2 * MP * 256,
                 O_PS5I = O_PS5R + 2 * NB * 1024, O_PGLA = O_PS5I + 2 * NB * 1024, O_PGDN = O_PGLA + 2 * NB * 16384, O_PCONV = O_PGDN + 2 * NB * 16384,
                 O_SMK = O_PCONV + 2 * NB * 3 * 768, O_SMV = O_SMK + 2 * SB * 256, O_SS5R = O_SMV + 2 * SB * 256, O_SS5I = O_SS5R + 2 * SB * 1024,
                 O_SGLA = O_SS5I + 2 * SB * 1024, O_SGDN = O_SGLA + (size_t)2 * SB * 16384, O_SCONV = O_SGDN + (size_t)2 * SB * 16384, O_END = O_SCONV + 2 * SB * 3 * 768;
static_assert(O_END == 36292608, "output size");
constexpr size_t al256(size_t x) { return (x + 255) & ~(size_t)255; }
constexpr size_t WS_CTL = 0, CTL_BYTES = 1u << 20;
constexpr size_t WSZ_WIN = (size_t)NP * D * 2, WSZ_WG = (size_t)NGATE * D * 2, WSZ_WBR = (size_t)4 * D * BW * 2, WSZ_WOUT = (size_t)D * D * 2, WSZ_FF1 = (size_t)DFF * D * 2, WSZ_FF2 = (size_t)D * DFF * 2;
constexpr size_t WO_WIN = 0, WO_WG = WO_WIN + WSZ_WIN, WO_WBR = WO_WG + WSZ_WG, WO_WOUT = WO_WBR + WSZ_WBR, WO_FF1 = WO_WOUT + WSZ_WOUT, WO_FF2 = WO_FF1 + WSZ_FF1, W_LAYER = al256(WO_FF2 + WSZ_FF2);
constexpr size_t WS_W = CTL_BYTES;
constexpr size_t WS_H = WS_W + 2 * W_LAYER;
constexpr size_t WS_PROJ = WS_H + (size_t)MPAD * D * 2;
constexpr size_t WS_GATE = WS_PROJ + (size_t)MPAD * NP * 4;
constexpr size_t WS_Y = WS_GATE + (size_t)MPAD * NGATE * 2;
constexpr size_t YSTRIDE = (size_t)MPAD * BW * 2;
constexpr size_t WS_M32 = WS_Y + 4 * YSTRIDE;
constexpr size_t WS_MRG = WS_M32 + (size_t)MPAD * D * 4;
constexpr size_t WS_X1 = WS_MRG + (size_t)MPAD * D * 2;
constexpr size_t WS_X2 = WS_X1 + (size_t)MPAD * D * 4;
constexpr size_t WS_Z = WS_X2 + (size_t)MPAD * D * 4;
constexpr size_t WS_TMP = WS_Z + (size_t)MPAD * DFF * 2;
constexpr size_t TSTRIDE = (size_t)MPAD * BW * 4;
constexpr int T_LA = 0, T_GQ = 1, T_GK = 2, T_GV = 3, T_MQ = 4, T_YPRE = 5, T_OGLA = 6, T_OGDN = 7, T_N = 8;
constexpr size_t WS_GB = WS_TMP + T_N * TSTRIDE;
constexpr size_t WS_KM = WS_GB + 2 * (size_t)MPAD * 4 * 4;
constexpr size_t WS_KMS = WS_KM + 4 * 16 * 256 * 4;
constexpr size_t WS_END = WS_KMS + 32 * 32 * 256 * 4;
constexpr int CW_BAR = 1024;
constexpr int RING_BYTES = 131072, MISC_OFF = RING_BYTES + 320, LDS_BYTES = 147456;
#define LASQ __attribute__((address_space(3)))

DI float wsum(float v) {
#pragma unroll
    for (int o = 32; o >= 1; o >>= 1) v += __shfl_xor(v, o);
    return v;
}
DI float wmaxf(float v) {
#pragma unroll
    for (int o = 32; o >= 1; o >>= 1) v = fmaxf(v, __shfl_xor(v, o));
    return v;
}
DI unsigned f2bf(float f) { unsigned u = __builtin_bit_cast(unsigned, f); return (u + 0x7fffu + ((u >> 16) & 1u)) >> 16; }
DI unsigned pk2(float lo, float hi) { return f2bf(lo) | (f2bf(hi) << 16); }
DI float bflo(unsigned w) { return __builtin_bit_cast(float, w << 16); }
DI float bfhi(unsigned w) { return __builtin_bit_cast(float, w & 0xffff0000u); }
DI float sigmoid_(float x) { return 1.f / (1.f + __expf(-x)); }
DI float silu_(float x) { return x * sigmoid_(x); }
DI float softplus_(float x) { return x > 20.f ? x : log1pf(expf(x)); }
DI float logsigmoid_(float x) { return -softplus_(-x); }
DI float gelu_tanh_(float x) { const float u = 0.7978845608028654f * (x + 0.044715f * x * x * x); return 0.5f * x * (1.f + tanhf(u)); }

namespace pg8 {
#define EPI_OPAQUE_LANE() int fr = fr_, fq = fq_; asm volatile("" : "+v"(fr), "+v"(fq))
template <unsigned LDC> struct EpiStoreF32 {
    static constexpr bool PERM = false, AFTER_DRAIN = false;
    float* C;
    __device__ __forceinline__ void operator()(const f32x4 (&acc)[2][2][4][2], const Unit& u, int wr, int wc, int fr_, int fq_) const {
        EPI_OPAQUE_LANE();
        const unsigned row0 = (unsigned)(u.pm * BM + wr * 64 + fr), col0 = (unsigned)(u.pn * BM + wc * 32 + 4 * fq);
        const unsigned o0 = (row0 * LDC + col0) * 4u; char* cb = (char*)C;
#pragma unroll
        for (int ai = 0; ai < 2; ++ai)
#pragma unroll
            for (int m = 0; m < 4; ++m) {
#pragma unroll
                for (int bj = 0; bj < 2; ++bj)
#pragma unroll
                    for (int n = 0; n < 2; ++n) *(f32x4*)(cb + (o0 + ((unsigned)(ai * HALF + m * 16) * LDC + (unsigned)(bj * HALF + n * 16)) * 4u)) = acc[ai][bj][m][n]; }
    }
};
template <int ACT, unsigned LDC> struct EpiActBf16 {
    static constexpr bool PERM = true, AFTER_DRAIN = false;
    bf16_t* O;
    __device__ __forceinline__ void operator()(const f32x4 (&acc)[2][2][4][2], const Unit& u, int wr, int wc, int fr_, int fq_) const {
        EPI_OPAQUE_LANE();
        const unsigned row0 = (unsigned)(u.pm * BM + wr * 64 + fr), col0 = (unsigned)(u.pn * BM + wc * 32 + 8 * fq);
        const unsigned o0 = (row0 * LDC + col0) * 2u; char* ob = (char*)O;
#pragma unroll
        for (int ai = 0; ai < 2; ++ai)
#pragma unroll
            for (int m = 0; m < 4; ++m) {
#pragma unroll
                for (int bj = 0; bj < 2; ++bj) { f32x4 v0 = acc[ai][bj][m][0], v1 = acc[ai][bj][m][1];
#pragma unroll
                    for (int j = 0; j < 4; ++j) {
                        if (ACT == 0) { v0[j] = __builtin_amdgcn_rcpf(1.f + __expf(-v0[j])); v1[j] = __builtin_amdgcn_rcpf(1.f + __expf(-v1[j])); }
                        else { const float a = fmaxf(v0[j], 0.f), b = fmaxf(v1[j], 0.f); v0[j] = a * a; v1[j] = b * b; } }
                    u32x4 w; w.x = cvt_pk_bf16(v0[0], v0[1]); w.y = cvt_pk_bf16(v0[2], v0[3]); w.z = cvt_pk_bf16(v1[0], v1[1]); w.w = cvt_pk_bf16(v1[2], v1[3]);
                    *(u32x4*)(ob + (o0 + ((unsigned)(ai * HALF + m * 16) * LDC + (unsigned)(bj * HALF)) * 2u)) = w; } }
    }
};
template <int MODE> struct EpiGate {
    static constexpr bool PERM = true, AFTER_DRAIN = false;
    static constexpr unsigned LDG = 4096, LD = 1024;
    const bf16_t* gate; float* m32; bf16_t* mrg;
    __device__ __forceinline__ void operator()(const f32x4 (&acc)[2][2][4][2], const Unit& u, int wr, int wc, int fr_, int fq_) const {
        EPI_OPAQUE_LANE();
        const unsigned row0 = (unsigned)(u.pm * BM + wr * 64 + fr), col0 = (unsigned)(u.pn * BM + wc * 32 + 8 * fq);
        const unsigned g0 = (row0 * LDG + col0) * 2u, m0 = (row0 * LD + col0) * 4u, b0 = (row0 * LD + col0) * 2u;
        const char* gb = (const char*)gate; char* mb = (char*)m32; char* bb = (char*)mrg;
#pragma unroll
        for (int ai = 0; ai < 2; ++ai)
#pragma unroll
            for (int m = 0; m < 4; ++m) { const unsigned dr = (unsigned)(ai * HALF + m * 16);
#pragma unroll
                for (int bj = 0; bj < 2; ++bj) { const unsigned dc = (unsigned)(bj * HALF);
                    const u32x4 gw = *(const u32x4*)(gb + (g0 + (dr * LDG + dc) * 2u));
                    f32x4 v0 = acc[ai][bj][m][0], v1 = acc[ai][bj][m][1];
                    v0[0] *= __builtin_bit_cast(float, gw.x << 16); v0[1] *= __builtin_bit_cast(float, gw.x & 0xffff0000u);
                    v0[2] *= __builtin_bit_cast(float, gw.y << 16); v0[3] *= __builtin_bit_cast(float, gw.y & 0xffff0000u);
                    v1[0] *= __builtin_bit_cast(float, gw.z << 16); v1[1] *= __builtin_bit_cast(float, gw.z & 0xffff0000u);
                    v1[2] *= __builtin_bit_cast(float, gw.w << 16); v1[3] *= __builtin_bit_cast(float, gw.w & 0xffff0000u);
                    const unsigned mo = m0 + (dr * LD + dc) * 4u;
                    if (MODE != 0) { v0 += *(const f32x4*)(mb + mo); v1 += *(const f32x4*)(mb + mo + 16u); }
                    if (MODE != 2) { *(f32x4*)(mb + mo) = v0; *(f32x4*)(mb + mo + 16u) = v1; }
                    else { u32x4 w; w.x = cvt_pk_bf16(v0[0], v0[1]); w.y = cvt_pk_bf16(v0[2], v0[3]); w.z = cvt_pk_bf16(v1[0], v1[1]); w.w = cvt_pk_bf16(v1[2], v1[3]);
                           *(u32x4*)(bb + (b0 + (dr * LD + dc) * 2u)) = w; }
                    asm volatile("" ::: "memory"); } }
    }
};
struct EpiRes {
    static constexpr bool PERM = false, AFTER_DRAIN = false;
    static constexpr unsigned LD = 1024;
    const float* base_p; const float* base_s; float* out_p; float* out_s; int msplit; int ns;
    __device__ __forceinline__ void operator()(const f32x4 (&acc)[2][2][4][2], const Unit& u, int wr, int wc, int fr_, int fq_) const {
        EPI_OPAQUE_LANE();
        const bool smp = u.pm * BM >= msplit;
        const char* bb = (const char*)(smp ? base_s : base_p); char* ob = (char*)(smp ? out_s : out_p);
        const int rl0 = u.pm * BM - (smp ? msplit : 0) + wr * 64 + fr; const unsigned col0 = (unsigned)(u.pn * BM + wc * 32 + 4 * fq);
        const int lim = smp ? ns : 0x7fffffff;
#pragma unroll
        for (int ai = 0; ai < 2; ++ai)
#pragma unroll
            for (int m = 0; m < 4; ++m) { const int row = rl0 + ai * HALF + m * 16;
                if (row < lim) { const unsigned off = ((unsigned)row * LD + col0) * 4u;
#pragma unroll
                    for (int bj = 0; bj < 2; ++bj)
#pragma unroll
                        for (int n = 0; n < 2; ++n) { const unsigned o = off + (unsigned)(bj * HALF + n * 16) * 4u; const f32x4 b = *(const f32x4*)(bb + o); *(f32x4*)(ob + o) = b + acc[ai][bj][m][n]; } }
                asm volatile("" ::: "memory"); }
    }
};
}

struct Args { const void* in[40]; float* out; unsigned char* ws; int ph_lo, ph_hi, li, pad; };
struct Ctx {
    float* out; unsigned char* ws;
    LASQ unsigned char* lds;
    int tid, lane, wave, vcu, G, gw, NGW;
};
constexpr int PTAB_OFF = RING_BYTES;
DI unsigned long long inU(const Ctx& C, int i) { const u32x2 v = *(const LASQ u32x2*)(C.lds + PTAB_OFF + 8 * i);
    return ((unsigned long long)(unsigned)__builtin_amdgcn_readfirstlane((int)v.y) << 32) | (unsigned)__builtin_amdgcn_readfirstlane((int)v.x); }
DI const float* inF(const Ctx& C, int i) { return (const float*)inU(C, i); }
DI const int* inI(const Ctx& C, int i) { return (const int*)inU(C, i); }
DI float* tmpbuf(const Ctx& C, int i) { return (float*)(C.ws + WS_TMP + (size_t)i * TSTRIDE); }
DI bf16* ybuf(const Ctx& C, int i) { return (bf16*)(C.ws + WS_Y + (size_t)i * YSTRIDE); }
DI float* projp(const Ctx& C) { return (float*)(C.ws + WS_PROJ); }
DI bf16* Hp(const Ctx& C) { return (bf16*)(C.ws + WS_H); }
DI bf16* gatep(const Ctx& C) { return (bf16*)(C.ws + WS_GATE); }
DI float* m32p(const Ctx& C) { return (float*)(C.ws + WS_M32); }
DI bf16* mrgp(const Ctx& C) { return (bf16*)(C.ws + WS_MRG); }
DI float* X1p(const Ctx& C) { return (float*)(C.ws + WS_X1); }
DI float* X2p(const Ctx& C) { return (float*)(C.ws + WS_X2); }
DI bf16* Zp(const Ctx& C) { return (bf16*)(C.ws + WS_Z); }
DI float* GBp(const Ctx& C) { return (float*)(C.ws + WS_GB); }
DI float* GGp(const Ctx& C) { return (float*)(C.ws + WS_GB) + (size_t)MPAD * 4; }
DI float* KMp(const Ctx& C) { return (float*)(C.ws + WS_KM); }
DI float* KMSp(const Ctx& C) { return (float*)(C.ws + WS_KMS); }
DI bf16* wptr(const Ctx& C, int l, size_t off) { return (bf16*)(C.ws + WS_W + (size_t)l * W_LAYER + off); }

DI int winmap(int c) {
    if (c < 1024) return c;
    if (c < 1280) return 1040 + (c - 1024);
    if (c < 2048) return 1296 + (c - 1280);
    if (c < 2304) return 2072 + (c - 2048);
    if (c < 3072) return 2328 + (c - 2304);
    if (c < 3088) return 1024 + (c - 3072);
    if (c < 3096) return 2064 + (c - 3088);
    return -1;
}
template <bool MAP> DI void tr_item(const float* W, int K, int Nsrc, int Ndst, bf16* WT, LASQ float* scr, int item, int lane) {
    const int nblk = Ndst / 32, kb = item / nblk, nb = item % nblk, k0 = 64 * kb, n0 = 32 * nb;
    const int nd = n0 + (lane & 31); const int ns = MAP ? winmap(nd) : nd;
#pragma unroll 8
    for (int i = 0; i < 32; ++i) { const int kk = 2 * i + (lane >> 5); scr[kk * 33 + (lane & 31)] = (ns >= 0) ? W[(size_t)(k0 + kk) * Nsrc + ns] : 0.f; }
    asm volatile("s_waitcnt lgkmcnt(0)" ::: "memory");
    const int c = lane & 7;
#pragma unroll
    for (int j = 0; j < 4; ++j) { const int n = (lane >> 3) + 8 * j; const LASQ float* s = scr + (8 * c) * 33 + n;
        u32x4 o; o.x = pk2(s[0 * 33], s[1 * 33]); o.y = pk2(s[2 * 33], s[3 * 33]); o.z = pk2(s[4 * 33], s[5 * 33]); o.w = pk2(s[6 * 33], s[7 * 33]);
        *(u32x4*)(WT + (size_t)(n0 + n) * K + k0 + 8 * c) = o; }
    asm volatile("s_waitcnt lgkmcnt(0)" ::: "memory");
}
DI void rms_row(const float* xrow, const float* g, bf16* orow, int lane) {
    const f32x4* xr = (const f32x4*)xrow + lane; const f32x4* gr = (const f32x4*)g + lane;
    f32x4 v[4]; float s = 0.f;
#pragma unroll
    for (int j = 0; j < 4; ++j) { v[j] = xr[64 * j]; s += (v[j].x * v[j].x + v[j].y * v[j].y) + (v[j].z * v[j].z + v[j].w * v[j].w); }
    const float r = 1.f / sqrtf(wsum(s) * (1.f / D) + 1e-6f);
    unsigned long long* o8 = (unsigned long long*)orow + lane;
#pragma unroll
    for (int j = 0; j < 4; ++j) { const f32x4 gg = gr[64 * j];
        o8[64 * j] = (unsigned long long)pk2(v[j].x * r * gg.x, v[j].y * r * gg.y) | ((unsigned long long)pk2(v[j].z * r * gg.z, v[j].w * r * gg.w) << 32); }
}
DI void norm_rows(Ctx& C, const float* xp, const float* xs, const float* g) {
    for (int m = C.gw; m < MR; m += C.NGW) { const float* x = (m < MP) ? xp + (size_t)m * D : xs + (size_t)(m - MP) * D; rms_row(x, g, Hp(C) + (size_t)m * D, C.lane); }
}
DI void prologue(Ctx& C) {
    LASQ float* scr = (LASQ float*)(C.lds + C.wave * 16384);
    constexpr int I_IN = (D / 64) * (NP / 32), I_G = (D / 64) * (NGATE / 32), I_BR = (BW / 64) * (D / 32), I_O = (D / 64) * (D / 32), I_1 = (D / 64) * (DFF / 32), I_2 = (DFF / 64) * (D / 32);
    constexpr int PER_L = I_IN + I_G + 4 * I_BR + I_O + I_1 + I_2;
    for (int it = C.gw; it < 2 * PER_L; it += C.NGW) {
        const int l = it / PER_L; int r = it % PER_L;
        if (r < I_IN) { tr_item<true>(inF(C, 11) + (size_t)l * D * 3096, D, 3096, NP, wptr(C, l, WO_WIN), scr, r, C.lane); continue; } r -= I_IN;
        if (r < I_G) { tr_item<false>(inF(C, 31) + (size_t)l * D * NGATE, D, NGATE, NGATE, wptr(C, l, WO_WG), scr, r, C.lane); continue; } r -= I_G;
        if (r < 4 * I_BR) { const int br = r / I_BR; tr_item<false>(inF(C, 32 + br) + (size_t)l * BW * D, BW, D, D, wptr(C, l, WO_WBR) + (size_t)br * D * BW, scr, r % I_BR, C.lane); continue; } r -= 4 * I_BR;
        if (r < I_O) { tr_item<false>(inF(C, 36) + (size_t)l * D * D, D, D, D, wptr(C, l, WO_WOUT), scr, r, C.lane); continue; } r -= I_O;
        if (r < I_1) { tr_item<false>(inF(C, 38) + (size_t)l * D * DFF, D, DFF, DFF, wptr(C, l, WO_FF1), scr, r, C.lane); continue; } r -= I_1;
        tr_item<false>(inF(C, 39) + (size_t)l * DFF * D, DFF, D, D, wptr(C, l, WO_FF2), scr, r, C.lane);
    }
    norm_rows(C, inF(C, 0), inF(C, 1), inF(C, 10));
}

DI void pre_row(Ctx& C, int l, int m) {
    const int lane = C.lane; const bool smp = m >= MP; const int bs = m - MP, t = smp ? 0 : (m & (SEQ - 1)), pos = smp ? PAST : t;
    const float* pr = projp(C) + (size_t)m * NP;
    {
        const float* Wg = inF(C, 22) + (size_t)l * 16 * 256; const float* bg = inF(C, 23) + l * 256; float* LA = tmpbuf(C, T_LA) + (size_t)m * 256;
        float lr[16];
#pragma unroll
        for (int r = 0; r < 16; ++r) lr[r] = pr[C_LR + r];
#pragma unroll
        for (int i = 0; i < 4; ++i) { const int c = lane + 64 * i; float x = bg[c];
#pragma unroll
            for (int r = 0; r < 16; ++r) x += lr[r] * Wg[r * 256 + c];
            LA[c] = logsigmoid_(x) * (1.f / 16.f); }
    }
    {
        const float* cw = inF(C, 25) + (size_t)l * 4 * 768; const float* cst = inF(C, 9) + ((size_t)l * SB + (smp ? bs : 0)) * 3 * 768;
#pragma unroll 1
        for (int grp = 0; grp < 3; ++grp) {
            float vals[4];
#pragma unroll
            for (int i = 0; i < 4; ++i) { const int c = grp * 256 + lane + 64 * i; float acc = 0.f;
#pragma unroll
                for (int j = 0; j < 4; ++j) { const int tt = t - 3 + j; float xin;
                    if (tt >= 0) xin = projp(C)[(size_t)(m - 3 + j) * NP + C_DQ + c]; else xin = smp ? cst[(tt + 3) * 768 + c] : 0.f;
                    acc += cw[j * 768 + c] * xin; }
                vals[i] = silu_(acc); }
            if (grp < 2) {
#pragma unroll
                for (int i = 0; i < 4; ++i) { const float ss = wsum(vals[i] * vals[i]); vals[i] *= (1.f / sqrtf(ss + 1e-6f)) * (grp == 0 ? 0.125f : 1.f); } }
            float* GO = tmpbuf(C, T_GQ + grp) + (size_t)m * 256;
#pragma unroll
            for (int i = 0; i < 4; ++i) GO[i * 64 + lane] = vals[i];
            asm volatile("" ::: "memory");
        }
        if (lane < 4) { GBp(C)[(size_t)m * 4 + lane] = sigmoid_(pr[C_DB + lane]);
                        GGp(C)[(size_t)m * 4 + lane] = -expf(inF(C, 26)[l * 4 + lane]) * softplus_(pr[C_DA + lane] + inF(C, 27)[l * 4 + lane]); }
        if (!smp && t >= SEQ - 3) { float* o = C.out + O_PCONV + (((size_t)l * NB + (m >> 12)) * 3 + (t - (SEQ - 3))) * 768;
#pragma unroll
            for (int i = 0; i < 12; ++i) o[lane + 64 * i] = pr[C_DQ + lane + 64 * i]; }
        if (smp) { float* o = C.out + O_SCONV + ((size_t)l * SB + bs) * 3 * 768;
#pragma unroll
            for (int i = 0; i < 12; ++i) { const int c = lane + 64 * i; o[c] = cst[768 + c]; o[768 + c] = cst[2 * 768 + c]; o[2 * 768 + c] = pr[C_DQ + c]; } }
    }
    {
        const float* qn = inF(C, 29) + l * 64; const float* kn = inF(C, 30) + l * 64;
        const float inv = powf(500000.f, -(float)(lane & 7) * 0.125f), ang = (float)pos * inv, cs = cosf(ang), sn = sinf(ang);
        float* MQ = tmpbuf(C, T_MQ) + (size_t)m * 256;
        float* MK = smp ? C.out + O_SMK + ((size_t)l * SB + bs) * 256 : C.out + O_PMK + ((size_t)l * MP + m) * 256;
        float* MV = smp ? C.out + O_SMV + ((size_t)l * SB + bs) * 256 : C.out + O_PMV + ((size_t)l * MP + m) * 256;
#pragma unroll
        for (int i = 0; i < 4; ++i) {
            float xq = pr[C_MQ + i * 64 + lane], xk = pr[C_MK + i * 64 + lane];
            xq = xq * (1.f / sqrtf(wsum(xq * xq) * (1.f / 64.f) + 1e-6f)) * qn[lane];
            xk = xk * (1.f / sqrtf(wsum(xk * xk) * (1.f / 64.f) + 1e-6f)) * kn[lane];
            const float pq = __shfl_xor(xq, 8), pk = __shfl_xor(xk, 8);
            if (lane < 8) { xq = xq * cs - pq * sn; xk = xk * cs - pk * sn; } else if (lane < 16) { xq = xq * cs + pq * sn; xk = xk * cs + pk * sn; }
            MQ[i * 64 + lane] = xq; MK[i * 64 + lane] = xk; MV[i * 64 + lane] = pr[C_MV + i * 64 + lane]; }
    }
}
DI void kmean_item(Ctx& C, int l, int it) {
    const int lane = C.lane; float s[4] = {0.f, 0.f, 0.f, 0.f};
    if (it < NB * 16) { const int b = it >> 4, blk = it & 15; const float* k = C.out + O_PMK + ((size_t)l * MP + (size_t)b * SEQ + blk * 256) * 256;
        for (int j = 0; j < 256; ++j) {
#pragma unroll
            for (int i = 0; i < 4; ++i) s[i] += k[(size_t)j * 256 + lane + 64 * i]; }
#pragma unroll
        for (int i = 0; i < 4; ++i) KMp(C)[(size_t)it * 256 + lane + 64 * i] = s[i] * (1.f / 256.f);
    } else { const int r = it - NB * 16, bs = r >> 5, blk = r & 31; const int* pt = inI(C, 4) + bs * 64 + blk * 2; const float* ck = inF(C, 2) + (size_t)l * NPOOL * 128 * 256;
        for (int pg = 0; pg < 2; ++pg) { const float* k = ck + (size_t)pt[pg] * 128 * 256;
            for (int j = 0; j < 128; ++j) {
#pragma unroll
                for (int i = 0; i < 4; ++i) s[i] += k[(size_t)j * 256 + lane + 64 * i]; } }
#pragma unroll
        for (int i = 0; i < 4; ++i) KMSp(C)[(size_t)r * 256 + lane + 64 * i] = s[i] * (1.f / 256.f);
    }
}
DI void s5_naive(Ctx& C, int l, int s, int g) {
    const int lane = C.lane; const int pg = (l * 16 + g) * 64 + lane;
    const float dt = expf(inF(C, 14)[l * 16 + g]); const float ar = inF(C, 12)[pg], ai = inF(C, 13)[pg];
    const float mag = expf(ar * dt), ang = ai * dt, are = mag * cosf(ang), aim = mag * sinf(ang);
    const float den = ar * ar + ai * ai, nr = are - 1.f, fre = (nr * ar + aim * ai) / den, fim = (aim * ar - nr * ai) / den;
    float bre[16], bim[16], cre[16], cim[16];
#pragma unroll
    for (int c = 0; c < 16; ++c) { const float br = inF(C, 15)[(size_t)pg * 16 + c], bi = inF(C, 16)[(size_t)pg * 16 + c]; bre[c] = fre * br - fim * bi; bim[c] = fre * bi + fim * br;
        cre[c] = inF(C, 17)[((size_t)(l * 16 + g) * 16 + c) * 64 + lane]; cim[c] = inF(C, 18)[((size_t)(l * 16 + g) * 16 + c) * 64 + lane]; }
    const float dd = inF(C, 19)[l * 256 + g * 16 + (lane & 15)];
    int L, row0; float hr = 0.f, hi = 0.f;
    if (s < NB) { L = SEQ; row0 = s * SEQ; } else { L = 1; row0 = MP + (s - NB); hr = inF(C, 5)[((size_t)(l * SB + s - NB) * 16 + g) * 64 + lane]; hi = inF(C, 6)[((size_t)(l * SB + s - NB) * 16 + g) * 64 + lane]; }
    float* YPRE = tmpbuf(C, T_YPRE);
    for (int t = 0; t < L; ++t) {
        const float* up = projp(C) + (size_t)(row0 + t) * NP + C_S5U + g * 16;
        float xr = 0.f, xi = 0.f;
#pragma unroll
        for (int c = 0; c < 16; ++c) { const float u = up[c]; xr += bre[c] * u; xi += bim[c] * u; }
        const float nhr = are * hr - aim * hi + xr, nhi = are * hi + aim * hr + xi; hr = nhr; hi = nhi;
        float myy = 0.f;
#pragma unroll
        for (int c = 0; c < 16; ++c) { const float yc = wsum(hr * cre[c] - hi * cim[c]); if (lane == c) myy = yc; }
        if (lane < 16) YPRE[(size_t)(row0 + t) * 256 + g * 16 + lane] = gelu_tanh_(myy + dd * up[lane]);
    }
    const size_t so = (s < NB) ? ((size_t)(l * NB + s) * 16 + g) * 64 + lane : ((size_t)(l * SB + s - NB) * 16 + g) * 64 + lane;
    if (s < NB) { C.out[O_PS5R + so] = hr; C.out[O_PS5I + so] = hi; } else { C.out[O_SS5R + so] = hr; C.out[O_SS5I + so] = hi; }
}
DI void gla_naive(Ctx& C, int l, int s, int h, int j) {
    const int lane = C.lane; float S[8]; int L, row0; size_t sto;
    if (s < NB) { L = SEQ; row0 = s * SEQ; sto = O_PGLA + (((size_t)(l * NB + s) * 4 + h) * 64 + lane) * 64 + 8 * j;
#pragma unroll
        for (int i = 0; i < 8; ++i) S[i] = 0.f; }
    else { L = 1; row0 = MP + s - NB; sto = O_SGLA + (((size_t)(l * SB + s - NB) * 4 + h) * 64 + lane) * 64 + 8 * j; const float* st = inF(C, 7) + (((size_t)(l * SB + s - NB) * 4 + h) * 64 + lane) * 64 + 8 * j;
#pragma unroll
        for (int i = 0; i < 8; ++i) S[i] = st[i]; }
    const float* LA = tmpbuf(C, T_LA); float* OG = tmpbuf(C, T_OGLA);
    for (int t = 0; t < L; ++t) { const size_t m = row0 + t; const float* pr = projp(C) + m * NP;
        const float q = pr[C_AQ + h * 64 + lane] * 0.125f, k = pr[C_AK + h * 64 + lane], a = __expf(LA[m * 256 + h * 64 + lane]);
        float myo = 0.f;
#pragma unroll
        for (int i = 0; i < 8; ++i) { S[i] = a * S[i] + k * pr[C_AV + h * 64 + 8 * j + i]; const float o = wsum(q * S[i]); if (lane == i) myo = o; }
        if (lane < 8) OG[m * 256 + h * 64 + 8 * j + lane] = myo; }
#pragma unroll
    for (int i = 0; i < 8; ++i) C.out[sto + i] = S[i];
}
DI void gdn_naive(Ctx& C, int l, int s, int h, int j) {
    const int lane = C.lane; float S[8]; int L, row0; size_t sto;
    if (s < NB) { L = SEQ; row0 = s * SEQ; sto = O_PGDN + (((size_t)(l * NB + s) * 4 + h) * 64 + lane) * 64 + 8 * j;
#pragma unroll
        for (int i = 0; i < 8; ++i) S[i] = 0.f; }
    else { L = 1; row0 = MP + s - NB; sto = O_SGDN + (((size_t)(l * SB + s - NB) * 4 + h) * 64 + lane) * 64 + 8 * j; const float* st = inF(C, 8) + (((size_t)(l * SB + s - NB) * 4 + h) * 64 + lane) * 64 + 8 * j;
#pragma unroll
        for (int i = 0; i < 8; ++i) S[i] = st[i]; }
    const float* GQ = tmpbuf(C, T_GQ); const float* GK = tmpbuf(C, T_GK); const float* GV = tmpbuf(C, T_GV); float* OG = tmpbuf(C, T_OGDN);
    for (int t = 0; t < L; ++t) { const size_t m = row0 + t;
        const float q = GQ[m * 256 + h * 64 + lane], k = GK[m * 256 + h * 64 + lane], beta = GBp(C)[m * 4 + h], a = __expf(GGp(C)[m * 4 + h]);
        float myo = 0.f;
#pragma unroll
        for (int i = 0; i < 8; ++i) { S[i] *= a; const float ks = wsum(k * S[i]); S[i] += beta * k * (GV[m * 256 + h * 64 + 8 * j + i] - ks); const float o = wsum(q * S[i]); if (lane == i) myo = o; }
        if (lane < 8) OG[m * 256 + h * 64 + 8 * j + lane] = myo; }
#pragma unroll
    for (int i = 0; i < 8; ++i) C.out[sto + i] = S[i];
}
DI const float* moba_kv_row(const Ctx& C, int l, bool smp, int b, int kp, int h, bool isv) {
    if (!smp) return C.out + (isv ? O_PMV : O_PMK) + ((size_t)l * MP + (size_t)b * SEQ + kp) * 256 + h * 64;
    if (kp >= PAST) return C.out + (isv ? O_SMV : O_SMK) + ((size_t)l * SB + b) * 256 + h * 64;
    const int page = (inI(C, 4))[b * 64 + (kp >> 7)];
    return inF(C, isv ? 3 : 2) + (((size_t)l * NPOOL + page) * 128 + (kp & 127)) * 256 + h * 64;
}
DI void moba_naive(Ctx& C, int l, int m, int h, LASQ float* wl) {
    const int lane = C.lane; const bool smp = m >= MP; const int b = smp ? m - MP : (m >> 12), t = smp ? 0 : (m & (SEQ - 1)), pos = smp ? PAST : t, own = pos >> 8;
    const float q = tmpbuf(C, T_MQ)[(size_t)m * 256 + h * 64 + lane];
    wl[lane] = q;
    const float* km = smp ? KMSp(C) + (size_t)b * 32 * 256 + h * 64 : KMp(C) + (size_t)b * 16 * 256 + h * 64;
    float myg = -3.0e38f;
    for (int n = 0; n < own; ++n) { const float gs = wsum(q * km[(size_t)n * 256 + lane]); if (lane == n) myg = gs; }
    int sel[4];
#pragma unroll
    for (int r = 0; r < 3; ++r) { if (r < own) { const float mx = wmaxf(myg); const unsigned long long bal = __ballot(myg == mx); const int idx = __ffsll((long long)bal) - 1; sel[r] = idx; if (lane == idx) myg = -3.0e38f; } else sel[r] = -1; }
    sel[3] = own;
    asm volatile("s_waitcnt lgkmcnt(0)" ::: "memory");
    float lg[4][4]; float mx = -3.0e38f;
#pragma unroll
    for (int r = 0; r < 4; ++r) {
#pragma unroll
        for (int i = 0; i < 4; ++i) { lg[r][i] = -3.0e38f;
            const int kp = sel[r] * 256 + lane + 64 * i;
            if (sel[r] >= 0 && kp <= pos) { const f32x4* kr = (const f32x4*)moba_kv_row(C, l, smp, b, kp, h, false); float dot = 0.f;
#pragma unroll
                for (int d4 = 0; d4 < 16; ++d4) { const f32x4 kv = kr[d4]; const f32x4 qv = *(const LASQ f32x4*)(wl + 4 * d4); dot += (kv.x * qv.x + kv.y * qv.y) + (kv.z * qv.z + kv.w * qv.w); }
                lg[r][i] = dot * 0.125f; mx = fmaxf(mx, lg[r][i]); } } }
    mx = wmaxf(mx); float sum = 0.f;
#pragma unroll
    for (int r = 0; r < 4; ++r)
#pragma unroll
        for (int i = 0; i < 4; ++i) { const float p = (lg[r][i] > -1.0e38f) ? __expf(lg[r][i] - mx) : 0.f; sum += p; wl[64 + r * 256 + lane + 64 * i] = p; }
    sum = wsum(sum);
    asm volatile("s_waitcnt lgkmcnt(0)" ::: "memory");
    float o = 0.f;
#pragma unroll
    for (int r = 0; r < 4; ++r) { if (sel[r] < 0) continue; const int nk = (r == 3) ? (pos - own * 256 + 1) : 256;
        for (int key = 0; key < nk; ++key) { const float* vr = moba_kv_row(C, l, smp, b, sel[r] * 256 + key, h, true); o += wl[64 + r * 256 + key] * vr[lane]; } }
    ybuf(C, 3)[(size_t)m * 256 + h * 64 + lane] = (bf16)f2bf(o / sum);
    asm volatile("s_waitcnt lgkmcnt(0)" ::: "memory");
}
DI void post_row(Ctx& C, int l, int m) {
    const int lane = C.lane; const float* pr = projp(C) + (size_t)m * NP;
    {   const float* y = tmpbuf(C, T_YPRE) + (size_t)m * 256; const float* Wg = inF(C, 20) + (size_t)l * 256 * 256; const float* bg = inF(C, 21) + l * 256;
        float z[4];
#pragma unroll
        for (int i = 0; i < 4; ++i) z[i] = bg[lane + 64 * i];
        for (int k = 0; k < 256; ++k) { const float yk = y[k];
#pragma unroll
            for (int i = 0; i < 4; ++i) z[i] += yk * Wg[(size_t)k * 256 + lane + 64 * i]; }
#pragma unroll
        for (int i = 0; i < 4; ++i) ybuf(C, 0)[(size_t)m * 256 + lane + 64 * i] = (bf16)f2bf(y[lane + 64 * i] * sigmoid_(z[i])); }
    {   const float* og = tmpbuf(C, T_OGLA) + (size_t)m * 256; const float gn = inF(C, 24)[l * 64 + lane];
#pragma unroll
        for (int i = 0; i < 4; ++i) { const float o = og[i * 64 + lane]; const float r = 1.f / sqrtf(wsum(o * o) * (1.f / 64.f) + 1e-6f);
            ybuf(C, 1)[(size_t)m * 256 + i * 64 + lane] = (bf16)f2bf(o * r * gn * silu_(pr[C_AR + i * 64 + lane])); } }
    {   const float* og = tmpbuf(C, T_OGDN) + (size_t)m * 256; const float gn = inF(C, 28)[l * 64 + lane];
#pragma unroll
        for (int i = 0; i < 4; ++i) { const float o = og[i * 64 + lane]; const float r = 1.f / sqrtf(wsum(o * o) * (1.f / 64.f) + 1e-6f);
            ybuf(C, 2)[(size_t)m * 256 + i * 64 + lane] = (bf16)f2bf(o * r * gn * silu_(pr[C_DZ + i * 64 + lane])); } }
}

constexpr int PH_PER_LAYER = 11, N_PHASES = 1 + 2 * PH_PER_LAYER - 1;
#ifndef MK_ONE_LAUNCH
#define MK_ONE_LAUNCH 1
#endif

__global__ void __launch_bounds__(512, 2) fwd(Args a) {
    extern __shared__ __attribute__((aligned(16))) unsigned char lds_raw[];
    Ctx C;
    C.out = a.out; C.ws = a.ws; C.lds = (LASQ unsigned char*)lds_raw;
    C.tid = threadIdx.x; C.lane = C.tid & 63; C.wave = __builtin_amdgcn_readfirstlane(C.tid >> 6);
    C.G = gridDim.x; { const int bx = blockIdx.x; C.vcu = (C.G % 8 == 0) ? (bx % 8) * (C.G / 8) + bx / 8 : bx; }
    C.gw = C.wave * C.G + C.vcu; C.NGW = C.G * 8;
    volatile LASQ unsigned* MISC = (volatile LASQ unsigned*)(C.lds + MISC_OFF);
    if (C.tid < 32) MISC[C.tid] = 0u;
    if (C.tid < 40) *(LASQ unsigned long long*)(C.lds + PTAB_OFF + 8 * C.tid) = (unsigned long long)a.in[C.tid];
    __syncthreads();
    unsigned* ctl = (unsigned*)(a.ws + WS_CTL);
    XcdBarrier bar = xcd_barrier_post(ctl + CW_BAR + a.li * XCD_BAR_WORDS, (volatile LAS unsigned*)(MISC + 8));
    const int lo = a.ph_lo, hi = a.ph_hi; int ph = 0;
    LASQ unsigned char* ring = C.lds;
    const int bid = (int)blockIdx.x;
#define PH_BEGIN if (ph >= lo && ph < hi) { { int t_ = threadIdx.x; asm volatile("" : "+v"(t_)); C.tid = t_; C.lane = t_ & 63; }
#define PH_END   if (ph + 1 < hi) xcd_barrier(bar); } ++ph;

    PH_BEGIN
#if !defined(SKIP_PH0)
        prologue(C);
    #endif
    PH_END

    for (int l = 0; l < 2; ++l) {
        PH_BEGIN
#if !defined(SKIP_PH1)
            { pg8::Gemm g{Hp(C), wptr(C, l, WO_WIN), MPAD, NP, D}; pg8::StaticOrder S; S.init(MPAD, NP, C.G, bid); pg8::EpiStoreF32<NP> E{projp(C)};
              pg8::gemm_phase<pg8::EpiStoreF32<NP>, pg8::StaticOrder>(ring, g, S, E, nullptr); }
            { pg8::Gemm g{Hp(C), wptr(C, l, WO_WG), MPAD, NGATE, D}; pg8::StaticOrder S; S.init(MPAD, NGATE, C.G, C.G - 1 - bid); pg8::EpiActBf16<0, NGATE> E{gatep(C)};
              pg8::gemm_phase<pg8::EpiActBf16<0, NGATE>, pg8::StaticOrder>(ring, g, S, E, nullptr); }
        #endif
    PH_END
        PH_BEGIN
#if !defined(SKIP_PH2)
            for (int m = C.gw; m < MR; m += C.NGW) pre_row(C, l, m);
        #endif
    PH_END
        PH_BEGIN
#if !defined(SKIP_PH3)
            for (int it = C.gw; it < NB * 16 + SB * 32; it += C.NGW) kmean_item(C, l, it);
        #endif
    PH_END
        PH_BEGIN
#if !defined(SKIP_PH4)
            {   constexpr int nA = NB * 16, nB = NB * 32, nC = NB * 32, nD = SB * 16, nE = SB * 32, nF = SB * 32, nG = SB * 4, nH = MP * 4;
                constexpr int tot = nA + nB + nC + nD + nE + nF + nG + nH;
                LASQ float* wl = (LASQ float*)(C.lds + C.wave * 16384);
                for (int it = C.gw; it < tot; it += C.NGW) { int r = it;
                    if (r < nA) { s5_naive(C, l, r >> 4, r & 15); continue; } r -= nA;
                    if (r < nB) { gla_naive(C, l, r >> 5, (r >> 3) & 3, r & 7); continue; } r -= nB;
                    if (r < nC) { gdn_naive(C, l, r >> 5, (r >> 3) & 3, r & 7); continue; } r -= nC;
                    if (r < nD) { s5_naive(C, l, NB + (r >> 4), r & 15); continue; } r -= nD;
                    if (r < nE) { gla_naive(C, l, NB + (r >> 5), (r >> 3) & 3, r & 7); continue; } r -= nE;
                    if (r < nF) { gdn_naive(C, l, NB + (r >> 5), (r >> 3) & 3, r & 7); continue; } r -= nF;
                    if (r < nG) { moba_naive(C, l, MP + (r >> 2), r & 3, wl); continue; } r -= nG;
                    moba_naive(C, l, r >> 2, r & 3, wl); } }
        #endif
    PH_END
        PH_BEGIN
#if !defined(SKIP_PH5)
            for (int m = C.gw; m < MR; m += C.NGW) post_row(C, l, m);
        #endif
    PH_END
        PH_BEGIN
#if !defined(SKIP_PH6)
            int kbw = BW; asm volatile("" : "+s"(kbw));
            { pg8::Gemm g{ybuf(C, 0), wptr(C, l, WO_WBR), MPAD, D, kbw}; pg8::StaticOrder S; S.init(MPAD, D, C.G, bid); pg8::EpiGate<0> E{gatep(C), m32p(C), mrgp(C)};
              pg8::gemm_phase<pg8::EpiGate<0>, pg8::StaticOrder>(ring, g, S, E, nullptr); }
            { pg8::Gemm g{ybuf(C, 1), wptr(C, l, WO_WBR) + (size_t)1 * D * BW, MPAD, D, kbw}; pg8::StaticOrder S; S.init(MPAD, D, C.G, bid); pg8::EpiGate<1> E{gatep(C) + 1 * D, m32p(C), mrgp(C)};
              pg8::gemm_phase<pg8::EpiGate<1>, pg8::StaticOrder>(ring, g, S, E, nullptr); }
            { pg8::Gemm g{ybuf(C, 2), wptr(C, l, WO_WBR) + (size_t)2 * D * BW, MPAD, D, kbw}; pg8::StaticOrder S; S.init(MPAD, D, C.G, bid); pg8::EpiGate<1> E{gatep(C) + 2 * D, m32p(C), mrgp(C)};
              pg8::gemm_phase<pg8::EpiGate<1>, pg8::StaticOrder>(ring, g, S, E, nullptr); }
            { pg8::Gemm g{ybuf(C, 3), wptr(C, l, WO_WBR) + (size_t)3 * D * BW, MPAD, D, kbw}; pg8::StaticOrder S; S.init(MPAD, D, C.G, bid); pg8::EpiGate<2> E{gatep(C) + 3 * D, m32p(C), mrgp(C)};
              pg8::gemm_phase<pg8::EpiGate<2>, pg8::StaticOrder>(ring, g, S, E, nullptr); }
        #endif
    PH_END
        PH_BEGIN
#if !defined(SKIP_PH7)
            { const float* xin_p = (l == 0) ? inF(C, 0) : X2p(C); const float* xin_s = (l == 0) ? inF(C, 1) : X2p(C) + (size_t)MP * D;
              pg8::Gemm g{mrgp(C), wptr(C, l, WO_WOUT), MPAD, D, D}; pg8::StaticOrder S; S.init(MPAD, D, C.G, bid); pg8::EpiRes E{xin_p, xin_s, X1p(C), X1p(C) + (size_t)MP * D, MP, SB};
              pg8::gemm_phase<pg8::EpiRes, pg8::StaticOrder>(ring, g, S, E, nullptr); }
        #endif
    PH_END
        PH_BEGIN
#if !defined(SKIP_PH8)
            norm_rows(C, X1p(C), X1p(C) + (size_t)MP * D, inF(C, 37) + l * D);
        #endif
    PH_END
        PH_BEGIN
#if !defined(SKIP_PH9)
            { pg8::Gemm g{Hp(C), wptr(C, l, WO_FF1), MPAD, DFF, D}; pg8::StaticOrder S; S.init(MPAD, DFF, C.G, bid); pg8::EpiActBf16<1, DFF> E{Zp(C)};
              pg8::gemm_phase<pg8::EpiActBf16<1, DFF>, pg8::StaticOrder>(ring, g, S, E, nullptr); }
        #endif
    PH_END
        PH_BEGIN
#if !defined(SKIP_PH10)
            { float* xout_p = (l == 0) ? X2p(C) : C.out + O_YP; float* xout_s = (l == 0) ? X2p(C) + (size_t)MP * D : C.out + O_YS;
              pg8::Gemm g{Zp(C), wptr(C, l, WO_FF2), MPAD, D, DFF}; pg8::StaticOrder S; S.init(MPAD, D, C.G, bid); pg8::EpiRes E{X1p(C), X1p(C) + (size_t)MP * D, xout_p, xout_s, MP, SB};
              pg8::gemm_phase<pg8::EpiRes, pg8::StaticOrder>(ring, g, S, E, nullptr); }
        #endif
    PH_END
        if (l == 0) {
            PH_BEGIN
#if !defined(SKIP_PH11)
                norm_rows(C, X2p(C), X2p(C) + (size_t)MP * D, inF(C, 10) + D);
#endif
    PH_END
        }
    }
#undef PH_BEGIN
#undef PH_END
}

extern "C" void kernel_launch(void* const* d_in, const int* in_sizes, int n_in, void* d_out, int out_size, void* d_ws, size_t ws_size, hipStream_t stream) {
    static int grid = 0;
    if (grid == 0) {
        if (n_in != 40 || out_size != (int)O_END || ws_size < WS_END) { fprintf(stderr, "kernel_launch: unexpected shapes: n_in %d out %d ws %zu (need %zu)\n", n_in, out_size, ws_size, (size_t)WS_END); grid = -1; return; }
        int dev = 0, cus = 0, per_cu = 0;
        if (hipGetDevice(&dev) != hipSuccess || hipDeviceGetAttribute(&cus, hipDeviceAttributeMultiprocessorCount, dev) != hipSuccess) { grid = -1; return; }
        if (hipFuncSetAttribute((const void*)fwd, hipFuncAttributeMaxDynamicSharedMemorySize, LDS_BYTES) != hipSuccess) { fprintf(stderr, "kernel_launch: hipFuncSetAttribute failed\n"); grid = -1; return; }
        if (hipOccupancyMaxActiveBlocksPerMultiprocessor(&per_cu, (const void*)fwd, 512, LDS_BYTES) != hipSuccess || per_cu < 1) fprintf(stderr, "kernel_launch: occupancy query reports %d\n", per_cu);
        (void)hipGetLastError();
        grid = cus;
    }
    if (grid < 0) return;
    if (hipMemsetAsync((char*)d_ws + WS_CTL, 0, CTL_BYTES, stream) != hipSuccess) return;
    Args a{};
    for (int i = 0; i < 40; ++i) a.in[i] = d_in[i];
    a.out = (float*)d_out; a.ws = (unsigned char*)d_ws; a.pad = 0;
#if MK_ONE_LAUNCH
    a.ph_lo = 0; a.ph_hi = N_PHASES; a.li = 0;
    hipLaunchKernelGGL(fwd, dim3(grid), dim3(512), LDS_BYTES, stream, a);
#else
    for (int p = 0; p < N_PHASES; ++p) { a.ph_lo = p; a.ph_hi = p + 1; a.li = p; hipLaunchKernelGGL(fwd, dim3(grid), dim3(512), LDS_BYTES, stream, a); }
#endif
}
```

```cpp
#include <hip/hip_runtime.h>
#include <cstdio>
#include <cstdint>
namespace pg8 {
#define PG8_LAS __attribute__((address_space(3)))
typedef unsigned short bf16_t;
typedef short bf16x8 __attribute__((ext_vector_type(8)));
typedef float f32x4 __attribute__((ext_vector_type(4)));
typedef unsigned u32x4 __attribute__((ext_vector_type(4)));
constexpr int BM = 256, BK = 64, HALF = 128, HTB = HALF * BK * 2  , STAGE_BYTES = 8 * HTB, NXCD = 8, WGM = 8;

__host__ __device__ __forceinline__ int lds_byte(int r, int c) { const int st = (r >> 4) * 2 + (c >> 5), rr = r & 15, cc = c & 31, ob = rr * 64 + cc * 2; return st * 1024 + (ob ^ (((ob >> 9) & 1) << 5)); }
__host__ __device__ __forceinline__ void stage_rc(int b, int& R, int& C) { const int st = b / 1024, sb = b % 1024, swz = sb ^ (((sb >> 9) & 1) << 5); R = (st >> 1) * 16 + swz / 64; C = (st & 1) * 32 + (swz % 64) / 2; }
__host__ __device__ __forceinline__ int perm32(int rho) { const int n = rho >> 4, i = rho & 15; return 8 * (i >> 2) + 4 * n + (i & 3); }

struct Unit { int pm, pn; };
struct Gemm { const bf16_t* A; const bf16_t* Bt; int M, N, K; };

struct StaticOrder {
    int nM, nN, nwg, G, c;
    __host__ __device__ void init(int M, int N, int G_, int c_) { nM = M / BM; nN = N / BM; nwg = nM * nN; G = G_; c = c_; }
    __host__ __device__ bool next(int i, Unit& u) const {
        const long L = (long)i * G + c; if (L >= nwg) return false;
        int wgid = (int)L; { const int q = nwg / NXCD, r = nwg % NXCD, xcd = wgid % NXCD, off = wgid / NXCD; wgid = (xcd < r ? xcd * (q + 1) : r * (q + 1) + (xcd - r) * q) + off; }
        const int nig = WGM * nN, gid = wgid / nig, fm = gid * WGM, gsz = (nM - fm) < WGM ? (nM - fm) : WGM;
        u.pm = fm + ((wgid % nig) % gsz); u.pn = (wgid % nig) / gsz; return true;
    }
    __device__ __forceinline__ void a_ready(const Unit&) const {}
    __device__ __forceinline__ void done(const Unit&) const {}
};
struct CountedOrder : StaticOrder {
    const unsigned* ready; unsigned need; unsigned* tmo;
    __device__ __forceinline__ void a_ready(const Unit& u) const {
        if (threadIdx.x < 64) {
            const unsigned long long t0 = __builtin_amdgcn_s_memrealtime(); unsigned polls = 0;
            while ((unsigned)__builtin_amdgcn_readfirstlane(__hip_atomic_load(ready + 64 * u.pm, __ATOMIC_RELAXED, __HIP_MEMORY_SCOPE_AGENT)) < need) {
                if ((++polls & 255u) == 0u && __builtin_amdgcn_readfirstlane(__hip_atomic_load(tmo, __ATOMIC_RELAXED, __HIP_MEMORY_SCOPE_AGENT)) != 0u) break;
                if (__builtin_amdgcn_s_memrealtime() - t0 > 2000000ull) {
                    if (threadIdx.x == 0) { unsigned expect = 0u; __hip_atomic_compare_exchange_strong(tmo + 1, &expect, 0x600u | (unsigned)(u.pm & 0xff), __ATOMIC_RELAXED, __ATOMIC_RELAXED, __HIP_MEMORY_SCOPE_AGENT); __hip_atomic_store(tmo, 1u, __ATOMIC_RELAXED, __HIP_MEMORY_SCOPE_AGENT); }
                    break; }
                __builtin_amdgcn_s_sleep(2); }
            __builtin_amdgcn_fence(__ATOMIC_ACQUIRE, "agent");
            asm volatile("s_waitcnt vmcnt(0)" ::: "memory");
        }
#if !defined(BROKEN_HOOK_NO_BARRIER)
        asm volatile("" ::: "memory"); __builtin_amdgcn_s_barrier(); asm volatile("" ::: "memory");
#endif
    }
};

__device__ __forceinline__ unsigned cvt_pk_bf16(float lo, float hi) { unsigned r; asm volatile("v_cvt_pk_bf16_f32 %0, %1, %2" : "=v"(r) : "v"(lo), "v"(hi)); return r; }
typedef float f32x2 __attribute__((ext_vector_type(2)));
__device__ __forceinline__ f32x2 gelu_pk(f32x2 v) {
    const f32x2 av = __builtin_elementwise_abs(v), d = av * 0.2316418882f + 1.0f;
    f32x2 t; t.x = __builtin_amdgcn_rcpf(d.x); t.y = __builtin_amdgcn_rcpf(d.y);
    f32x2 q = t * 0.5307027145f + (-0.7265760135f); q = q * t + 0.7107068705f; q = q * t + (-0.142248368f); q = q * t + 0.127414796f; q = q * t;
    const f32x2 s = (v * v) * (-0.72134752044f);
    f32x2 e; e.x = __builtin_amdgcn_exp2f(s.x); e.y = __builtin_amdgcn_exp2f(s.y);
    const f32x2 m = v * (q * e), r = v - m;
    f32x2 o; o.x = v.x < 0.f ? m.x : r.x; o.y = v.y < 0.f ? m.y : r.y; return o;
}

struct EpiF32 {
    static constexpr bool PERM = false, AFTER_DRAIN = false;
    float* C; int ldc; const float* bias;
    __device__ __forceinline__ void operator()(const f32x4 (&acc)[2][2][4][2], const Unit& u, int wr, int wc, int fr, int fq) const {
        const int row0 = u.pm * BM + wr * 64 + fr, col0 = u.pn * BM + wc * 32 + 4 * fq;
        f32x4 bv[2][2];
#pragma unroll
        for (int bj = 0; bj < 2; ++bj)
#pragma unroll
            for (int n = 0; n < 2; ++n) bv[bj][n] = bias ? *(const f32x4*)(bias + col0 + bj * HALF + n * 16) : (f32x4){0.f, 0.f, 0.f, 0.f};
#pragma unroll
        for (int ai = 0; ai < 2; ++ai)
#pragma unroll
            for (int m = 0; m < 4; ++m) { float* rowp = C + (size_t)(row0 + ai * HALF + m * 16) * ldc + col0;
#pragma unroll
                for (int bj = 0; bj < 2; ++bj)
#pragma unroll
                    for (int n = 0; n < 2; ++n) *(f32x4*)(rowp + bj * HALF + n * 16) = acc[ai][bj][m][n] + bv[bj][n]; }
    }
};
template <int ACT  > struct EpiBf16 {
    static constexpr bool PERM = true, AFTER_DRAIN = false;
    bf16_t* O; int ldc; const float* bias; int split_cols; size_t split_stride;
    __device__ __forceinline__ void operator()(const f32x4 (&acc)[2][2][4][2], const Unit& u, int wr, int wc, int fr, int fq) const {
        const int row0 = u.pm * BM + wr * 64 + fr; int colt = u.pn * BM; bf16_t* base = O;
        if (split_cols) { const int t = colt / split_cols; base += (size_t)t * split_stride; colt -= t * split_cols; }
        const int col0 = colt + wc * 32 + 8 * fq, bcol0 = u.pn * BM + wc * 32 + 8 * fq;
        f32x4 bv[2][2];
#pragma unroll
        for (int bj = 0; bj < 2; ++bj)
#pragma unroll
            for (int n = 0; n < 2; ++n) bv[bj][n] = bias ? *(const f32x4*)(bias + bcol0 + bj * HALF + 4 * n) : (f32x4){0.f, 0.f, 0.f, 0.f};
#pragma unroll
        for (int ai = 0; ai < 2; ++ai)
#pragma unroll
            for (int m = 0; m < 4; ++m) { bf16_t* rowp = base + (size_t)(row0 + ai * HALF + m * 16) * ldc + col0;
#pragma unroll
                for (int bj = 0; bj < 2; ++bj) { f32x4 v0 = acc[ai][bj][m][0] + bv[bj][0], v1 = acc[ai][bj][m][1] + bv[bj][1];
                    if (ACT == 1) { f32x2 a = gelu_pk((f32x2){v0[0], v0[1]}), b = gelu_pk((f32x2){v0[2], v0[3]}), c = gelu_pk((f32x2){v1[0], v1[1]}), d = gelu_pk((f32x2){v1[2], v1[3]});
                        v0 = (f32x4){a.x, a.y, b.x, b.y}; v1 = (f32x4){c.x, c.y, d.x, d.y}; }
                    if (ACT == 2) {
#pragma unroll
                        for (int j = 0; j < 4; ++j) { v0[j] = 0.5f * v0[j] * (1.0f + erff(v0[j] * 0.70710678f)); v1[j] = 0.5f * v1[j] * (1.0f + erff(v1[j] * 0.70710678f)); } }
                    u32x4 w; w.x = cvt_pk_bf16(v0[0], v0[1]); w.y = cvt_pk_bf16(v0[2], v0[3]); w.z = cvt_pk_bf16(v1[0], v1[1]); w.w = cvt_pk_bf16(v1[2], v1[3]);
                    *(u32x4*)(rowp + bj * HALF) = w; } }
    }
};

struct PanelStats {
    unsigned* xbuf;
    unsigned* cnt;
    unsigned* tmo;
    int ntn; float eps;
    unsigned code;
    __device__ __forceinline__ bool run(const f32x4 (&v)[2][2][4][2], const Unit& u, int wr, int wc, int fr, int fq, PG8_LAS unsigned char* lds, int wid, int lane) const {
        typedef float f32x2v __attribute__((ext_vector_type(2)));
        PG8_LAS f32x2v* P = (PG8_LAS f32x2v*)lds;
        PG8_LAS f32x2v* S = (PG8_LAS f32x2v*)(lds + 8192);
        PG8_LAS unsigned* flag = (PG8_LAS unsigned*)(lds + 8192 + 2048);
#pragma unroll
        for (int ai = 0; ai < 2; ++ai)
#pragma unroll
            for (int m = 0; m < 4; ++m) {
                float s = 0.f;
#pragma unroll
                for (int bj = 0; bj < 2; ++bj)
#pragma unroll
                    for (int n = 0; n < 2; ++n) { const f32x4 x = v[ai][bj][m][n]; s += (x[0] + x[1]) + (x[2] + x[3]); }
                s += __shfl_xor(s, 16); s += __shfl_xor(s, 32);
                const float mw = s * (1.0f / 64.0f); float q = 0.f;
#pragma unroll
                for (int bj = 0; bj < 2; ++bj)
#pragma unroll
                    for (int n = 0; n < 2; ++n) { const f32x4 d = v[ai][bj][m][n] - mw; q += (d[0] * d[0] + d[1] * d[1]) + (d[2] * d[2] + d[3] * d[3]); }
                q += __shfl_xor(q, 16); q += __shfl_xor(q, 32);
                if (fq == 0) P[(ai * HALF + wr * 64 + m * 16 + fr) * 4 + wc] = (f32x2v){mw, q};
            }
        asm volatile("s_waitcnt lgkmcnt(0)" ::: "memory"); __builtin_amdgcn_s_barrier(); asm volatile("" ::: "memory");
#if defined(BROKEN_NO_WAIT)
        if (blockIdx.x >= 64) { const long long t0 = clock64(); while (clock64() - t0 < 60000) __builtin_amdgcn_s_sleep(8); }
#endif
        const int row = wid * 32 + (lane & 31);
        if (lane < 32) {
            const f32x2v a = P[row * 4 + 0], b = P[row * 4 + 1], c = P[row * 4 + 2], d = P[row * 4 + 3];
            const float mt = (a.x + b.x + c.x + d.x) * 0.25f;
            const float da = a.x - mt, db = b.x - mt, dc = c.x - mt, dd = d.x - mt;
            const float m2 = (a.y + b.y) + (c.y + d.y) + 64.0f * ((da * da + db * db) + (dc * dc + dd * dd));
            unsigned long long* slot = (unsigned long long*)xbuf + ((size_t)(u.pm * BM + row) * 4 + u.pn);
            __hip_atomic_store(slot, ((unsigned long long)__float_as_uint(m2) << 32) | __float_as_uint(mt), __ATOMIC_RELAXED, __HIP_MEMORY_SCOPE_AGENT);
        }
        asm volatile("s_waitcnt vmcnt(0)" ::: "memory");
        if (lane == 0) __hip_atomic_fetch_add(cnt + 64 * u.pm, 1u, __ATOMIC_RELAXED, __HIP_MEMORY_SCOPE_AGENT);
        if (wid == 0) {
            bool dead = false; const unsigned long long t0 = __builtin_amdgcn_s_memrealtime(); const unsigned want = 8u * (unsigned)ntn;
            for (;;) {
#if defined(BROKEN_NO_WAIT)
                break;
#endif
                if ((unsigned)__builtin_amdgcn_readfirstlane(__hip_atomic_load(cnt + 64 * u.pm, __ATOMIC_RELAXED, __HIP_MEMORY_SCOPE_AGENT)) >= want) break;
                if (__builtin_amdgcn_s_memrealtime() - t0 > 2000000ull) {
                    if (lane == 0) { unsigned expect = 0u; __hip_atomic_compare_exchange_strong(tmo + 1, &expect, code | (unsigned)(u.pm & 0xff), __ATOMIC_RELAXED, __ATOMIC_RELAXED, __HIP_MEMORY_SCOPE_AGENT);
                                     __hip_atomic_store(tmo, 1u, __ATOMIC_RELAXED, __HIP_MEMORY_SCOPE_AGENT); }
                    dead = true; break; }
                __builtin_amdgcn_s_sleep(2);
            }
            __builtin_amdgcn_fence(__ATOMIC_ACQUIRE, "agent");
            if (lane == 0) flag[0] = dead ? 1u : 0u;
        }
        asm volatile("s_waitcnt vmcnt(0) lgkmcnt(0)" ::: "memory"); __builtin_amdgcn_s_barrier(); asm volatile("" ::: "memory");
        const bool bad = flag[0] != 0u;
        if (lane < 32) {
            const unsigned long long* slot = (const unsigned long long*)xbuf + (size_t)(u.pm * BM + row) * 4; float mt[4], m2[4]; float ms = 0.f;
#pragma unroll
            for (int t = 0; t < 4; ++t) { if (t < ntn) { const unsigned long long w = __hip_atomic_load(slot + t, __ATOMIC_RELAXED, __HIP_MEMORY_SCOPE_AGENT); mt[t] = __uint_as_float((unsigned)w); m2[t] = __uint_as_float((unsigned)(w >> 32)); } else { mt[t] = 0.f; m2[t] = 0.f; } ms += mt[t]; }
            const float mean = ms / (float)ntn; float q = 0.f;
#pragma unroll
            for (int t = 0; t < 4; ++t) if (t < ntn) { const float dm = mt[t] - mean; q += m2[t] + 256.0f * dm * dm; }
            S[row] = (f32x2v){mean, 1.0f / sqrtf(q / (256.0f * (float)ntn) + eps)};
        }
        asm volatile("s_waitcnt lgkmcnt(0)" ::: "memory"); __builtin_amdgcn_s_barrier(); asm volatile("" ::: "memory");
        return bad;
    }
};
struct EpiLnRes {
    static constexpr bool PERM = false, AFTER_DRAIN = true;
    const float* base; float* out; int ldc; const float* bias; PanelStats st; unsigned poison;
    __device__ __forceinline__ void refuse(size_t i0, size_t stride, int M, int N) const { const float q = __builtin_nanf(""); for (size_t i = i0; i < (size_t)M * N; i += stride) out[(i / N) * ldc + i % N] = q;
        if (i0 == 0) { unsigned expect = 0u; __hip_atomic_compare_exchange_strong(st.tmo + 1, &expect, 0x7f0u, __ATOMIC_RELAXED, __ATOMIC_RELAXED, __HIP_MEMORY_SCOPE_AGENT); __hip_atomic_store(st.tmo, 1u, __ATOMIC_RELAXED, __HIP_MEMORY_SCOPE_AGENT); } }
    __device__ __forceinline__ void fused(f32x4 (&acc)[2][2][4][2], const Unit& u, int wr, int wc, int fr, int fq, PG8_LAS unsigned char* lds, int wid, int lane) const {
        typedef float f32x2v __attribute__((ext_vector_type(2)));
        const PG8_LAS f32x2v* S = (const PG8_LAS f32x2v*)(lds + 8192);
        const int col0 = u.pn * BM + wc * 32 + 4 * fq;
#pragma unroll
        for (int bj = 0; bj < 2; ++bj)
#pragma unroll
            for (int n = 0; n < 2; ++n) { const f32x4 bv = bias ? *(const f32x4*)(bias + col0 + bj * HALF + n * 16) : (f32x4){0.f, 0.f, 0.f, 0.f};
#pragma unroll
                for (int ai = 0; ai < 2; ++ai)
#pragma unroll
                    for (int m = 0; m < 4; ++m) acc[ai][bj][m][n] += bv; }
        const bool bad = st.run(acc, u, wr, wc, fr, fq, lds, wid, lane) || poison != 0u;
        const float qnan = __builtin_nanf("");
#pragma unroll
        for (int ai = 0; ai < 2; ++ai)
#pragma unroll
            for (int m = 0; m < 4; ++m) { const int r = ai * HALF + wr * 64 + m * 16 + fr; const f32x2v sr = S[r]; const size_t off = (size_t)(u.pm * BM + r) * ldc + col0;
#pragma unroll
                for (int bj = 0; bj < 2; ++bj)
#pragma unroll
                    for (int n = 0; n < 2; ++n) { const f32x4 bs = *(const f32x4*)(base + off + bj * HALF + n * 16); f32x4 o = bs + (acc[ai][bj][m][n] - sr.x) * sr.y;
                        if (bad) o = (f32x4){qnan, qnan, qnan, qnan}; *(f32x4*)(out + off + bj * HALF + n * 16) = o; }
                asm volatile("" ::: "memory"); }
    }
};
struct EpiLnResLn {
    static constexpr bool PERM = false, AFTER_DRAIN = true;
    const float* base; float* out; bf16_t* xn; int ldc; const float* bias; PanelStats st1, st2; unsigned poison;
    __device__ __forceinline__ void refuse(size_t i0, size_t stride, int M, int N) const { const float q = __builtin_nanf(""); for (size_t i = i0; i < (size_t)M * N; i += stride) { const size_t o = (i / N) * ldc + i % N; out[o] = q; xn[o] = (bf16_t)0x7fc0u; }
        if (i0 == 0) { unsigned expect = 0u; __hip_atomic_compare_exchange_strong(st1.tmo + 1, &expect, 0x7f0u, __ATOMIC_RELAXED, __ATOMIC_RELAXED, __HIP_MEMORY_SCOPE_AGENT); __hip_atomic_store(st1.tmo, 1u, __ATOMIC_RELAXED, __HIP_MEMORY_SCOPE_AGENT); } }
    __device__ __forceinline__ void fused(f32x4 (&acc)[2][2][4][2], const Unit& u, int wr, int wc, int fr, int fq, PG8_LAS unsigned char* lds, int wid, int lane) const {
        typedef float f32x2v __attribute__((ext_vector_type(2))); typedef unsigned u32x2v __attribute__((ext_vector_type(2)));
        const PG8_LAS f32x2v* S = (const PG8_LAS f32x2v*)(lds + 8192);
        const int col0 = u.pn * BM + wc * 32 + 4 * fq;
#pragma unroll
        for (int bj = 0; bj < 2; ++bj)
#pragma unroll
            for (int n = 0; n < 2; ++n) { const f32x4 bv = bias ? *(const f32x4*)(bias + col0 + bj * HALF + n * 16) : (f32x4){0.f, 0.f, 0.f, 0.f};
#pragma unroll
                for (int ai = 0; ai < 2; ++ai)
#pragma unroll
                    for (int m = 0; m < 4; ++m) acc[ai][bj][m][n] += bv; }
        bool bad = st1.run(acc, u, wr, wc, fr, fq, lds, wid, lane) || poison != 0u;
        const float qnan = __builtin_nanf("");
#pragma unroll
        for (int ai = 0; ai < 2; ++ai)
#pragma unroll
            for (int m = 0; m < 4; ++m) { const int r = ai * HALF + wr * 64 + m * 16 + fr; const f32x2v sr = S[r]; const size_t off = (size_t)(u.pm * BM + r) * ldc + col0;
#pragma unroll
                for (int bj = 0; bj < 2; ++bj)
#pragma unroll
                    for (int n = 0; n < 2; ++n) { const f32x4 bs = *(const f32x4*)(base + off + bj * HALF + n * 16); acc[ai][bj][m][n] = bs + (acc[ai][bj][m][n] - sr.x) * sr.y; }
                asm volatile("" : "+v"(acc[ai][0][m][0]), "+v"(acc[ai][0][m][1]), "+v"(acc[ai][1][m][0]), "+v"(acc[ai][1][m][1]));
                if (m & 1) asm volatile("" ::: "memory"); }
        const bool bad1 = bad;
        bad = st2.run(acc, u, wr, wc, fr, fq, lds, wid, lane) || bad;
#pragma unroll
        for (int ai = 0; ai < 2; ++ai)
#pragma unroll
            for (int m = 0; m < 4; ++m) { const int r = ai * HALF + wr * 64 + m * 16 + fr; const f32x2v sr = S[r]; const size_t off = (size_t)(u.pm * BM + r) * ldc + col0;
#pragma unroll
                for (int bj = 0; bj < 2; ++bj)
#pragma unroll
                    for (int n = 0; n < 2; ++n) { const f32x4 x1 = acc[ai][bj][m][n]; *(f32x4*)(out + off + bj * HALF + n * 16) = bad1 ? (f32x4){qnan, qnan, qnan, qnan} : x1;
                        const f32x4 o = (x1 - sr.x) * sr.y; u32x2v w; w.x = cvt_pk_bf16(o[0], o[1]); w.y = cvt_pk_bf16(o[2], o[3]);
                        if (bad) { w.x = 0x7fc07fc0u; w.y = 0x7fc07fc0u; } *(u32x2v*)(xn + off + bj * HALF + n * 16) = w; }
                asm volatile("" ::: "memory"); }
    }
};

template <class Epi, class Sched, bool STAMP = false>
__device__ __forceinline__ void gemm_phase(PG8_LAS unsigned char* lds, const Gemm g, const Sched& S, const Epi& E, unsigned long long* stamps) {
    int tid_o = threadIdx.x; asm volatile("" : "+v"(tid_o));
    const int tid = tid_o, wid = __builtin_amdgcn_readfirstlane(tid >> 6), lane = tid & 63, wr = wid >> 2, wc = wid & 3, fr = lane & 15, fq = lane >> 4;
    const int K = g.K, nt = K / BK;
    int ts_lo = 0, ts_hi = 0, nts = 0; const unsigned long long rt_entry = STAMP ? (unsigned long long)wall_clock64() : 0ull;
#define PG8_STAMP() do { if (STAMP && wid == 0 && nts < 64) { const unsigned long long _c = (unsigned long long)clock64(); \
        ts_lo = (lane == nts) ? (int)(unsigned)_c : ts_lo; ts_hi = (lane == nts) ? (int)(unsigned)(_c >> 32) : ts_hi; ++nts; } } while (0)
    PG8_STAMP();
    unsigned voffA[2], voffB[2];
#pragma unroll
    for (int i = 0; i < 2; ++i) { int R, C; stage_rc(tid * 16 + i * 8192, R, C); const int Rb = Epi::PERM ? ((R & ~31) + perm32(R & 31)) : R;
        voffA[i] = (unsigned)(R * K + C) * 2u; voffB[i] = (unsigned)(Rb * K + C) * 2u; }
    const size_t kstep = (size_t)(BK * 2);
    const size_t hstep = (size_t)HALF * K * 2;
    const size_t tstep = 2 * hstep;
    const unsigned ldsw = (unsigned)wid * 1024u;
    const int aoff = lds_byte(wr * 64 + fr, fq * 8), boff = lds_byte(wc * 32 + fr, fq * 8);
#define PG8_SA(b, h) (((b) * 2 + (h)) * HTB)
#define PG8_SB(b, h) ((4 + (b) * 2 + (h)) * HTB)
#define PG8_STAGE(bufoff, gbase, voff) do { _Pragma("unroll") for (int _i = 0; _i < 2; ++_i) \
        __builtin_amdgcn_global_load_lds((const unsigned*)((const char*)(gbase) + (voff)[_i]), (PG8_LAS unsigned*)(lds + (bufoff) + ldsw + _i * 8192), 16, 0, 0); } while (0)
#define PG8_LDA(dst, b, h) do { _Pragma("unroll") for (int m = 0; m < 4; ++m) _Pragma("unroll") for (int k = 0; k < 2; ++k) dst[m][k] = *(const PG8_LAS bf16x8*)(lds + PG8_SA(b, h) + aoff + m * 2048 + k * 1024); } while (0)
#define PG8_LDB(dst, b, h) do { _Pragma("unroll") for (int n = 0; n < 2; ++n) _Pragma("unroll") for (int k = 0; k < 2; ++k) dst[n][k] = *(const PG8_LAS bf16x8*)(lds + PG8_SB(b, h) + boff + n * 2048 + k * 1024); } while (0)
#define PG8_MMA(ai, bj, At, Bt) do { __builtin_amdgcn_s_setprio(1); _Pragma("unroll") for (int m = 0; m < 4; ++m) _Pragma("unroll") for (int n = 0; n < 2; ++n) _Pragma("unroll") for (int k = 0; k < 2; ++k) \
        acc[ai][bj][m][n] = __builtin_amdgcn_mfma_f32_16x16x32_bf16(Bt[n][k], At[m][k], acc[ai][bj][m][n], 0, 0, 0); __builtin_amdgcn_s_setprio(0); } while (0)
#define PG8_WAIT_V(n) asm volatile("s_waitcnt vmcnt(" #n ")" ::: "memory")
#define PG8_WAIT_L(n) asm volatile("s_waitcnt lgkmcnt(" #n ")" ::: "memory")
#define PG8_BAR __builtin_amdgcn_s_barrier()
#define PG8_SCHED __builtin_amdgcn_sched_barrier(0)
    Unit cur, nxt; int ui = 0;
    if (!S.next(0, cur)) return;
    f32x4 acc[2][2][4][2];
#pragma unroll
    for (int a = 0; a < 2; ++a)
#pragma unroll
        for (int b = 0; b < 2; ++b)
#pragma unroll
            for (int m = 0; m < 4; ++m)
#pragma unroll
                for (int n = 0; n < 2; ++n) acc[a][b][m][n] = (f32x4){0.f, 0.f, 0.f, 0.f};
    bf16x8 At[4][2], B0[2][2], B1[2][2];
    const char* cA = (const char*)g.A + (size_t)cur.pm * tstep; const char* cB = (const char*)g.Bt + (size_t)cur.pn * tstep;
    S.a_ready(cur);
    PG8_STAGE(PG8_SB(0, 0), cB, voffB); PG8_STAGE(PG8_SA(0, 0), cA, voffA); PG8_STAGE(PG8_SB(0, 1), cB + hstep, voffB); PG8_STAGE(PG8_SA(0, 1), cA + hstep, voffA);
    if (wr == 1) PG8_BAR;
    PG8_WAIT_V(4); PG8_BAR;
    PG8_STAGE(PG8_SB(1, 0), cB + kstep, voffB); PG8_STAGE(PG8_SA(1, 0), cA + kstep, voffA); PG8_STAGE(PG8_SB(1, 1), cB + hstep + kstep, voffB);
    PG8_WAIT_V(6); PG8_BAR;
    PG8_STAMP();
    for (;;) {
        const bool has_next = S.next(ui + 1, nxt);
        const char* nA = has_next ? (const char*)g.A + (size_t)nxt.pm * tstep : cA; const char* nB = has_next ? (const char*)g.Bt + (size_t)nxt.pn * tstep : cB;
        for (int t = 0; t < nt; t += 2) {
            const bool last = (t == nt - 2);
            const char* a1 = cA + (size_t)(t + 1) * kstep;
            const char* a2 = last ? nA : cA + (size_t)(t + 2) * kstep; const char* b2 = last ? nB : cB + (size_t)(t + 2) * kstep;
            const char* a3 = a2 + kstep; const char* b3 = b2 + kstep;
            if (last && has_next) S.a_ready(nxt);
            PG8_LDB(B0, 0, 0); PG8_SCHED; PG8_LDA(At, 0, 0); PG8_STAGE(PG8_SA(1, 1), a1 + hstep, voffA);
            PG8_WAIT_L(8); PG8_BAR; PG8_WAIT_L(0); PG8_MMA(0, 0, At, B0); PG8_BAR; PG8_SCHED;
            PG8_LDB(B1, 0, 1); PG8_STAGE(PG8_SB(0, 0), b2, voffB);
            PG8_BAR; PG8_WAIT_L(0); PG8_MMA(0, 1, At, B1); PG8_BAR;
            PG8_LDA(At, 0, 1); PG8_STAGE(PG8_SA(0, 0), a2, voffA);
            PG8_BAR; PG8_WAIT_L(0); PG8_MMA(1, 0, At, B0); PG8_BAR; PG8_SCHED;
            PG8_STAGE(PG8_SB(0, 1), b2 + hstep, voffB);
            PG8_WAIT_V(6); PG8_BAR; PG8_MMA(1, 1, At, B1); PG8_BAR;
            PG8_LDB(B0, 1, 0); PG8_SCHED; PG8_LDA(At, 1, 0); PG8_STAGE(PG8_SA(0, 1), a2 + hstep, voffA);
            PG8_WAIT_L(8); PG8_BAR; PG8_WAIT_L(0); PG8_MMA(0, 0, At, B0); PG8_BAR; PG8_SCHED;
            PG8_LDB(B1, 1, 1); PG8_STAGE(PG8_SB(1, 0), b3, voffB);
            PG8_BAR; PG8_WAIT_L(0); PG8_MMA(0, 1, At, B1); PG8_BAR;
            PG8_LDA(At, 1, 1); PG8_STAGE(PG8_SA(1, 0), a3, voffA);
            PG8_BAR; PG8_WAIT_L(0); PG8_MMA(1, 0, At, B0); PG8_BAR; PG8_SCHED;
            PG8_STAGE(PG8_SB(1, 1), b3 + hstep, voffB);
            PG8_WAIT_V(6); PG8_BAR; PG8_MMA(1, 1, At, B1); PG8_BAR;
        }
        PG8_STAMP();
        if constexpr (!Epi::AFTER_DRAIN) { E(acc, cur, wr, wc, fr, fq); S.done(cur); }
        PG8_STAMP();
        if (!has_next) break;
#pragma unroll
        for (int a = 0; a < 2; ++a)
#pragma unroll
            for (int b = 0; b < 2; ++b)
#pragma unroll
                for (int m = 0; m < 4; ++m)
#pragma unroll
                    for (int n = 0; n < 2; ++n) acc[a][b][m][n] = (f32x4){0.f, 0.f, 0.f, 0.f};
        cur = nxt; cA = nA; cB = nB; ++ui;
    }
    PG8_WAIT_V(0);
    if (wr == 0) PG8_BAR;
    PG8_BAR;
    if constexpr (Epi::AFTER_DRAIN) { E.fused(acc, cur, wr, wc, fr, fq, lds, wid, lane); S.done(cur); }
    PG8_STAMP();
    if (STAMP && wid == 0) { stamps[lane] = lane < nts ? (((unsigned long long)(unsigned)ts_hi << 32) | (unsigned)ts_lo) : 0ull;
        if (lane == 62) stamps[62] = rt_entry; if (lane == 63) stamps[63] = (unsigned long long)wall_clock64(); }
#undef PG8_STAMP
#undef PG8_SA
#undef PG8_SB
#undef PG8_STAGE
#undef PG8_LDA
#undef PG8_LDB
#undef PG8_MMA
#undef PG8_WAIT_V
#undef PG8_WAIT_L
#undef PG8_BAR
#undef PG8_SCHED
}
}
#define XB_TMO      128
#define XB_XCNT(j)  (256  + 64 * (j))
#define XB_XSUB(j)  (1280 + 64 * (j))
#define XB_XGEN(j)  (2304 + 64 * (j))
#define XB_TOP      3328
#define XB_TOPGEN   3392
#define XCD_BAR_WORDS 3456
#define XB_SPIN_CAP (1u << 22)
#define LAS __attribute__((address_space(3)))

__device__ __forceinline__ unsigned xb_ld(unsigned* p)              { return __hip_atomic_load(p, __ATOMIC_RELAXED, __HIP_MEMORY_SCOPE_AGENT); }
__device__ __forceinline__ unsigned xb_add(unsigned* p, unsigned v) { return __hip_atomic_fetch_add(p, v, __ATOMIC_RELAXED, __HIP_MEMORY_SCOPE_AGENT); }
__device__ __forceinline__ unsigned xb_xcc_id() { return (unsigned)__builtin_amdgcn_s_getreg((3 << 11) | 20) & 0xFu; }
#define XB_SPIN(cond, bar) do { unsigned _sp = 0; while (cond) { __builtin_amdgcn_s_sleep(1); \
    if ((++_sp & 255u) == 0u) { if (xb_ld(&(bar)[XB_TMO])) break; if (_sp > XB_SPIN_CAP) { atomicAdd(&(bar)[XB_TMO], 1u); break; } } } } while (0)

struct XcdBarrier {
    unsigned* bar; unsigned x;
    volatile LAS unsigned* st;
};

__device__ __forceinline__ XcdBarrier xcd_barrier_post(unsigned* bar, volatile LAS unsigned* st) {
    XcdBarrier b; b.bar = bar; b.x = xb_xcc_id(); b.st = st;
    if (threadIdx.x == 0) (void)xb_add(&bar[XB_XCNT(b.x)], 1u);
    return b;
}
__device__ __forceinline__ void xcd_barrier_complete(unsigned* bar, unsigned x, unsigned& nloc, unsigned& nx) {
    const unsigned G = gridDim.x * gridDim.y * gridDim.z;
    unsigned sum, cnt, mine, sp = 0u;
    for (;;) {
        sum = 0u; cnt = 0u; mine = 0u;
#pragma unroll
        for (unsigned j = 0; j < 16; ++j) { const unsigned c = xb_ld(&bar[XB_XCNT(j)]); sum += c; cnt += (c > 0u) ? 1u : 0u; mine = (j == x) ? c : mine; }
        if (sum == G) break;
        __builtin_amdgcn_s_sleep(1);
        if ((++sp & 255u) == 0u) { if (xb_ld(&bar[XB_TMO])) break; if (sp > XB_SPIN_CAP) { atomicAdd(&bar[XB_TMO], 1u); break; } }
    }
    nloc = mine > 0u ? mine : 1u; nx = cnt > 0u ? cnt : 1u;
}

__device__ __forceinline__ void xcd_barrier(const XcdBarrier& b) {
    asm volatile("s_waitcnt vmcnt(0)" ::: "memory");
    __syncthreads();
    if (threadIdx.x == 0) {
        unsigned* bar = b.bar;
        __builtin_amdgcn_s_waitcnt(0);
        unsigned nloc = b.st[0], nx = b.st[1];
        if (nloc == 0u) { xcd_barrier_complete(bar, b.x, nloc, nx); b.st[0] = nloc; b.st[1] = nx; }
        const unsigned old = xb_add(&bar[XB_XSUB(b.x)], 1u);
        const unsigned gen = old / nloc;
        if (old + 1u == (gen + 1u) * nloc) {
            __builtin_amdgcn_fence(__ATOMIC_RELEASE, "agent");
            asm volatile("s_waitcnt vmcnt(0)" ::: "memory");
            const unsigned og = xb_add(&bar[XB_TOP], 1u);
            const unsigned tg = og / nx;
            if (og + 1u == (tg + 1u) * nx) xb_add(&bar[XB_TOPGEN], 1u);
            else XB_SPIN(xb_ld(&bar[XB_TOPGEN]) == tg, bar);
            __builtin_amdgcn_fence(__ATOMIC_ACQUIRE, "agent");
            xb_add(&bar[XB_XGEN(b.x)], 1u);
            asm volatile("s_waitcnt vmcnt(0)" ::: "memory");
        } else {
            XB_SPIN(xb_ld(&bar[XB_XGEN(b.x)]) == gen, bar);
            __builtin_amdgcn_fence(__ATOMIC_ACQUIRE, "agent");
            asm volatile("s_waitcnt vmcnt(0)" ::: "memory");
        }
    }
    __syncthreads();
}

#define DI __device__ __forceinline__
typedef unsigned short bf16;
typedef float f32x4 __attribute__((ext_vector_type(4)));
typedef unsigned u32x4 __attribute__((ext_vector_type(4)));
typedef unsigned u32x2 __attribute__((ext_vector_type(2)));

constexpr int D = 1024, NB = 4, SEQ = 4096, MP = NB * SEQ, SB = 32, MR = MP + SB, MPAD = MP + 256;
constexpr int PAST = 8192, NPOOL = 2560;
constexpr int NP = 3328, DFF = 4096, NGATE = 4096, BW = 256;
constexpr int C_S5U = 0, C_AQ = 256, C_AK = 512, C_AV = 768, C_AR = 1024, C_DQ = 1280, C_DK = 1536, C_DV = 1792, C_DZ = 2048, C_MQ = 2304, C_MK = 2560, C_MV = 2816, C_LR = 3072, C_DB = 3088, C_DA = 3092;
constexpr size_t O_YP = 0, O_YS = O_YP + (size_t)MP * D, O_PMK = O_YS + (size_t)SB * D, O_PMV = O_PMK + (size_t)2 * MP * 256, O_PS5R = O_PMV + (size_t)2 * MP * 256,
                 O_PS5I = O_PS5R + 2 * NB * 1024, O_PGLA = O_PS5I + 2 * NB * 1024, O_PGDN = O_PGLA + 2 * NB * 16384, O_PCONV = O_PGDN + 2 * NB * 16384,
                 O_SMK = O_PCONV + 2 * NB * 3 * 768, O_SMV = O_SMK + 2 * SB * 256, O_SS5R = O_SMV + 2 * SB * 256, O_SS5I = O_SS5R + 2 * SB * 1024,
                 O_SGLA = O_SS5I + 2 * SB * 1024, O_SGDN = O_SGLA + (size_t)2 * SB * 16384, O_SCONV = O_SGDN + (size_t)2 * SB * 16384, O_END = O_SCONV + 2 * SB * 3 * 768;
static_assert(O_END == 36292608, "output size");
constexpr size_t al256(size_t x) { return (x + 255) & ~(size_t)255; }
constexpr size_t WS_CTL = 0, CTL_BYTES = 1u << 20;
constexpr size_t WSZ_WIN = (size_t)NP * D * 2, WSZ_WG = (size_t)NGATE * D * 2, WSZ_WBR = (size_t)4 * D * BW * 2, WSZ_WOUT = (size_t)D * D * 2, WSZ_FF1 = (size_t)DFF * D * 2, WSZ_FF2 = (size_t)D * DFF * 2;
constexpr size_t WO_WIN = 0, WO_WG = WO_WIN + WSZ_WIN, WO_WBR = WO_WG + WSZ_WG, WO_WOUT = WO_WBR + WSZ_WBR, WO_FF1 = WO_WOUT + WSZ_WOUT, WO_FF2 = WO_FF1 + WSZ_FF1, W_LAYER = al256(WO_FF2 + WSZ_FF2);
constexpr size_t WS_W = CTL_BYTES;
constexpr size_t WS_H = WS_W + 2 * W_LAYER;
constexpr size_t WS_PROJ = WS_H + (size_t)MPAD * D * 2;
constexpr size_t WS_GATE = WS_PROJ + (size_t)MPAD * NP * 4;
constexpr size_t WS_Y = WS_GATE + (size_t)MPAD * NGATE * 2;
constexpr size_t YSTRIDE = (size_t)MPAD * BW * 2;
constexpr size_t WS_M32 = WS_Y + 4 * YSTRIDE;
constexpr size_t WS_MRG = WS_M32 + (size_t)MPAD * D * 4;
constexpr size_t WS_SSQ = WS_M32;
constexpr size_t WS_SSQS = WS_SSQ + (size_t)MP * 16 * 4;
constexpr size_t WS_X1 = WS_MRG + (size_t)MPAD * D * 2;
constexpr size_t WS_X2 = WS_X1 + (size_t)MPAD * D * 4;
constexpr size_t WS_Z = WS_X2 + (size_t)MPAD * D * 4;
constexpr size_t WS_TMP = WS_Z + (size_t)MPAD * DFF * 2;
constexpr size_t TSTRIDE = (size_t)MPAD * BW * 4;
constexpr int T_LA = 0, T_GQ = 1, T_GK = 2, T_GV = 3, T_MQ = 4, T_YPRE = 5, T_OGLA = 6, T_OGDN = 7, T_N = 8;
constexpr size_t WS_GB = WS_TMP + T_N * TSTRIDE;
constexpr size_t WS_KM = WS_GB + 2 * (size_t)MPAD * 4 * 4;
constexpr size_t WS_KMS = WS_KM + 4 * 16 * 256 * 4;
constexpr size_t WS_END = WS_KMS + 32 * 32 * 256 * 4;
constexpr int CW_BAR = 1024;
constexpr int RING_BYTES = 131072, MISC_OFF = RING_BYTES + 320, LDS_BYTES = 147456;
constexpr int RS_OFF = RING_BYTES + 1024;
#define LASQ __attribute__((address_space(3)))

DI float wsum(float v) {
#pragma unroll
    for (int o = 32; o >= 1; o >>= 1) v += __shfl_xor(v, o);
    return v;
}
DI float wmaxf(float v) {
#pragma unroll
    for (int o = 32; o >= 1; o >>= 1) v = fmaxf(v, __shfl_xor(v, o));
    return v;
}
DI unsigned f2bf(float f) { unsigned u = __builtin_bit_cast(unsigned, f); return (u + 0x7fffu + ((u >> 16) & 1u)) >> 16; }
DI unsigned pk2(float lo, float hi) { return f2bf(lo) | (f2bf(hi) << 16); }
DI float bflo(unsigned w) { return __builtin_bit_cast(float, w << 16); }
DI float bfhi(unsigned w) { return __builtin_bit_cast(float, w & 0xffff0000u); }
DI float rcp_(float x) { return __builtin_amdgcn_rcpf(x); }
DI float rsq_(float x) { return __builtin_amdgcn_rsqf(x); }
DI float sigmoid_(float x) { return rcp_(1.f + __expf(-x)); }
DI float silu_(float x) { return x * sigmoid_(x); }
DI float softplus_(float x) { return x > 20.f ? x : __logf(1.f + __expf(x)); }
DI float logsigmoid_(float x) { return -softplus_(-x); }
DI float gelu_tanh_(float x) { const float u = 0.7978845608028654f * (x + 0.044715f * x * x * x); return x * rcp_(1.f + __expf(-2.f * u)); }

namespace pg8 {
#define EPI_OPAQUE_LANE() int fr = fr_, fq = fq_; asm volatile("" : "+v"(fr), "+v"(fq))
template <unsigned LDC> struct EpiStoreF32 {
    static constexpr bool PERM = false, AFTER_DRAIN = false;
    float* C; const LASQ float* rs; mutable int k;
    __device__ __forceinline__ void operator()(const f32x4 (&acc)[2][2][4][2], const Unit& u, int wr, int wc, int fr_, int fq_) const {
        EPI_OPAQUE_LANE();
        const unsigned row0 = (unsigned)(u.pm * BM + wr * 64 + fr), col0 = (unsigned)(u.pn * BM + wc * 32 + 4 * fq);
        const unsigned o0 = (row0 * LDC + col0) * 4u; char* cb = (char*)C;
        const LASQ float* rp = rs + k * 256 + wr * 64 + fr; ++k;
#pragma unroll
        for (int ai = 0; ai < 2; ++ai)
#pragma unroll
            for (int m = 0; m < 4; ++m) { const float sc = rp[ai * HALF + m * 16];
#pragma unroll
                for (int bj = 0; bj < 2; ++bj)
#pragma unroll
                    for (int n = 0; n < 2; ++n) *(f32x4*)(cb + (o0 + ((unsigned)(ai * HALF + m * 16) * LDC + (unsigned)(bj * HALF + n * 16)) * 4u)) = acc[ai][bj][m][n] * sc; }
    }
};
template <int ACT, unsigned LDC> struct EpiActBf16 {
    static constexpr bool PERM = true, AFTER_DRAIN = false;
    bf16_t* O; const LASQ float* rs; mutable int k;
    __device__ __forceinline__ void operator()(const f32x4 (&acc)[2][2][4][2], const Unit& u, int wr, int wc, int fr_, int fq_) const {
        EPI_OPAQUE_LANE();
        const unsigned row0 = (unsigned)(u.pm * BM + wr * 64 + fr), col0 = (unsigned)(u.pn * BM + wc * 32 + 8 * fq);
        const unsigned o0 = (row0 * LDC + col0) * 2u; char* ob = (char*)O;
        const LASQ float* rp = rs + k * 256 + wr * 64 + fr; ++k;
#pragma unroll
        for (int ai = 0; ai < 2; ++ai)
#pragma unroll
            for (int m = 0; m < 4; ++m) { const float sc = rp[ai * HALF + m * 16];
#pragma unroll
                for (int bj = 0; bj < 2; ++bj) { f32x4 v0 = acc[ai][bj][m][0] * sc, v1 = acc[ai][bj][m][1] * sc;
#pragma unroll
                    for (int j = 0; j < 4; ++j) {
                        if (ACT == 0) { v0[j] = __builtin_amdgcn_rcpf(1.f + __expf(-v0[j])); v1[j] = __builtin_amdgcn_rcpf(1.f + __expf(-v1[j])); }
                        else { const float a = fmaxf(v0[j], 0.f), b = fmaxf(v1[j], 0.f); v0[j] = a * a; v1[j] = b * b; } }
                    u32x4 w; w.x = cvt_pk_bf16(v0[0], v0[1]); w.y = cvt_pk_bf16(v0[2], v0[3]); w.z = cvt_pk_bf16(v1[0], v1[1]); w.w = cvt_pk_bf16(v1[2], v1[3]);
                    *(u32x4*)(ob + (o0 + ((unsigned)(ai * HALF + m * 16) * LDC + (unsigned)(bj * HALF)) * 2u)) = w; } }
    }
};
template <int MODE> struct EpiGate {
    static constexpr bool PERM = true, AFTER_DRAIN = false;
    static constexpr unsigned LDG = 4096, LD = 1024;
    const bf16_t* gate; float* m32; bf16_t* mrg;
    __device__ __forceinline__ void operator()(const f32x4 (&acc)[2][2][4][2], const Unit& u, int wr, int wc, int fr_, int fq_) const {
        EPI_OPAQUE_LANE();
        const unsigned row0 = (unsigned)(u.pm * BM + wr * 64 + fr), col0 = (unsigned)(u.pn * BM + wc * 32 + 8 * fq);
        const unsigned g0 = (row0 * LDG + col0) * 2u, m0 = (row0 * LD + col0) * 4u, b0 = (row0 * LD + col0) * 2u;
        const char* gb = (const char*)gate; char* mb = (char*)m32; char* bb = (char*)mrg;
#pragma unroll
        for (int ai = 0; ai < 2; ++ai)
#pragma unroll
            for (int m = 0; m < 4; ++m) { const unsigned dr = (unsigned)(ai * HALF + m * 16);
#pragma unroll
                for (int bj = 0; bj < 2; ++bj) { const unsigned dc = (unsigned)(bj * HALF);
                    const u32x4 gw = *(const u32x4*)(gb + (g0 + (dr * LDG + dc) * 2u));
                    f32x4 v0 = acc[ai][bj][m][0], v1 = acc[ai][bj][m][1];
                    v0[0] *= __builtin_bit_cast(float, gw.x << 16); v0[1] *= __builtin_bit_cast(float, gw.x & 0xffff0000u);
                    v0[2] *= __builtin_bit_cast(float, gw.y << 16); v0[3] *= __builtin_bit_cast(float, gw.y & 0xffff0000u);
                    v1[0] *= __builtin_bit_cast(float, gw.z << 16); v1[1] *= __builtin_bit_cast(float, gw.z & 0xffff0000u);
                    v1[2] *= __builtin_bit_cast(float, gw.w << 16); v1[3] *= __builtin_bit_cast(float, gw.w & 0xffff0000u);
                    const unsigned mo = m0 + (dr * LD + dc) * 4u;
                    if (MODE != 0) { v0 += *(const f32x4*)(mb + mo); v1 += *(const f32x4*)(mb + mo + 16u); }
                    if (MODE != 2) { *(f32x4*)(mb + mo) = v0; *(f32x4*)(mb + mo + 16u) = v1; }
                    else { u32x4 w; w.x = cvt_pk_bf16(v0[0], v0[1]); w.y = cvt_pk_bf16(v0[2], v0[3]); w.z = cvt_pk_bf16(v1[0], v1[1]); w.w = cvt_pk_bf16(v1[2], v1[3]);
                           *(u32x4*)(bb + (b0 + (dr * LD + dc) * 2u)) = w; }
                    asm volatile("" ::: "memory"); } }
    }
};
struct EpiRes {
    static constexpr bool PERM = false, AFTER_DRAIN = false;
    static constexpr unsigned LD = 1024;
    const float* base_p; float* out_p; bf16_t* hb; float* ssq;
    __device__ __forceinline__ void operator()(const f32x4 (&acc)[2][2][4][2], const Unit& u, int wr, int wc, int fr_, int fq_) const {
        EPI_OPAQUE_LANE();
        const char* bb = (const char*)base_p; char* ob = (char*)out_p; char* hbb = (char*)hb;
        const int rl0 = u.pm * BM + wr * 64 + fr; const unsigned col0 = (unsigned)(u.pn * BM + wc * 32 + 4 * fq);
#pragma unroll
        for (int ai = 0; ai < 2; ++ai) {
            f32x4 b[4][2][2];
#pragma unroll
            for (int m = 0; m < 4; ++m) { const unsigned off = ((unsigned)(rl0 + ai * HALF + m * 16) * LD + col0) * 4u;
#pragma unroll
                for (int bj = 0; bj < 2; ++bj)
#pragma unroll
                    for (int n = 0; n < 2; ++n) b[m][bj][n] = *(const f32x4*)(bb + off + (unsigned)(bj * HALF + n * 16) * 4u); }
#pragma unroll
            for (int m = 0; m < 4; ++m) { const int row = rl0 + ai * HALF + m * 16;
                const unsigned off = ((unsigned)row * LD + col0) * 4u; float s = 0.f;
#pragma unroll
                for (int bj = 0; bj < 2; ++bj)
#pragma unroll
                    for (int n = 0; n < 2; ++n) { const unsigned o = off + (unsigned)(bj * HALF + n * 16) * 4u; const f32x4 v = b[m][bj][n] + acc[ai][bj][m][n]; *(f32x4*)(ob + o) = v;
                        if (hb) { s += (v.x * v.x + v.y * v.y) + (v.z * v.z + v.w * v.w); u32x2 w; w.x = cvt_pk_bf16(v.x, v.y); w.y = cvt_pk_bf16(v.z, v.w); *(u32x2*)(hbb + (o >> 1)) = w; } }
                if (hb) { s += __shfl_xor(s, 16); s += __shfl_xor(s, 32); if (fq == 0) ssq[(unsigned)row * 16u + (unsigned)(u.pn * 4 + wc)] = s; } }
            asm volatile("" ::: "memory"); }
    }
};
}

#ifndef FAST_GLA
#define FAST_GLA 1
#endif
#ifndef FAST_S5
#define FAST_S5 1
#endif
#ifndef FAST_GDN
#define FAST_GDN 1
#endif
struct Args { const void* in[40]; float* out; unsigned char* ws; int ph_lo, ph_hi, li, pad; };
struct Ctx {
    float* out; unsigned char* ws;
    float* outb; unsigned char* wsb;
    LASQ unsigned char* lds;
    int tid, lane, wave, vcu, G, gw, NGW;
};
constexpr int PTAB_OFF = RING_BYTES;
DI unsigned long long inU(const Ctx& C, int i) { const u32x2 v = *(const LASQ u32x2*)(C.lds + PTAB_OFF + 8 * i);
    return ((unsigned long long)(unsigned)__builtin_amdgcn_readfirstlane((int)v.y) << 32) | (unsigned)__builtin_amdgcn_readfirstlane((int)v.x); }
#define GASQ __attribute__((address_space(1)))
DI const float* inF(const Ctx& C, int i) { return (const float*)(const GASQ float*)inU(C, i); }
DI const int* inI(const Ctx& C, int i) { return (const int*)(const GASQ int*)inU(C, i); }
DI float* tmpbuf(const Ctx& C, int i) { return (float*)(C.ws + WS_TMP + (size_t)i * TSTRIDE); }
DI bf16* ybuf(const Ctx& C, int i) { return (bf16*)(C.ws + WS_Y + (size_t)i * YSTRIDE); }
DI float* projp(const Ctx& C) { return (float*)(C.ws + WS_PROJ); }
DI bf16* Hp(const Ctx& C) { return (bf16*)(C.ws + WS_H); }
DI bf16* gatep(const Ctx& C) { return (bf16*)(C.ws + WS_GATE); }
DI float* m32p(const Ctx& C) { return (float*)(C.ws + WS_M32); }
DI bf16* mrgp(const Ctx& C) { return (bf16*)(C.ws + WS_MRG); }
DI float* X1p(const Ctx& C) { return (float*)(C.ws + WS_X1); }
DI float* X2p(const Ctx& C) { return (float*)(C.ws + WS_X2); }
DI bf16* Zp(const Ctx& C) { return (bf16*)(C.ws + WS_Z); }
DI float* GBp(const Ctx& C) { return (float*)(C.ws + WS_GB); }
DI float* GGp(const Ctx& C) { return (float*)(C.ws + WS_GB) + (size_t)MPAD * 4; }
DI float* KMp(const Ctx& C) { return (float*)(C.ws + WS_KM); }
DI float* KMSp(const Ctx& C) { return (float*)(C.ws + WS_KMS); }
DI bf16* wptr(const Ctx& C, int l, size_t off) { return (bf16*)(C.ws + WS_W + (size_t)l * W_LAYER + off); }

DI void refresh(Ctx& C) { int t_ = threadIdx.x; asm volatile("" : "+v"(t_)); C.tid = t_; C.lane = t_ & 63; int v_ = C.vcu, w_ = C.wave; size_t z_ = 0; asm volatile("" : "+s"(v_), "+s"(w_), "+s"(z_)); C.vcu = v_; C.wave = w_; C.ws = C.wsb + z_; C.out = C.outb + z_; C.gw = w_ * C.G + v_; }
DI int winmap(int c) {
    if (c < 1024) return c;
    if (c < 1280) return 1040 + (c - 1024);
    if (c < 2048) return 1296 + (c - 1280);
    if (c < 2304) return 2072 + (c - 2048);
    if (c < 3072) return 2328 + (c - 2304);
    if (c < 3088) return 1024 + (c - 3072);
    if (c < 3096) return 2064 + (c - 3088);
    return -1;
}
template <bool MAP, bool GAIN = false> DI void tr_item(const float* W, int K, int Nsrc, int Ndst, bf16* WT, LASQ float* scr, int item, int lane, const float* gn = nullptr) {
    const int nblk = Ndst / 32, kb = item / nblk, nb = item % nblk, k0 = 64 * kb, n0 = 32 * nb;
    const int nd = n0 + (lane & 31); const int ns = MAP ? winmap(nd) : nd;
    const int c = lane & 7;
    f32x4 ga = {1.f, 1.f, 1.f, 1.f}, gb = ga; if (GAIN) { ga = *(const f32x4*)(gn + k0 + 8 * c); gb = *(const f32x4*)(gn + k0 + 8 * c + 4); }
#pragma unroll
    for (int i = 0; i < 32; ++i) { const int kk = 2 * i + (lane >> 5); scr[kk * 33 + (lane & 31)] = (ns >= 0) ? __builtin_nontemporal_load(W + (size_t)(k0 + kk) * Nsrc + ns) : 0.f; }
    asm volatile("s_waitcnt lgkmcnt(0)" ::: "memory");
#pragma unroll
    for (int j = 0; j < 4; ++j) { const int n = (lane >> 3) + 8 * j; const LASQ float* s = scr + (8 * c) * 33 + n;
        u32x4 o; if (GAIN) { o.x = pk2(s[0 * 33] * ga.x, s[1 * 33] * ga.y); o.y = pk2(s[2 * 33] * ga.z, s[3 * 33] * ga.w); o.z = pk2(s[4 * 33] * gb.x, s[5 * 33] * gb.y); o.w = pk2(s[6 * 33] * gb.z, s[7 * 33] * gb.w); }
        else { o.x = pk2(s[0 * 33], s[1 * 33]); o.y = pk2(s[2 * 33], s[3 * 33]); o.z = pk2(s[4 * 33], s[5 * 33]); o.w = pk2(s[6 * 33], s[7 * 33]); }
        *(u32x4*)(WT + (size_t)(n0 + n) * K + k0 + 8 * c) = o; }
    asm volatile("s_waitcnt lgkmcnt(0)" ::: "memory");
}
DI void rms_row(const float* xrow, const float* g, bf16* orow, int lane) {
    const f32x4* xr = (const f32x4*)xrow + lane; const f32x4* gr = (const f32x4*)g + lane;
    f32x4 v[4]; float s = 0.f;
#pragma unroll
    for (int j = 0; j < 4; ++j) { v[j] = xr[64 * j]; s += (v[j].x * v[j].x + v[j].y * v[j].y) + (v[j].z * v[j].z + v[j].w * v[j].w); }
    const float r = 1.f / sqrtf(wsum(s) * (1.f / D) + 1e-6f);
    unsigned long long* o8 = (unsigned long long*)orow + lane;
#pragma unroll
    for (int j = 0; j < 4; ++j) { const f32x4 gg = gr[64 * j];
        o8[64 * j] = (unsigned long long)pk2(v[j].x * r * gg.x, v[j].y * r * gg.y) | ((unsigned long long)pk2(v[j].z * r * gg.z, v[j].w * r * gg.w) << 32); }
}
DI void cast_rows(Ctx& C, const float* xp, const float* xs) {
    const int lane = C.lane;
    for (int m0 = 4 * C.gw; m0 < MR; m0 += 4 * C.NGW) {
        const float* x0 = (m0 < MP) ? xp + (size_t)m0 * D : xs + (size_t)(m0 - MP) * D;
        f32x4 v[4][4];
#pragma unroll
        for (int i = 0; i < 4; ++i)
#pragma unroll
            for (int j = 0; j < 4; ++j) v[i][j] = __builtin_nontemporal_load((const f32x4*)(x0 + (size_t)i * D) + lane + 64 * j);
#pragma unroll
        for (int i = 0; i < 4; ++i) { float s = 0.f;
#pragma unroll
            for (int j = 0; j < 4; ++j) s += (v[i][j].x * v[i][j].x + v[i][j].y * v[i][j].y) + (v[i][j].z * v[i][j].z + v[i][j].w * v[i][j].w);
            s = wsum(s);
            if (m0 < MP) { if (lane < 16) ((float*)(C.ws + WS_SSQ))[(size_t)(m0 + i) * 16 + lane] = (lane == 0) ? s : 0.f; }
            else ((float*)(C.ws + WS_SSQS))[(size_t)(m0 + i - MP) * 64 + lane] = (lane == 0) ? s : 0.f;
            unsigned long long* o8 = (unsigned long long*)(Hp(C) + (size_t)(m0 + i) * D) + lane;
#pragma unroll
            for (int j = 0; j < 4; ++j) o8[64 * j] = (unsigned long long)pk2(v[i][j].x, v[i][j].y) | ((unsigned long long)pk2(v[i][j].z, v[i][j].w) << 32); }
    }
}
template <class Order> DI void fill_rs(Ctx& C, const Order& S, int slot0) {
    LASQ float* rsl = (LASQ float*)(C.lds + RS_OFF) + slot0 * 256; const float* sq = (const float*)(C.ws + WS_SSQ) + (size_t)(C.tid >> 1) * 16 + (C.tid & 1) * 8;
    constexpr int NU = 4; f32x4 a[NU], b[NU]; bool ok[NU];
#pragma unroll
    for (int i = 0; i < NU; ++i) { pg8::Unit u; ok[i] = S.next(i, u); const float* p = sq + (size_t)(ok[i] ? u.pm : 0) * 256 * 16; a[i] = ((const f32x4*)p)[0]; b[i] = ((const f32x4*)p)[1]; }
#pragma unroll
    for (int i = 0; i < NU; ++i) { float s = ((a[i].x + a[i].y) + (a[i].z + a[i].w)) + ((b[i].x + b[i].y) + (b[i].z + b[i].w)); s += __shfl_xor(s, 1);
        if (ok[i] && !(C.tid & 1)) rsl[i * 256 + (C.tid >> 1)] = rsq_(s * (1.f / D) + 1e-6f); }
    pg8::Unit u;
    for (int i = NU; S.next(i, u); ++i) { const float* p = sq + (size_t)u.pm * 256 * 16;
        const f32x4 a2 = ((const f32x4*)p)[0], b2 = ((const f32x4*)p)[1]; float s = ((a2.x + a2.y) + (a2.z + a2.w)) + ((b2.x + b2.y) + (b2.z + b2.w)); s += __shfl_xor(s, 1);
        if (!(C.tid & 1)) rsl[i * 256 + (C.tid >> 1)] = rsq_(s * (1.f / D) + 1e-6f); }
}
DI float sample_rs(Ctx& C) { const f32x4 a = *((const f32x4*)(C.ws + WS_SSQS) + C.tid); float s = (a.x + a.y) + (a.z + a.w);
#pragma unroll
    for (int o = 1; o < 16; o <<= 1) s += __shfl_xor(s, o);
    return rsq_(s * (1.f / D) + 1e-6f); }
DI void prologue(Ctx& C) {
    LASQ float* scr = (LASQ float*)(C.lds + C.wave * 16384);
    constexpr int I_IN = (D / 64) * (NP / 32), I_G = (D / 64) * (NGATE / 32), I_BR = (BW / 64) * (D / 32), I_O = (D / 64) * (D / 32), I_1 = (D / 64) * (DFF / 32), I_2 = (DFF / 64) * (D / 32);
    constexpr int PER_L = I_IN + I_G + 4 * I_BR + I_O + I_1 + I_2;
    for (int it = C.gw; it < 2 * PER_L; it += C.NGW) {
        const int l = it / PER_L; int r = it % PER_L;
        if (r < I_IN) { tr_item<true, true>(inF(C, 11) + (size_t)l * D * 3096, D, 3096, NP, wptr(C, l, WO_WIN), scr, r, C.lane, inF(C, 10) + l * D); continue; } r -= I_IN;
        if (r < I_G) { tr_item<false, true>(inF(C, 31) + (size_t)l * D * NGATE, D, NGATE, NGATE, wptr(C, l, WO_WG), scr, r, C.lane, inF(C, 10) + l * D); continue; } r -= I_G;
        if (r < 4 * I_BR) { const int br = r / I_BR; tr_item<false>(inF(C, 32 + br) + (size_t)l * BW * D, BW, D, D, wptr(C, l, WO_WBR) + (size_t)br * D * BW, scr, r % I_BR, C.lane); continue; } r -= 4 * I_BR;
        if (r < I_O) { tr_item<false>(inF(C, 36) + (size_t)l * D * D, D, D, D, wptr(C, l, WO_WOUT), scr, r, C.lane); continue; } r -= I_O;
        if (r < I_1) { tr_item<false, true>(inF(C, 38) + (size_t)l * D * DFF, D, DFF, DFF, wptr(C, l, WO_FF1), scr, r, C.lane, inF(C, 37) + l * D); continue; } r -= I_1;
        tr_item<false>(inF(C, 39) + (size_t)l * DFF * D, DFF, D, D, wptr(C, l, WO_FF2), scr, r, C.lane);
    }
    cast_rows(C, inF(C, 0), inF(C, 1));
}

DI void pre_row(Ctx& C, int l, int m, const float* ropetab, int piece) {
    const int lane = C.lane; const bool smp = m >= MP; const int bs = m - MP, t = smp ? 0 : (m & (SEQ - 1)), pos = smp ? PAST : t;
    const float* pr = projp(C) + (size_t)m * NP;
    if ((!FAST_GLA || smp) && piece == 0) {
        const float* Wg = inF(C, 22) + (size_t)l * 16 * 256; const float* bg = inF(C, 23) + l * 256; float* LA = tmpbuf(C, T_LA) + (size_t)m * 256;
        float lr[16];
#pragma unroll
        for (int r = 0; r < 16; ++r) lr[r] = pr[C_LR + r];
#pragma unroll
        for (int i = 0; i < 4; ++i) { const int c = lane + 64 * i; float x = bg[c];
#pragma unroll
            for (int r = 0; r < 16; ++r) x += lr[r] * Wg[r * 256 + c];
            LA[c] = logsigmoid_(x) * (1.f / 16.f); }
    }
    if (piece >= 1 && piece <= 3) {
        const float* cw = inF(C, 25) + (size_t)l * 4 * 768; const float* cst = inF(C, 9) + ((size_t)l * SB + (smp ? bs : 0)) * 3 * 768;
        if (!FAST_GDN || smp) {
        { const int grp = piece - 1;
            float vals[4];
#pragma unroll
            for (int i = 0; i < 4; ++i) { const int c = grp * 256 + lane + 64 * i; float acc = 0.f;
#pragma unroll
                for (int j = 0; j < 4; ++j) { const int tt = t - 3 + j; float xin;
                    if (tt >= 0) xin = projp(C)[(size_t)(m - 3 + j) * NP + C_DQ + c]; else xin = smp ? cst[(tt + 3) * 768 + c] : 0.f;
                    acc += cw[j * 768 + c] * xin; }
                vals[i] = silu_(acc); }
            if (grp < 2) {
#pragma unroll
                for (int i = 0; i < 4; ++i) { const float ss = wsum(vals[i] * vals[i]); vals[i] *= (1.f / sqrtf(ss + 1e-6f)) * (grp == 0 ? 0.125f : 1.f); } }
            float* GO = tmpbuf(C, T_GQ + grp) + (size_t)m * 256;
#pragma unroll
            for (int i = 0; i < 4; ++i) GO[i * 64 + lane] = vals[i];
            asm volatile("" ::: "memory");
        }
        if (lane < 4 && piece == 1) { GBp(C)[(size_t)m * 4 + lane] = sigmoid_(pr[C_DB + lane]);
                        GGp(C)[(size_t)m * 4 + lane] = -expf(inF(C, 26)[l * 4 + lane]) * softplus_(pr[C_DA + lane] + inF(C, 27)[l * 4 + lane]); }
        }
        if (!smp && t >= SEQ - 3 && piece == 3) { float* o = C.out + O_PCONV + (((size_t)l * NB + (m >> 12)) * 3 + (t - (SEQ - 3))) * 768;
#pragma unroll
            for (int i = 0; i < 12; ++i) o[lane + 64 * i] = pr[C_DQ + lane + 64 * i]; }
        if (smp && piece == 3) { float* o = C.out + O_SCONV + ((size_t)l * SB + bs) * 3 * 768;
#pragma unroll
            for (int i = 0; i < 12; ++i) { const int c = lane + 64 * i; o[c] = cst[768 + c]; o[768 + c] = cst[2 * 768 + c]; o[2 * 768 + c] = pr[C_DQ + c]; } }
    }
    if (piece >= 4) {
        const float* qn = inF(C, 29) + l * 64; const float* kn = inF(C, 30) + l * 64;
        const float* rt = ropetab + (size_t)(smp ? SEQ : t) * 16; const float cs = rt[lane & 7], sn = rt[8 + (lane & 7)];
        float* MQ = tmpbuf(C, T_MQ) + (size_t)m * 256;
        float* MK = smp ? C.out + O_SMK + ((size_t)l * SB + bs) * 256 : C.out + O_PMK + ((size_t)l * MP + m) * 256;
        float* MV = smp ? C.out + O_SMV + ((size_t)l * SB + bs) * 256 : C.out + O_PMV + ((size_t)l * MP + m) * 256;
        { const int i = piece - 4;
            float xq = pr[C_MQ + i * 64 + lane], xk = pr[C_MK + i * 64 + lane];
            xq = xq * (1.f / sqrtf(wsum(xq * xq) * (1.f / 64.f) + 1e-6f)) * qn[lane];
            xk = xk * (1.f / sqrtf(wsum(xk * xk) * (1.f / 64.f) + 1e-6f)) * kn[lane];
            const float pq = __shfl_xor(xq, 8), pk = __shfl_xor(xk, 8);
            if (lane < 8) { xq = xq * cs - pq * sn; xk = xk * cs - pk * sn; } else if (lane < 16) { xq = xq * cs + pq * sn; xk = xk * cs + pk * sn; }
            MQ[i * 64 + lane] = xq; MK[i * 64 + lane] = xk; MV[i * 64 + lane] = pr[C_MV + i * 64 + lane]; }
    }
}
DI void kmean_item(Ctx& C, int l, int it) {
    const int lane = C.lane; float s[4] = {0.f, 0.f, 0.f, 0.f};
    if (it < NB * 16) { const int b = it >> 4, blk = it & 15; const float* k = C.out + O_PMK + ((size_t)l * MP + (size_t)b * SEQ + blk * 256) * 256;
        for (int j = 0; j < 256; ++j) {
#pragma unroll
            for (int i = 0; i < 4; ++i) s[i] += k[(size_t)j * 256 + lane + 64 * i]; }
#pragma unroll
        for (int i = 0; i < 4; ++i) KMp(C)[(size_t)it * 256 + lane + 64 * i] = s[i] * (1.f / 256.f);
    } else { const int r = it - NB * 16, bs = r >> 5, blk = r & 31; const int* pt = inI(C, 4) + bs * 64 + blk * 2; const float* ck = inF(C, 2) + (size_t)l * NPOOL * 128 * 256;
        for (int pg = 0; pg < 2; ++pg) { const float* k = ck + (size_t)pt[pg] * 128 * 256;
            for (int j = 0; j < 128; ++j) {
#pragma unroll
                for (int i = 0; i < 4; ++i) s[i] += k[(size_t)j * 256 + lane + 64 * i]; } }
#pragma unroll
        for (int i = 0; i < 4; ++i) KMSp(C)[(size_t)r * 256 + lane + 64 * i] = s[i] * (1.f / 256.f);
    }
}
DI void s5_naive(Ctx& C, int l, int s, int g, const float* s5p, bf16* ysb) {
    const int lane = C.lane;
    const float* P = s5p + (size_t)(l * 16 + g) * 36 * 64 + lane; const float are = P[0], aim = P[64];
    float bre[16], bim[16], cre[16], cim[16];
#pragma unroll
    for (int c = 0; c < 16; ++c) { bre[c] = P[(4 + c) * 64]; bim[c] = P[(20 + c) * 64];
        cre[c] = inF(C, 17)[((size_t)(l * 16 + g) * 16 + c) * 64 + lane]; cim[c] = inF(C, 18)[((size_t)(l * 16 + g) * 16 + c) * 64 + lane]; }
    const float dd = inF(C, 19)[l * 256 + g * 16 + (lane & 15)];
    int L, row0; float hr = 0.f, hi = 0.f;
    if (s < NB) { L = SEQ; row0 = s * SEQ; } else { L = 1; row0 = MP + (s - NB); hr = inF(C, 5)[((size_t)(l * SB + s - NB) * 16 + g) * 64 + lane]; hi = inF(C, 6)[((size_t)(l * SB + s - NB) * 16 + g) * 64 + lane]; }
    float* YPRE = tmpbuf(C, T_YPRE);
    for (int t = 0; t < L; ++t) {
        const float* up = projp(C) + (size_t)(row0 + t) * NP + C_S5U + g * 16;
        float xr = 0.f, xi = 0.f;
#pragma unroll
        for (int c = 0; c < 16; ++c) { const float u = up[c]; xr += bre[c] * u; xi += bim[c] * u; }
        const float nhr = are * hr - aim * hi + xr, nhi = are * hi + aim * hr + xi; hr = nhr; hi = nhi;
        float myy = 0.f;
#pragma unroll
        for (int c = 0; c < 16; ++c) { const float yc = wsum(hr * cre[c] - hi * cim[c]); if (lane == c) myy = yc; }
        if (lane < 16) { const float yv = gelu_tanh_(myy + dd * up[lane]); YPRE[(size_t)(row0 + t) * 256 + g * 16 + lane] = yv; if (s >= NB) ysb[(size_t)(s - NB) * 256 + g * 16 + lane] = (bf16)f2bf(yv); }
    }
    const size_t so = (s < NB) ? ((size_t)(l * NB + s) * 16 + g) * 64 + lane : ((size_t)(l * SB + s - NB) * 16 + g) * 64 + lane;
    if (s < NB) { C.out[O_PS5R + so] = hr; C.out[O_PS5I + so] = hi; } else { C.out[O_SS5R + so] = hr; C.out[O_SS5I + so] = hi; }
}
DI void gla_naive(Ctx& C, int l, int s, int h, int j) {
    const int lane = C.lane; float S[8]; int L, row0; size_t sto;
    if (s < NB) { L = SEQ; row0 = s * SEQ; sto = O_PGLA + (((size_t)(l * NB + s) * 4 + h) * 64 + lane) * 64 + 8 * j;
#pragma unroll
        for (int i = 0; i < 8; ++i) S[i] = 0.f; }
    else { L = 1; row0 = MP + s - NB; sto = O_SGLA + (((size_t)(l * SB + s - NB) * 4 + h) * 64 + lane) * 64 + 8 * j; const float* st = inF(C, 7) + (((size_t)(l * SB + s - NB) * 4 + h) * 64 + lane) * 64 + 8 * j;
#pragma unroll
        for (int i = 0; i < 8; ++i) S[i] = st[i]; }
    const float* LA = tmpbuf(C, T_LA); float* OG = tmpbuf(C, T_OGLA);
    for (int t = 0; t < L; ++t) { const size_t m = row0 + t; const float* pr = projp(C) + m * NP;
        const float q = pr[C_AQ + h * 64 + lane] * 0.125f, k = pr[C_AK + h * 64 + lane], a = __expf(LA[m * 256 + h * 64 + lane]);
        float myo = 0.f;
#pragma unroll
        for (int i = 0; i < 8; ++i) { S[i] = a * S[i] + k * pr[C_AV + h * 64 + 8 * j + i]; const float o = wsum(q * S[i]); if (lane == i) myo = o; }
        if (lane < 8) OG[m * 256 + h * 64 + 8 * j + lane] = myo; }
#pragma unroll
    for (int i = 0; i < 8; ++i) C.out[sto + i] = S[i];
}
DI void gdn_naive(Ctx& C, int l, int s, int h, int j) {
    const int lane = C.lane; float S[8]; int L, row0; size_t sto;
    if (s < NB) { L = SEQ; row0 = s * SEQ; sto = O_PGDN + (((size_t)(l * NB + s) * 4 + h) * 64 + lane) * 64 + 8 * j;
#pragma unroll
        for (int i = 0; i < 8; ++i) S[i] = 0.f; }
    else { L = 1; row0 = MP + s - NB; sto = O_SGDN + (((size_t)(l * SB + s - NB) * 4 + h) * 64 + lane) * 64 + 8 * j; const float* st = inF(C, 8) + (((size_t)(l * SB + s - NB) * 4 + h) * 64 + lane) * 64 + 8 * j;
#pragma unroll
        for (int i = 0; i < 8; ++i) S[i] = st[i]; }
    const float* GQ = tmpbuf(C, T_GQ); const float* GK = tmpbuf(C, T_GK); const float* GV = tmpbuf(C, T_GV); float* OG = tmpbuf(C, T_OGDN);
    for (int t = 0; t < L; ++t) { const size_t m = row0 + t;
        const float q = GQ[m * 256 + h * 64 + lane], k = GK[m * 256 + h * 64 + lane], beta = GBp(C)[m * 4 + h], a = __expf(GGp(C)[m * 4 + h]);
        float myo = 0.f;
#pragma unroll
        for (int i = 0; i < 8; ++i) { S[i] *= a; const float ks = wsum(k * S[i]); S[i] += beta * k * (GV[m * 256 + h * 64 + 8 * j + i] - ks); const float o = wsum(q * S[i]); if (lane == i) myo = o; }
        if (lane < 8) OG[m * 256 + h * 64 + 8 * j + lane] = myo; }
#pragma unroll
    for (int i = 0; i < 8; ++i) C.out[sto + i] = S[i];
}
DI const float* moba_kv_row(const Ctx& C, int l, bool smp, int b, int kp, int h, bool isv) {
    if (!smp) return C.out + (isv ? O_PMV : O_PMK) + ((size_t)l * MP + (size_t)b * SEQ + kp) * 256 + h * 64;
    if (kp >= PAST) return C.out + (isv ? O_SMV : O_SMK) + ((size_t)l * SB + b) * 256 + h * 64;
    const int page = (inI(C, 4))[b * 64 + (kp >> 7)];
    return inF(C, isv ? 3 : 2) + (((size_t)l * NPOOL + page) * 128 + (kp & 127)) * 256 + h * 64;
}
DI void moba_naive(Ctx& C, int l, int m, int h, LASQ float* wl) {
    const int lane = C.lane; const bool smp = m >= MP; const int b = smp ? m - MP : (m >> 12), t = smp ? 0 : (m & (SEQ - 1)), pos = smp ? PAST : t, own = pos >> 8;
    const float q = tmpbuf(C, T_MQ)[(size_t)m * 256 + h * 64 + lane];
    wl[lane] = q;
    const float* km = smp ? KMSp(C) + (size_t)b * 32 * 256 + h * 64 : KMp(C) + (size_t)b * 16 * 256 + h * 64;
    float myg = -3.0e38f;
    for (int n = 0; n < own; ++n) { const float gs = wsum(q * km[(size_t)n * 256 + lane]); if (lane == n) myg = gs; }
    int sel[4];
#pragma unroll
    for (int r = 0; r < 3; ++r) { if (r < own) { const float mx = wmaxf(myg); const unsigned long long bal = __ballot(myg == mx); const int idx = __ffsll((long long)bal) - 1; sel[r] = idx; if (lane == idx) myg = -3.0e38f; } else sel[r] = -1; }
    sel[3] = own;
    asm volatile("s_waitcnt lgkmcnt(0)" ::: "memory");
    float lg[4][4]; float mx = -3.0e38f;
#pragma unroll
    for (int r = 0; r < 4; ++r) {
#pragma unroll
        for (int i = 0; i < 4; ++i) { lg[r][i] = -3.0e38f;
            const int kp = sel[r] * 256 + lane + 64 * i;
            if (sel[r] >= 0 && kp <= pos) { const f32x4* kr = (const f32x4*)moba_kv_row(C, l, smp, b, kp, h, false); float dot = 0.f;
#pragma unroll
                for (int d4 = 0; d4 < 16; ++d4) { const f32x4 kv = kr[d4]; const f32x4 qv = *(const LASQ f32x4*)(wl + 4 * d4); dot += (kv.x * qv.x + kv.y * qv.y) + (kv.z * qv.z + kv.w * qv.w); }
                lg[r][i] = dot * 0.125f; mx = fmaxf(mx, lg[r][i]); } } }
    mx = wmaxf(mx); float sum = 0.f;
#pragma unroll
    for (int r = 0; r < 4; ++r)
#pragma unroll
        for (int i = 0; i < 4; ++i) { const float p = (lg[r][i] > -1.0e38f) ? __expf(lg[r][i] - mx) : 0.f; sum += p; wl[64 + r * 256 + lane + 64 * i] = p; }
    sum = wsum(sum);
    asm volatile("s_waitcnt lgkmcnt(0)" ::: "memory");
    float o = 0.f;
#pragma unroll
    for (int r = 0; r < 4; ++r) { if (sel[r] < 0) continue; const int nk = (r == 3) ? (pos - own * 256 + 1) : 256;
        for (int key = 0; key < nk; ++key) { const float* vr = moba_kv_row(C, l, smp, b, sel[r] * 256 + key, h, true); o += wl[64 + r * 256 + key] * vr[lane]; } }
    ybuf(C, 3)[(size_t)m * 256 + h * 64 + lane] = (bf16)f2bf(o / sum);
    asm volatile("s_waitcnt lgkmcnt(0)" ::: "memory");
}
DI void post_row(Ctx& C, int l, int m, int piece) {
    const int lane = C.lane; const float* pr = projp(C) + (size_t)m * NP;
    if (piece < 4) {   const float* og = tmpbuf(C, T_OGLA) + (size_t)m * 256; const float gn = inF(C, 24)[l * 64 + lane];
        { const int i = piece; const float o = og[i * 64 + lane]; const float r = 1.f / sqrtf(wsum(o * o) * (1.f / 64.f) + 1e-6f);
            ybuf(C, 1)[(size_t)m * 256 + i * 64 + lane] = (bf16)f2bf(o * r * gn * silu_(pr[C_AR + i * 64 + lane])); } }
    if (piece >= 4) {   const float* og = tmpbuf(C, T_OGDN) + (size_t)m * 256; const float gn = inF(C, 28)[l * 64 + lane];
        { const int i = piece - 4; const float o = og[i * 64 + lane]; const float r = 1.f / sqrtf(wsum(o * o) * (1.f / 64.f) + 1e-6f);
            ybuf(C, 2)[(size_t)m * 256 + i * 64 + lane] = (bf16)f2bf(o * r * gn * silu_(pr[C_DZ + i * 64 + lane])); } }
}

typedef short bf16x8v __attribute__((ext_vector_type(8)));
typedef short bf16x4v __attribute__((ext_vector_type(4)));
DI bf16x8v cvt8(f32x4 a, f32x4 b) { u32x4 w; w.x = pg8::cvt_pk_bf16(a.x, a.y); w.y = pg8::cvt_pk_bf16(a.z, a.w); w.z = pg8::cvt_pk_bf16(b.x, b.y); w.w = pg8::cvt_pk_bf16(b.z, b.w); return __builtin_bit_cast(bf16x8v, w); }
#define MFMA16(a, b, c) __builtin_amdgcn_mfma_f32_16x16x32_bf16((a), (b), (c), 0, 0, 0)
constexpr int AT_KS = 144, AT_VS = 144, AT_KB = 64 * AT_KS, AT_VB = 64 * AT_VS;
DI void moba_attn_qtile(Ctx& C, int l, int b, int h, int qt, const bf16* QB, const bf16* KBp, const bf16* VTp, const float* KSUM) {
    const int tid = C.tid, lane = C.lane, wave = C.wave, li = lane & 15, fq = lane >> 4;
    const int qb = qt >> 1, qpos = qt * 128 + wave * 16 + li;
    const size_t rowq = (size_t)b * SEQ + qpos;
    const float* mq = tmpbuf(C, T_MQ) + rowq * 256 + h * 64;
    const bf16* Kg = KBp + (size_t)b * SEQ * 256 + h * 64;
    const bf16* Vg = VTp + (size_t)(b * 4 + h) * 64 * SEQ;
    bf16x8v qf[2];
#pragma unroll
    for (int ks = 0; ks < 2; ++ks) qf[ks] = *(const bf16x8v*)(QB + rowq * 256 + h * 64 + 32 * ks + 8 * fq);
    unsigned selmask = 0u;
    if (qb > 0) {
        f32x4 qg[4];
#pragma unroll
        for (int j = 0; j < 4; ++j) qg[j] = *(const f32x4*)(mq + 16 * fq + 4 * j);
        float v1 = -3.0e38f, v2 = -3.0e38f, v3 = -3.0e38f; int i1 = -1, i2 = -1, i3 = -1;
        const float* km = KSUM + (size_t)b * 64 * 256 + h * 64 + 16 * fq;
        for (int n = 0; n < qb; ++n) { float g = 0.f;
#pragma unroll
            for (int c4 = 0; c4 < 4; ++c4)
#pragma unroll
            for (int j = 0; j < 4; ++j) { const f32x4 kv = *(const f32x4*)(km + (size_t)(4 * n + c4) * 256 + 4 * j); g += (qg[j].x * kv.x + qg[j].y * kv.y) + (qg[j].z * kv.z + qg[j].w * kv.w); }
            g += __shfl_xor(g, 16); g += __shfl_xor(g, 32);
            if (g > v1) { v3 = v2; i3 = i2; v2 = v1; i2 = i1; v1 = g; i1 = n; } else if (g > v2) { v3 = v2; i3 = i2; v2 = g; i2 = n; } else if (g > v3) { v3 = g; i3 = n; } }
        if (i1 >= 0) selmask |= 1u << i1; if (i2 >= 0) selmask |= 1u << i2; if (i3 >= 0) selmask |= 1u << i3;
    }
    const int ntile = qt * 2 + 2;
    f32x4 O[4]; float m = -1.0e30f, lsum = 0.f;
#pragma unroll
    for (int dt = 0; dt < 4; ++dt) O[dt] = (f32x4){0.f, 0.f, 0.f, 0.f};
    const int kkey = tid >> 3, kseg = tid & 7;
    LASQ unsigned char* L = C.lds;
    constexpr int AT_TB = AT_KB + AT_VB;
    u32x4 ka, va;
#define AT_LOAD(t) do { const int tl_ = ((t) < ntile) ? (t) : ntile - 1; ka = *(const GASQ u32x4*)(Kg + (size_t)(tl_ * 64 + kkey) * 256 + 8 * kseg); va = *(const GASQ u32x4*)(Vg + (size_t)kkey * SEQ + tl_ * 64 + 8 * kseg); } while (0)
#define AT_STORE(bo) do { *(LASQ u32x4*)(L + (bo) + kkey * AT_KS + kseg * 16) = ka; *(LASQ u32x4*)(L + (bo) + AT_KB + kkey * AT_VS + kseg * 16) = va; } while (0)
#define AT_QK(dst, bo) do { _Pragma("unroll") for (int nt = 0; nt < 4; ++nt) { dst[nt] = (f32x4){0.f, 0.f, 0.f, 0.f}; \
            _Pragma("unroll") for (int ks = 0; ks < 2; ++ks) { const bf16x8v kf = *(const LASQ bf16x8v*)(L + (bo) + (16 * nt + li) * AT_KS + (32 * ks + 8 * fq) * 2); dst[nt] = MFMA16(kf, qf[ks], dst[nt]); } } } while (0)
#define AT_BAR() do { asm volatile("s_waitcnt lgkmcnt(0)" ::: "memory"); __builtin_amdgcn_s_barrier(); asm volatile("" ::: "memory"); } while (0)
#define AT_STEP(OWN, t) do { \
        f32x4 sn[4]; \
        AT_QK(sn, b1); \
        const int key0 = (t) * 64; const float ninf = -__builtin_inff(); bool ok = true; \
        if (OWN) { _Pragma("unroll") for (int nt = 0; nt < 4; ++nt) _Pragma("unroll") for (int r = 0; r < 4; ++r) s[nt][r] = (key0 + 16 * nt + 4 * fq + r <= qpos) ? s[nt][r] : ninf; } \
        else ok = (selmask >> (key0 >> 8)) & 1u; \
        float mx = fmaxf(fmaxf(fmaxf(s[0][0], s[0][1]), fmaxf(s[0][2], s[0][3])), fmaxf(fmaxf(s[1][0], s[1][1]), fmaxf(s[1][2], s[1][3]))); \
        mx = fmaxf(mx, fmaxf(fmaxf(fmaxf(s[2][0], s[2][1]), fmaxf(s[2][2], s[2][3])), fmaxf(fmaxf(s[3][0], s[3][1]), fmaxf(s[3][2], s[3][3])))); \
        if (!OWN) mx = ok ? mx : ninf; \
        mx = fmaxf(mx, __shfl_xor(mx, 16)); mx = fmaxf(mx, __shfl_xor(mx, 32)); \
        const float mn = fmaxf(m, mx), alpha = __builtin_amdgcn_exp2f(m - mn); \
        const float mnb = (OWN || ok) ? mn : __builtin_inff(); \
        float ps = 0.f; f32x4 p[4]; \
        _Pragma("unroll") for (int nt = 0; nt < 4; ++nt) _Pragma("unroll") for (int r = 0; r < 4; ++r) { const float e_ = __builtin_amdgcn_exp2f(s[nt][r] - mnb); p[nt][r] = e_; ps += e_; } \
        lsum = lsum * alpha + ps; m = mn; \
        _Pragma("unroll") for (int dt = 0; dt < 4; ++dt) O[dt] *= alpha; \
        bf16x8v pf[2]; \
        _Pragma("unroll") for (int ks = 0; ks < 2; ++ks) pf[ks] = cvt8(p[2 * ks], p[2 * ks + 1]); \
        const LASQ unsigned char* VL = L + b0 + AT_KB; \
        _Pragma("unroll") for (int dt = 0; dt < 4; ++dt) _Pragma("unroll") for (int ks = 0; ks < 2; ++ks) { \
            const bf16x4v lo = *(const LASQ bf16x4v*)(VL + (16 * dt + li) * AT_VS + (32 * ks + 4 * fq) * 2), hi = *(const LASQ bf16x4v*)(VL + (16 * dt + li) * AT_VS + (32 * ks + 16 + 4 * fq) * 2); \
            O[dt] = MFMA16(__builtin_shufflevector(lo, hi, 0, 1, 2, 3, 4, 5, 6, 7), pf[ks], O[dt]); } \
        AT_STORE(b2);              \
        AT_LOAD((t) + 3); \
        AT_BAR(); \
        _Pragma("unroll") for (int nt = 0; nt < 4; ++nt) s[nt] = sn[nt]; \
        { const int bt_ = b0; b0 = b1; b1 = b2; b2 = bt_; } } while (0)
    int b0 = 0, b1 = AT_TB, b2 = 2 * AT_TB;
    AT_LOAD(0); AT_STORE(b0); AT_LOAD(1); AT_STORE(b1); AT_LOAD(2); __syncthreads();
    f32x4 s[4]; AT_QK(s, b0);
    const int npast = qb * 4;
    for (int t = 0; t < npast; ++t) AT_STEP(false, t);
    for (int t = npast; t < ntile; ++t) AT_STEP(true, t);
    __syncthreads();
#undef AT_STEP
#undef AT_QK
#undef AT_BAR
#undef AT_LOAD
#undef AT_STORE
    lsum += __shfl_xor(lsum, 16); lsum += __shfl_xor(lsum, 32);
    const float inv = 1.f / lsum;
    bf16* yd = ybuf(C, 3) + rowq * 256 + h * 64;
#pragma unroll
    for (int dt = 0; dt < 4; ++dt) { u32x2 w; w.x = pg8::cvt_pk_bf16(O[dt][0] * inv, O[dt][1] * inv); w.y = pg8::cvt_pk_bf16(O[dt][2] * inv, O[dt][3] * inv); *(u32x2*)(yd + 16 * dt + 4 * fq) = w; }
}

constexpr size_t WS_GLA = WS_END;
constexpr size_t GLA_VT = WS_GLA, GLA_DST = GLA_VT + (size_t)1024 * 4096 * 2, GLA_SC = GLA_DST + (size_t)1024 * 4096 * 4, GLA_DEC = GLA_SC + (size_t)1024 * 4096 * 4,
                 GLA_Q = GLA_DEC + (size_t)1024 * 64 * 4, GLA_K = GLA_Q + (size_t)MPAD * 256 * 2, WS_END2 = GLA_K + (size_t)MPAD * 256 * 2;
DI bf16* glaQ(const Ctx& C) { return (bf16*)(C.ws + GLA_Q); }
DI bf16* glaK(const Ctx& C) { return (bf16*)(C.ws + GLA_K); }
constexpr int LT = 72;

DI void gla_prep_chunk(Ctx& C, int l, int b, int c) {
    const int tid = C.tid, lane = C.lane, wave = C.wave, h = wave >> 1, rh = wave & 1, li = lane & 15, fq = lane >> 4;
    const size_t row0 = (size_t)b * SEQ + (size_t)c * 64; const int unit = ((b * 64 + c) * 4 + h);
    LASQ unsigned char* L = C.lds;
    LASQ float* LR = (LASQ float*)L; LASQ float* TOT = (LASQ float*)(L + 4096) + h * 64; LASQ float* BL = (LASQ float*)(L + 5120) + h * 64;
    LASQ unsigned char* KT = L + 8192 + h * (2 * 64 * LT * 2); LASQ unsigned char* VT = KT + 64 * LT * 2;
    if (tid < 256) { const int t = tid >> 2, r4 = tid & 3; *(LASQ f32x4*)(LR + t * 16 + 4 * r4) = *(const f32x4*)(projp(C) + (row0 + t) * NP + C_LR + 4 * r4); }
    float wg[16];
#pragma unroll
    for (int r = 0; r < 16; ++r) wg[r] = inF(C, 22)[(size_t)l * 16 * 256 + r * 256 + h * 64 + lane];
    const float bgv = inF(C, 23)[l * 256 + h * 64 + lane];
    __syncthreads();
    float qv[32], kv[32], vv[32];
#pragma unroll
    for (int i = 0; i < 32; ++i) { const float* pr = projp(C) + (row0 + 32 * rh + i) * NP + h * 64 + lane; qv[i] = pr[C_AQ]; kv[i] = pr[C_AK]; vv[i] = pr[C_AV]; }
    float bc[32]; float run = 0.f;
#pragma unroll
    for (int i = 0; i < 32; ++i) { const int t = 32 * rh + i; float x = bgv;
#pragma unroll
        for (int r4 = 0; r4 < 4; ++r4) { const f32x4 lr = *(const LASQ f32x4*)(LR + t * 16 + 4 * r4); x += lr.x * wg[4 * r4] + lr.y * wg[4 * r4 + 1] + lr.z * wg[4 * r4 + 2] + lr.w * wg[4 * r4 + 3]; }
        run += logsigmoid_(x) * (1.f / 16.f); bc[i] = run; }
    if (rh == 0) TOT[lane] = run;
    __syncthreads();
    if (rh == 1) { const float off = TOT[lane];
#pragma unroll
        for (int i = 0; i < 32; ++i) bc[i] += off;
        BL[lane] = bc[31]; }
    __syncthreads();
    float* BCg = tmpbuf(C, T_LA); bf16* Qg = glaQ(C); bf16* Kg = glaK(C);
    bf16* VTg = (bf16*)(C.ws + GLA_VT) + (size_t)unit * 4096;
#pragma unroll
    for (int g8 = 0; g8 < 4; ++g8) {
        float kt[8];
#pragma unroll
        for (int e = 0; e < 8; ++e) { const int i = 8 * g8 + e; const size_t row = row0 + 32 * rh + i;
            BCg[row * 256 + h * 64 + lane] = bc[i];
            const float ep = __expf(bc[i]), en = __expf(-bc[i]); kt[e] = kv[i] * en;
            Qg[row * 256 + h * 64 + lane] = (bf16)f2bf(qv[i] * 0.125f * ep); Kg[row * 256 + h * 64 + lane] = (bf16)f2bf(kt[e]); }
        u32x4 kw, vw; kw.x = pk2(kt[0], kt[1]); kw.y = pk2(kt[2], kt[3]); kw.z = pk2(kt[4], kt[5]); kw.w = pk2(kt[6], kt[7]);
        vw.x = pk2(vv[8 * g8], vv[8 * g8 + 1]); vw.y = pk2(vv[8 * g8 + 2], vv[8 * g8 + 3]); vw.z = pk2(vv[8 * g8 + 4], vv[8 * g8 + 5]); vw.w = pk2(vv[8 * g8 + 6], vv[8 * g8 + 7]);
        *(LASQ u32x4*)(KT + lane * (LT * 2) + (32 * rh + 8 * g8) * 2) = kw; *(LASQ u32x4*)(VT + lane * (LT * 2) + (32 * rh + 8 * g8) * 2) = vw;
        *(u32x4*)(VTg + lane * 64 + 32 * rh + 8 * g8) = vw; }
    __syncthreads();
    float* DSTg = (float*)(C.ws + GLA_DST) + (size_t)unit * 4096;
#pragma unroll
    for (int at = 0; at < 2; ++at) { const int d0 = 16 * (2 * rh + at);
        bf16x8v af[2];
#pragma unroll
        for (int ks = 0; ks < 2; ++ks) af[ks] = *(const LASQ bf16x8v*)(KT + (d0 + li) * (LT * 2) + (32 * ks + 8 * fq) * 2);
        const f32x4 eb = {__expf(BL[d0 + 4 * fq]), __expf(BL[d0 + 4 * fq + 1]), __expf(BL[d0 + 4 * fq + 2]), __expf(BL[d0 + 4 * fq + 3])};
#pragma unroll
        for (int bt = 0; bt < 4; ++bt) { f32x4 acc = {0.f, 0.f, 0.f, 0.f};
#pragma unroll
            for (int ks = 0; ks < 2; ++ks) { const bf16x8v bf = *(const LASQ bf16x8v*)(VT + (16 * bt + li) * (LT * 2) + (32 * ks + 8 * fq) * 2); acc = MFMA16(af[ks], bf, acc); }
            *(f32x4*)(DSTg + (16 * bt + li) * 64 + d0 + 4 * fq) = acc * eb; } }
    if (rh == 0) ((float*)(C.ws + GLA_DEC))[(size_t)unit * 64 + lane] = __expf(BL[lane]);
    __syncthreads();
}
DI void gla_scan_item(Ctx& C, int l, int it) {
    const int lane = C.lane, b = it >> 8, h = (it >> 6) & 3, v = it & 63;
    const float* DST = (const float*)(C.ws + GLA_DST); float* SC = (float*)(C.ws + GLA_SC); const float* DEC = (const float*)(C.ws + GLA_DEC);
    float S = 0.f;
    for (int c0 = 0; c0 < 64; c0 += 8) { float ds[8], de[8];
#pragma unroll
        for (int e = 0; e < 8; ++e) { const size_t u = (size_t)((b * 64 + c0 + e) * 4 + h); ds[e] = DST[u * 4096 + v * 64 + lane]; de[e] = DEC[u * 64 + lane]; }
#pragma unroll
        for (int e = 0; e < 8; ++e) { const size_t u = (size_t)((b * 64 + c0 + e) * 4 + h); SC[u * 4096 + v * 64 + lane] = S; S = de[e] * S + ds[e]; } }
    C.out[O_PGLA + (((size_t)(l * NB + b) * 4 + h) * 64 + lane) * 64 + v] = S;
}
DI void gla_out_chunk(Ctx& C, int l, int b, int c) {
    const int tid = C.tid, lane = C.lane, wave = C.wave, h = wave >> 1, rh = wave & 1, li = lane & 15, fq = lane >> 4;
    const size_t row0 = (size_t)b * SEQ + (size_t)c * 64; const int unit = ((b * 64 + c) * 4 + h);
    LASQ unsigned char* L = C.lds; constexpr int TB = 64 * LT * 2;
    LASQ unsigned char* KL = L + h * (3 * TB); LASQ unsigned char* VT = KL + TB; LASQ unsigned char* ST = VT + TB;
    {
        const int x = (rh << 6) | lane, r = x >> 1, hf = x & 1;
        const bf16* kg = glaK(C) + (row0 + r) * 256 + h * 64 + 32 * hf; const bf16* vg = (const bf16*)(C.ws + GLA_VT) + (size_t)unit * 4096 + r * 64 + 32 * hf;
        const float* sg = (const float*)(C.ws + GLA_SC) + (size_t)unit * 4096 + r * 64 + 32 * hf;
#pragma unroll
        for (int e = 0; e < 4; ++e) { *(LASQ u32x4*)(KL + r * (LT * 2) + (32 * hf + 8 * e) * 2) = *(const u32x4*)(kg + 8 * e); *(LASQ u32x4*)(VT + r * (LT * 2) + (32 * hf + 8 * e) * 2) = *(const u32x4*)(vg + 8 * e);
            const f32x4 s0 = *(const f32x4*)(sg + 8 * e), s1 = *(const f32x4*)(sg + 8 * e + 4); *(LASQ bf16x8v*)(ST + r * (LT * 2) + (32 * hf + 8 * e) * 2) = cvt8(s0, s1); }
    }
    __syncthreads();
    const float* gnp = inF(C, 24) + l * 64;
#pragma unroll 1
    for (int bt = 0; bt < 2; ++bt) { const int iq = 32 * rh + 16 * bt + li; const size_t row = row0 + iq;
        bf16x8v qf[2];
#pragma unroll
        for (int ks = 0; ks < 2; ++ks) qf[ks] = *(const bf16x8v*)(glaQ(C) + row * 256 + h * 64 + 32 * ks + 8 * fq);
        f32x4 s[4];
#pragma unroll
        for (int jt = 0; jt < 4; ++jt) { s[jt] = (f32x4){0.f, 0.f, 0.f, 0.f};
#pragma unroll
            for (int ks = 0; ks < 2; ++ks) { const bf16x8v kf = *(const LASQ bf16x8v*)(KL + (16 * jt + li) * (LT * 2) + (32 * ks + 8 * fq) * 2); s[jt] = MFMA16(kf, qf[ks], s[jt]); }
#pragma unroll
            for (int r = 0; r < 4; ++r) s[jt][r] = (16 * jt + 4 * fq + r <= iq) ? s[jt][r] : 0.f; }
        bf16x8v pf[2];
#pragma unroll
        for (int ks = 0; ks < 2; ++ks) pf[ks] = cvt8(s[2 * ks], s[2 * ks + 1]);
        f32x4 o[4]; float ss = 0.f;
#pragma unroll
        for (int vt = 0; vt < 4; ++vt) { o[vt] = (f32x4){0.f, 0.f, 0.f, 0.f};
#pragma unroll
            for (int ks = 0; ks < 2; ++ks) { const LASQ unsigned char* vr = VT + (16 * vt + li) * (LT * 2);
                const bf16x4v lo = *(const LASQ bf16x4v*)(vr + (32 * ks + 4 * fq) * 2), hi = *(const LASQ bf16x4v*)(vr + (32 * ks + 16 + 4 * fq) * 2);
                o[vt] = MFMA16(__builtin_shufflevector(lo, hi, 0, 1, 2, 3, 4, 5, 6, 7), pf[ks], o[vt]);
                const bf16x8v sf = *(const LASQ bf16x8v*)(ST + (16 * vt + li) * (LT * 2) + (32 * ks + 8 * fq) * 2); o[vt] = MFMA16(sf, qf[ks], o[vt]); }
            ss += (o[vt][0] * o[vt][0] + o[vt][1] * o[vt][1]) + (o[vt][2] * o[vt][2] + o[vt][3] * o[vt][3]); }
        ss += __shfl_xor(ss, 16); ss += __shfl_xor(ss, 32);
        const float rinv = rsq_(ss * (1.f / 64.f) + 1e-6f);
        const float* ar = projp(C) + row * NP + C_AR + h * 64; bf16* yb = ybuf(C, 1) + row * 256 + h * 64;
#pragma unroll
        for (int vt = 0; vt < 4; ++vt) { const f32x4 g = *(const f32x4*)(ar + 16 * vt + 4 * fq), gn = *(const f32x4*)(gnp + 16 * vt + 4 * fq);
            u32x2 w; w.x = pg8::cvt_pk_bf16(o[vt][0] * rinv * gn.x * silu_(g.x), o[vt][1] * rinv * gn.y * silu_(g.y)); w.y = pg8::cvt_pk_bf16(o[vt][2] * rinv * gn.z * silu_(g.z), o[vt][3] * rinv * gn.w * silu_(g.w));
            *(u32x2*)(yb + 16 * vt + 4 * fq) = w; } }
    __syncthreads();
}

typedef float f32x2 __attribute__((ext_vector_type(2)));
constexpr size_t WS_S5 = WS_END2;
constexpr size_t S5_P = WS_S5;
constexpr size_t S5_CC = S5_P + (size_t)2 * 16 * 36 * 64 * 4;
constexpr size_t S5_WGT = S5_CC + (size_t)2 * 16 * 16 * 128 * 2;
constexpr size_t S5_E = S5_WGT + (size_t)2 * 256 * 256 * 2;
constexpr size_t S5_HIN = S5_E + (size_t)256 * 16 * 128 * 4;
constexpr size_t S5_YSB = S5_HIN + (size_t)256 * 16 * 128 * 4;
constexpr size_t ROPE_TAB = S5_YSB + 32 * 256 * 2;
constexpr size_t WS_END3 = ROPE_TAB + (size_t)(SEQ + 1) * 16 * 4;
DI void rope_item(Ctx& C, int it) {
    const int lane = C.lane, idx = 4 * it + (lane >> 4), j = lane & 15; if (idx > SEQ) return;
    const float pos = (idx == SEQ) ? (float)PAST : (float)idx; const float ang = pos * powf(500000.f, -(float)(j & 7) * 0.125f);
    ((float*)(C.ws + ROPE_TAB))[(size_t)idx * 16 + j] = (j < 8) ? cosf(ang) : sinf(ang);
}
DI void s5_param_item(Ctx& C, int it) {
    const int lane = C.lane, l = it >> 4, g = it & 15, pg = (l * 16 + g) * 64 + lane;
    const float dt = expf(inF(C, 14)[l * 16 + g]); const float ar = inF(C, 12)[pg], ai = inF(C, 13)[pg];
    const float mag = expf(ar * dt), ang = ai * dt, are = mag * cosf(ang), aim = mag * sinf(ang);
    const float den = ar * ar + ai * ai, nr = are - 1.f, fre = (nr * ar + aim * ai) / den, fim = (aim * ar - nr * ai) / den;
    float* P = (float*)(C.ws + S5_P) + (size_t)(l * 16 + g) * 36 * 64 + lane;
    float pr = are, pi = aim;
#pragma unroll
    for (int k = 0; k < 6; ++k) { const float nr2 = pr * pr - pi * pi, ni2 = 2.f * pr * pi; pr = nr2; pi = ni2; }
    P[0] = are; P[64] = aim; P[128] = pr; P[192] = pi;
#pragma unroll
    for (int c = 0; c < 16; ++c) { const float br = inF(C, 15)[(size_t)pg * 16 + c], bi = inF(C, 16)[(size_t)pg * 16 + c]; P[(4 + c) * 64] = fre * br - fim * bi; P[(20 + c) * 64] = fre * bi + fim * br; }
    unsigned* CC = (unsigned*)(C.ws + S5_CC) + (size_t)(l * 16 + g) * 16 * 64;
#pragma unroll
    for (int c = 0; c < 16; ++c) CC[c * 64 + lane] = pk2(inF(C, 17)[((size_t)(l * 16 + g) * 16 + c) * 64 + lane], -inF(C, 18)[((size_t)(l * 16 + g) * 16 + c) * 64 + lane]);
}
DI void s5_pass1_chunk(Ctx& C, int l, int b, int c) {
    const int lane = C.lane, wave = C.wave; const size_t row0 = (size_t)b * SEQ + (size_t)c * 64;
    LASQ float* US = (LASQ float*)(C.lds + wave * 4096);
#pragma unroll 1
    for (int gi = 0; gi < 2; ++gi) { const int g = 2 * wave + gi;
        { const float* up = projp(C) + (row0 + lane) * NP + C_S5U + g * 16;
#pragma unroll
          for (int j = 0; j < 4; ++j) *(LASQ f32x4*)(US + lane * 16 + 4 * j) = *(const f32x4*)(up + 4 * j); }
        const float* P = (const float*)(C.ws + S5_P) + (size_t)(l * 16 + g) * 36 * 64 + lane;
        const float are = P[0], aim = P[64]; f32x2 bb[16];
#pragma unroll
        for (int k = 0; k < 16; ++k) { bb[k].x = P[(4 + k) * 64]; bb[k].y = P[(20 + k) * 64]; }
        asm volatile("s_waitcnt lgkmcnt(0)" ::: "memory");
        float hr = 0.f, hi = 0.f;
#pragma unroll 4
        for (int t = 0; t < 64; ++t) { f32x2 xa = {0.f, 0.f}, xb = {0.f, 0.f};
#pragma unroll
            for (int j = 0; j < 4; ++j) { const f32x4 u = *(const LASQ f32x4*)(US + t * 16 + 4 * j);
                xa += bb[4 * j] * u.x + bb[4 * j + 1] * u.y; xb += bb[4 * j + 2] * u.z + bb[4 * j + 3] * u.w; }
            const float xr = xa.x + xb.x, xi = xa.y + xb.y;
            const float nhr = are * hr - aim * hi + xr, nhi = are * hi + aim * hr + xi; hr = nhr; hi = nhi; }
        float* E = (float*)(C.ws + S5_E) + ((size_t)((b * 64 + c) * 16 + g)) * 128; E[lane] = hr; E[64 + lane] = hi;
        asm volatile("s_waitcnt lgkmcnt(0)" ::: "memory");
    }
    __syncthreads();
}
DI void s5_carry_item(Ctx& C, int l, int it) {
    const int lane = C.lane, b = it >> 4, g = it & 15;
    const float* P = (const float*)(C.ws + S5_P) + (size_t)(l * 16 + g) * 36 * 64 + lane; const float a6r = P[128], a6i = P[192];
    const float* E = (const float*)(C.ws + S5_E); float* HIN = (float*)(C.ws + S5_HIN);
    float hr = 0.f, hi = 0.f;
    for (int c0 = 0; c0 < 64; c0 += 8) { float er[8], ei[8];
#pragma unroll
        for (int e = 0; e < 8; ++e) { const size_t o = ((size_t)((b * 64 + c0 + e) * 16 + g)) * 128; er[e] = E[o + lane]; ei[e] = E[o + 64 + lane]; }
#pragma unroll
        for (int e = 0; e < 8; ++e) { const size_t o = ((size_t)((b * 64 + c0 + e) * 16 + g)) * 128; HIN[o + lane] = hr; HIN[o + 64 + lane] = hi;
            const float nr = a6r * hr - a6i * hi + er[e], ni = a6r * hi + a6i * hr + ei[e]; hr = nr; hi = ni; } }
    const size_t so = ((size_t)(l * NB + b) * 16 + g) * 64 + lane; C.out[O_PS5R + so] = hr; C.out[O_PS5I + so] = hi;
}
constexpr int S5_HP = 136, S5_YP = 264;
DI void s5_out_chunk(Ctx& C, int l, int b, int c) {
    const int lane = C.lane, wave = C.wave, li = lane & 15, fq = lane >> 4; const size_t row0 = (size_t)b * SEQ + (size_t)c * 64;
    LASQ float* US = (LASQ float*)(C.lds + wave * 8448); LASQ unsigned char* HS = C.lds + wave * 8448 + 4096; LASQ unsigned char* Y = C.lds + 8 * 8448;
#pragma unroll 1
    for (int gi = 0; gi < 2; ++gi) { const int g = 2 * wave + gi;
        { const float* up = projp(C) + (row0 + lane) * NP + C_S5U + g * 16;
#pragma unroll
          for (int j = 0; j < 4; ++j) *(LASQ f32x4*)(US + lane * 16 + 4 * j) = *(const f32x4*)(up + 4 * j); }
        const float* P = (const float*)(C.ws + S5_P) + (size_t)(l * 16 + g) * 36 * 64 + lane;
        const float are = P[0], aim = P[64]; f32x2 bb[16];
#pragma unroll
        for (int k = 0; k < 16; ++k) { bb[k].x = P[(4 + k) * 64]; bb[k].y = P[(20 + k) * 64]; }
        bf16x8v cf[4];
        { const bf16* cc = (const bf16*)(C.ws + S5_CC) + ((size_t)(l * 16 + g) * 16 + li) * 128;
#pragma unroll
          for (int ks = 0; ks < 4; ++ks) cf[ks] = *(const bf16x8v*)(cc + 32 * ks + 8 * fq); }
        const f32x4 dd = *(const f32x4*)(inF(C, 19) + l * 256 + g * 16 + 4 * fq);
        const float* HIN = (const float*)(C.ws + S5_HIN) + ((size_t)((b * 64 + c) * 16 + g)) * 128; float hr = HIN[lane], hi = HIN[64 + lane];
        asm volatile("s_waitcnt lgkmcnt(0)" ::: "memory");
#pragma unroll 1
        for (int tb = 0; tb < 4; ++tb) {
#pragma unroll 4
            for (int i = 0; i < 16; ++i) { const int t = 16 * tb + i; f32x2 xa = {0.f, 0.f}, xb = {0.f, 0.f};
#pragma unroll
                for (int j = 0; j < 4; ++j) { const f32x4 u = *(const LASQ f32x4*)(US + t * 16 + 4 * j);
                    xa += bb[4 * j] * u.x + bb[4 * j + 1] * u.y; xb += bb[4 * j + 2] * u.z + bb[4 * j + 3] * u.w; }
                const float xr = xa.x + xb.x, xi = xa.y + xb.y;
                const float nhr = are * hr - aim * hi + xr, nhi = are * hi + aim * hr + xi; hr = nhr; hi = nhi;
                *(LASQ unsigned*)(HS + i * (S5_HP * 2) + 4 * lane) = pk2(hr, hi); }
            asm volatile("s_waitcnt lgkmcnt(0)" ::: "memory");
            f32x4 acc = {0.f, 0.f, 0.f, 0.f};
#pragma unroll
            for (int ks = 0; ks < 4; ++ks) { const bf16x8v hf = *(const LASQ bf16x8v*)(HS + li * (S5_HP * 2) + (32 * ks + 8 * fq) * 2); acc = MFMA16(cf[ks], hf, acc); }
            const f32x4 u = *(const LASQ f32x4*)(US + (16 * tb + li) * 16 + 4 * fq);
            u32x2 w; w.x = pg8::cvt_pk_bf16(gelu_tanh_(acc[0] + dd.x * u.x), gelu_tanh_(acc[1] + dd.y * u.y)); w.y = pg8::cvt_pk_bf16(gelu_tanh_(acc[2] + dd.z * u.z), gelu_tanh_(acc[3] + dd.w * u.w));
            *(LASQ u32x2*)(Y + (16 * tb + li) * (S5_YP * 2) + (g * 16 + 4 * fq) * 2) = w;
            asm volatile("s_waitcnt lgkmcnt(0)" ::: "memory");
        }
    }
    __syncthreads();
    f32x4 z[2][4];
#pragma unroll
    for (int at = 0; at < 2; ++at)
#pragma unroll
        for (int bt = 0; bt < 4; ++bt) z[at][bt] = (f32x4){0.f, 0.f, 0.f, 0.f};
    const bf16* wg = (const bf16*)(C.ws + S5_WGT) + (size_t)l * 256 * 256;
#pragma unroll 2
    for (int ks = 0; ks < 8; ++ks) { bf16x8v af[2], bfr[4];
#pragma unroll
        for (int at = 0; at < 2; ++at) af[at] = *(const bf16x8v*)(wg + (size_t)(32 * wave + 16 * at + li) * 256 + 32 * ks + 8 * fq);
#pragma unroll
        for (int bt = 0; bt < 4; ++bt) bfr[bt] = *(const LASQ bf16x8v*)(Y + (16 * bt + li) * (S5_YP * 2) + (32 * ks + 8 * fq) * 2);
#pragma unroll
        for (int at = 0; at < 2; ++at)
#pragma unroll
            for (int bt = 0; bt < 4; ++bt) z[at][bt] = MFMA16(af[at], bfr[bt], z[at][bt]); }
#pragma unroll
    for (int at = 0; at < 2; ++at) { const int n0 = 32 * wave + 16 * at + 4 * fq; const f32x4 bg = *(const f32x4*)(inF(C, 21) + l * 256 + n0);
#pragma unroll
        for (int bt = 0; bt < 4; ++bt) { const int t = 16 * bt + li; const u32x2 yw = *(const LASQ u32x2*)(Y + t * (S5_YP * 2) + n0 * 2);
            u32x2 w; w.x = pg8::cvt_pk_bf16(bflo(yw.x) * sigmoid_(z[at][bt][0] + bg.x), bfhi(yw.x) * sigmoid_(z[at][bt][1] + bg.y)); w.y = pg8::cvt_pk_bf16(bflo(yw.y) * sigmoid_(z[at][bt][2] + bg.z), bfhi(yw.y) * sigmoid_(z[at][bt][3] + bg.w));
            *(u32x2*)(ybuf(C, 0) + (row0 + t) * 256 + n0) = w; } }
    __syncthreads();
}
#ifndef GDN_CUT
#define GDN_CUT 4
#endif

constexpr size_t WS_GDN = WS_END3;
constexpr size_t GDN_Q = WS_GDN, GDN_K = GDN_Q + (size_t)MPAD * 256 * 2;
constexpr size_t GDN_GC = GDN_K + (size_t)MPAD * 256 * 2, GDN_BE = GDN_GC + 1024 * 64 * 4;
constexpr size_t GDN_W = GDN_BE + 1024 * 64 * 4;
constexpr size_t GDN_UT = GDN_W + (size_t)1024 * 4096 * 2;
constexpr size_t GDN_AC = GDN_UT + (size_t)1024 * 4096 * 4;
constexpr size_t GDN_BCT = GDN_AC + (size_t)1024 * 4096 * 4;
constexpr size_t GDN_SC = GDN_BCT + (size_t)1024 * 4096 * 4;
constexpr size_t WS_END4 = GDN_SC + (size_t)1024 * 4096 * 4;
constexpr int GD_MP = 72;
constexpr int GD_HSZ = 512 + 64 * LT * 2 + 64 * GD_MP * 4;
DI float wave_incl_scan(float x, int lane) {
#pragma unroll
    for (int o = 1; o < 64; o <<= 1) { const float y = __shfl_up(x, o); if (lane >= o) x += y; }
    return x;
}
#define GDN_CONV64(out, chan_off, cwp)  do { const float w0 = (cwp)[0], w1 = (cwp)[768], w2 = (cwp)[2 * 768], w3 = (cwp)[3 * 768]; \
        const float* p0 = projp(C) + row0 * NP + (chan_off); float x0 = 0.f, x1 = 0.f, x2 = 0.f; \
        if (c > 0) { x0 = *(p0 - 3 * (size_t)NP); x1 = *(p0 - 2 * (size_t)NP); x2 = *(p0 - (size_t)NP); } \
        _Pragma("unroll") for (int t = 0; t < 64; ++t) { const float x3 = p0[(size_t)t * NP]; out[t] = silu_(w0 * x0 + w1 * x1 + w2 * x2 + w3 * x3); x0 = x1; x1 = x2; x2 = x3; } } while (0)
DI void gdn_prep_chunk(Ctx& C, int l, int b, int c) {
    const int lane = C.lane, wave = C.wave, h = wave >> 1, role = wave & 1, li = lane & 15, fq = lane >> 4;
    const size_t row0 = (size_t)b * SEQ + (size_t)c * 64; const int unit = ((b * 64 + c) * 4 + h);
    LASQ unsigned char* HB = C.lds + h * GD_HSZ;
    LASQ float* GC = (LASQ float*)HB; LASQ float* BE = GC + 64; LASQ unsigned char* KH = HB + 512; LASQ float* M = (LASQ float*)(HB + 512 + 64 * LT * 2);
    const float* cw = inF(C, 25) + (size_t)l * 4 * 768;
    float X[64];
    if (role == 0) {
        {
            const float* pr = projp(C) + (row0 + lane) * NP; const float beta = sigmoid_(pr[C_DB + h]);
            const float g = -expf(inF(C, 26)[l * 4 + h]) * softplus_(pr[C_DA + h] + inF(C, 27)[l * 4 + h]);
            const float gc = wave_incl_scan(g, lane); GC[lane] = gc; BE[lane] = beta;
            ((float*)(C.ws + GDN_GC))[(size_t)unit * 64 + lane] = gc; ((float*)(C.ws + GDN_BE))[(size_t)unit * 64 + lane] = beta; }
        GDN_CONV64(X, C_DK + h * 64 + lane, cw + 256 + h * 64 + lane);
        bf16* Kg = (bf16*)(C.ws + GDN_K) + row0 * 256 + h * 64 + lane;
#pragma unroll
        for (int t = 0; t < 64; ++t) { X[t] *= rsq_(wsum(X[t] * X[t]) + 1e-6f); const unsigned short kb = (unsigned short)f2bf(X[t]);
            *(LASQ unsigned short*)(KH + t * (LT * 2) + lane * 2) = kb; Kg[(size_t)t * 256] = kb; }
    } else {
        {
            float Qv[64];
            GDN_CONV64(Qv, C_DQ + h * 64 + lane, cw + h * 64 + lane);
            bf16* Qg = (bf16*)(C.ws + GDN_Q) + row0 * 256 + h * 64 + lane;
#pragma unroll
            for (int t = 0; t < 64; ++t) Qg[(size_t)t * 256] = (bf16)f2bf(Qv[t] * (0.125f * rsq_(wsum(Qv[t] * Qv[t]) + 1e-6f)));
        }
        asm volatile("" ::: "memory");
        GDN_CONV64(X, C_DV + h * 64 + lane, cw + 512 + h * 64 + lane);
    }
    __syncthreads();
#if GDN_CUT >= 1
    {
        float zf; asm volatile("v_mov_b32 %0, 0" : "=v"(zf));
#pragma unroll
        for (int it = 0; it < 2; ++it) { const int i0 = 16 * (2 * role + it); bf16x8v bfr[2];
#pragma unroll
            for (int ks = 0; ks < 2; ++ks) bfr[ks] = *(const LASQ bf16x8v*)(KH + (i0 + li) * (LT * 2) + (32 * ks + 8 * fq) * 2);
            const float gi = GC[i0 + li];
#pragma unroll
            for (int jt = 0; jt < 4; ++jt) { f32x4 acc = {0.f, 0.f, 0.f, 0.f};
#pragma unroll
                for (int ks = 0; ks < 2; ++ks) { const bf16x8v af = *(const LASQ bf16x8v*)(KH + (16 * jt + li) * (LT * 2) + (32 * ks + 8 * fq) * 2); acc = MFMA16(af, bfr[ks], acc); }
                f32x4 mv;
#pragma unroll
                for (int r = 0; r < 4; ++r) { const int j = 16 * jt + 4 * fq + r; mv[r] = (i0 + li > j) ? __expf(gi - GC[j]) * BE[j] * acc[r] : zf; }
                *(LASQ f32x4*)(M + (i0 + li) * GD_MP + 16 * jt + 4 * fq) = mv; } }
    }
#endif
    __syncthreads();
    const float glast = GC[63];
#if GDN_CUT >= 2
    if (role == 0) {
#pragma unroll
        for (int j8 = 0; j8 < 8; ++j8) { float kw[8];
#pragma unroll
            for (int e = 0; e < 8; ++e) { const int j = 8 * j8 + e; kw[e] = X[j] * __expf(glast - GC[j]) * BE[j]; }
            u32x4 w; w.x = pk2(kw[0], kw[1]); w.y = pk2(kw[2], kw[3]); w.z = pk2(kw[4], kw[5]); w.w = pk2(kw[6], kw[7]);
            *(LASQ u32x4*)(KH + lane * (LT * 2) + j8 * 16) = w; }
#pragma unroll
        for (int i = 0; i < 64; ++i) X[i] *= __expf(GC[i]);
    }
#endif
#if GDN_CUT >= 3
#pragma unroll
    for (int i = 1; i < 64; ++i) { float s = 0.f;
#pragma unroll
        for (int j4 = 0; j4 < (i + 3) / 4; ++j4) { const f32x4 mr = *(const LASQ f32x4*)(M + i * GD_MP + 4 * j4);
            s += mr.x * X[4 * j4];
            if (4 * j4 + 1 < i) s += mr.y * X[4 * j4 + 1];
            if (4 * j4 + 2 < i) s += mr.z * X[4 * j4 + 2];
            if (4 * j4 + 3 < i) s += mr.w * X[4 * j4 + 3]; }
        X[i] -= s; asm volatile("" : "+v"(X[i]) :: "memory"); }
#endif
    __syncthreads();
    LASQ unsigned char* WT = (LASQ unsigned char*)M; LASQ unsigned char* UT = WT + 64 * LT * 2;
    {   LASQ unsigned char* dst = (role == 0 ? WT : UT) + lane * (LT * 2);
#pragma unroll
        for (int j8 = 0; j8 < 8; ++j8) { u32x4 w; w.x = pk2(X[8 * j8], X[8 * j8 + 1]); w.y = pk2(X[8 * j8 + 2], X[8 * j8 + 3]); w.z = pk2(X[8 * j8 + 4], X[8 * j8 + 5]); w.w = pk2(X[8 * j8 + 6], X[8 * j8 + 7]);
            *(LASQ u32x4*)(dst + j8 * 16) = w; }
        if (role == 0) { bf16* Wg = (bf16*)(C.ws + GDN_W) + (size_t)unit * 4096 + lane;
#pragma unroll
            for (int i = 0; i < 64; ++i) Wg[i * 64] = (bf16)f2bf(X[i]); }
        else { float* Ug = (float*)(C.ws + GDN_UT) + (size_t)unit * 4096 + lane * 64;
#pragma unroll
            for (int i4 = 0; i4 < 16; ++i4) *(f32x4*)(Ug + 4 * i4) = (f32x4){X[4 * i4], X[4 * i4 + 1], X[4 * i4 + 2], X[4 * i4 + 3]}; }
    }
    __syncthreads();
#if GDN_CUT >= 4
    if (role == 0) {
        bf16* ACh = (bf16*)(C.ws + GDN_AC) + (size_t)unit * 4096; bf16* ACl = ACh + (size_t)1024 * 4096; const float eg = __expf(glast);
#pragma unroll 1
        for (int bt = 0; bt < 4; ++bt) { bf16x8v bfr[2];
#pragma unroll
            for (int ks = 0; ks < 2; ++ks) bfr[ks] = *(const LASQ bf16x8v*)(KH + (16 * bt + li) * (LT * 2) + (32 * ks + 8 * fq) * 2);
#pragma unroll
            for (int at = 0; at < 4; ++at) { f32x4 acc = {0.f, 0.f, 0.f, 0.f};
#pragma unroll
                for (int ks = 0; ks < 2; ++ks) { const bf16x8v af = *(const LASQ bf16x8v*)(WT + (16 * at + li) * (LT * 2) + (32 * ks + 8 * fq) * 2); acc = MFMA16(af, bfr[ks], acc); }
                f32x4 o;
#pragma unroll
                for (int r = 0; r < 4; ++r) o[r] = ((16 * at + 4 * fq + r) == (16 * bt + li) ? eg : 0.f) - acc[r];
                u32x2 wh, wl; wh.x = pg8::cvt_pk_bf16(o[0], o[1]); wh.y = pg8::cvt_pk_bf16(o[2], o[3]);
                wl.x = pg8::cvt_pk_bf16(o[0] - bflo(wh.x), o[1] - bfhi(wh.x)); wl.y = pg8::cvt_pk_bf16(o[2] - bflo(wh.y), o[3] - bfhi(wh.y));
                const int pos = (16 * bt + li) * 64 + 32 * (at >> 1) + 8 * fq + 4 * (at & 1);
                *(u32x2*)(ACh + pos) = wh; *(u32x2*)(ACl + pos) = wl; } }
    } else {
        float* BCg = (float*)(C.ws + GDN_BCT) + (size_t)unit * 4096;
#pragma unroll 1
        for (int bt = 0; bt < 4; ++bt) { bf16x8v bfr[2];
#pragma unroll
            for (int ks = 0; ks < 2; ++ks) bfr[ks] = *(const LASQ bf16x8v*)(UT + (16 * bt + li) * (LT * 2) + (32 * ks + 8 * fq) * 2);
#pragma unroll
            for (int at = 0; at < 4; ++at) { f32x4 acc = {0.f, 0.f, 0.f, 0.f};
#pragma unroll
                for (int ks = 0; ks < 2; ++ks) { const bf16x8v af = *(const LASQ bf16x8v*)(KH + (16 * at + li) * (LT * 2) + (32 * ks + 8 * fq) * 2); acc = MFMA16(af, bfr[ks], acc); }
                *(f32x4*)(BCg + (16 * bt + li) * 64 + 16 * at + 4 * fq) = acc; } }
    }
#endif
    __syncthreads();
}
DI void bf_split(const f32x4 a, const f32x4 b, bf16x8v& hi, bf16x8v& lo) {
    u32x4 w; w.x = pg8::cvt_pk_bf16(a.x, a.y); w.y = pg8::cvt_pk_bf16(a.z, a.w); w.z = pg8::cvt_pk_bf16(b.x, b.y); w.w = pg8::cvt_pk_bf16(b.z, b.w);
    hi = __builtin_bit_cast(bf16x8v, w);
    const f32x4 ra = {a.x - bflo(w.x), a.y - bfhi(w.x), a.z - bflo(w.y), a.w - bfhi(w.y)}, rb = {b.x - bflo(w.z), b.y - bfhi(w.z), b.z - bflo(w.w), b.w - bfhi(w.w)};
    lo = cvt8(ra, rb);
}
DI void gdn_scan_item(Ctx& C, int l, int it) {
    const int lane = C.lane, li = lane & 15, fq = lane >> 4, b = it >> 4, h = (it >> 2) & 3, vs = it & 3, v = 16 * vs + li;
    const bf16* ACh = (const bf16*)(C.ws + GDN_AC); const bf16* ACl = ACh + (size_t)1024 * 4096; const float* BCT = (const float*)(C.ws + GDN_BCT); float* SC = (float*)(C.ws + GDN_SC);
    f32x4 S[4];
#pragma unroll
    for (int at = 0; at < 4; ++at) S[at] = (f32x4){0.f, 0.f, 0.f, 0.f};
    bf16x8v Ahn[4][2], Aln[4][2]; f32x4 Bn[4];
#define GDN_SCAN_LOAD(cc) do { const size_t u_ = (size_t)((b * 64 + (cc)) * 4 + h) * 4096; \
        _Pragma("unroll") for (int at = 0; at < 4; ++at) { Bn[at] = *(const f32x4*)(BCT + u_ + v * 64 + 16 * at + 4 * fq); \
            _Pragma("unroll") for (int ks = 0; ks < 2; ++ks) { Ahn[at][ks] = *(const bf16x8v*)(ACh + u_ + (16 * at + li) * 64 + 32 * ks + 8 * fq); Aln[at][ks] = *(const bf16x8v*)(ACl + u_ + (16 * at + li) * 64 + 32 * ks + 8 * fq); } } } while (0)
    GDN_SCAN_LOAD(0);
    for (int c = 0; c < 64; ++c) {
        bf16x8v Ah[4][2], Al[4][2]; f32x4 Bc[4];
#pragma unroll
        for (int at = 0; at < 4; ++at) { Bc[at] = Bn[at];
#pragma unroll
            for (int ks = 0; ks < 2; ++ks) { Ah[at][ks] = Ahn[at][ks]; Al[at][ks] = Aln[at][ks]; } }
        if (c + 1 < 64) GDN_SCAN_LOAD(c + 1);
        const size_t u = (size_t)((b * 64 + c) * 4 + h) * 4096;
#pragma unroll
        for (int at = 0; at < 4; ++at) *(f32x4*)(SC + u + v * 64 + 16 * at + 4 * fq) = S[at];
        bf16x8v sh[2], sl[2];
#pragma unroll
        for (int ks = 0; ks < 2; ++ks) bf_split(S[2 * ks], S[2 * ks + 1], sh[ks], sl[ks]);
#pragma unroll
        for (int at = 0; at < 4; ++at) { f32x4 acc = Bc[at];
#pragma unroll
            for (int ks = 0; ks < 2; ++ks) { acc = MFMA16(Ah[at][ks], sh[ks], acc); acc = MFMA16(Ah[at][ks], sl[ks], acc); acc = MFMA16(Al[at][ks], sh[ks], acc); }
            S[at] = acc; }
    }
#undef GDN_SCAN_LOAD
    float* so = C.out + O_PGDN + ((size_t)(l * NB + b) * 4 + h) * 4096 + v;
#pragma unroll
    for (int at = 0; at < 4; ++at)
#pragma unroll
        for (int r = 0; r < 4; ++r) so[(size_t)(16 * at + 4 * fq + r) * 64] = S[at][r];
}
constexpr int GO_HSZ = 512 + 4 * 64 * LT * 2;
DI void gdn_out_chunk(Ctx& C, int l, int b, int c) {
    const int lane = C.lane, wave = C.wave, hh = wave >> 2, qw = wave & 3, li = lane & 15, fq = lane >> 4;
    const size_t row0 = (size_t)b * SEQ + (size_t)c * 64;
    LASQ unsigned char* HB = C.lds + hh * GO_HSZ; constexpr int TB = 64 * LT * 2;
    LASQ float* GC = (LASQ float*)HB; LASQ float* BE = GC + 64; LASQ unsigned char* KH = HB + 512; LASQ unsigned char* WL = KH + TB; LASQ unsigned char* ST = WL + TB; LASQ unsigned char* UTL = ST + TB;
    const float* gnp = inF(C, 28) + l * 64;
#pragma unroll 1
    for (int pass = 0; pass < 2; ++pass) { const int h = 2 * pass + hh; const int unit = ((b * 64 + c) * 4 + h);
        {
            const int x = (qw << 6) | lane, r = x >> 2, qd = x & 3;
            const bf16* kg = (const bf16*)(C.ws + GDN_K) + (row0 + r) * 256 + h * 64 + 16 * qd; const bf16* wgp = (const bf16*)(C.ws + GDN_W) + (size_t)unit * 4096 + r * 64 + 16 * qd;
            const float* sg = (const float*)(C.ws + GDN_SC) + (size_t)unit * 4096 + r * 64 + 16 * qd;
#pragma unroll
            for (int e = 0; e < 2; ++e) { *(LASQ u32x4*)(KH + r * (LT * 2) + (16 * qd + 8 * e) * 2) = *(const u32x4*)(kg + 8 * e); *(LASQ u32x4*)(WL + r * (LT * 2) + (16 * qd + 8 * e) * 2) = *(const u32x4*)(wgp + 8 * e);
                const f32x4 s0 = *(const f32x4*)(sg + 8 * e), s1 = *(const f32x4*)(sg + 8 * e + 4); *(LASQ bf16x8v*)(ST + r * (LT * 2) + (16 * qd + 8 * e) * 2) = cvt8(s0, s1); }
            if (x < 64) { GC[x] = ((const float*)(C.ws + GDN_GC))[(size_t)unit * 64 + x]; BE[x] = ((const float*)(C.ws + GDN_BE))[(size_t)unit * 64 + x]; }
        }
        __syncthreads();
        {
            bf16x8v af[2];
#pragma unroll
            for (int ks = 0; ks < 2; ++ks) af[ks] = *(const LASQ bf16x8v*)(WL + (16 * qw + li) * (LT * 2) + (32 * ks + 8 * fq) * 2);
            const float* Ug = (const float*)(C.ws + GDN_UT) + (size_t)unit * 4096;
#pragma unroll
            for (int bt = 0; bt < 4; ++bt) { f32x4 acc = {0.f, 0.f, 0.f, 0.f};
#pragma unroll
                for (int ks = 0; ks < 2; ++ks) { const bf16x8v bfr = *(const LASQ bf16x8v*)(ST + (16 * bt + li) * (LT * 2) + (32 * ks + 8 * fq) * 2); acc = MFMA16(af[ks], bfr, acc); }
                const f32x4 uu = *(const f32x4*)(Ug + (16 * bt + li) * 64 + 16 * qw + 4 * fq) - acc;
                u32x2 w; w.x = pg8::cvt_pk_bf16(uu.x, uu.y); w.y = pg8::cvt_pk_bf16(uu.z, uu.w);
                *(LASQ u32x2*)(UTL + (16 * bt + li) * (LT * 2) + (16 * qw + 4 * fq) * 2) = w; }
        }
        __syncthreads();
        {   const int iq = 16 * qw + li; const size_t row = row0 + iq;
            bf16x8v qf[2];
#pragma unroll
            for (int ks = 0; ks < 2; ++ks) qf[ks] = *(const bf16x8v*)((const bf16*)(C.ws + GDN_Q) + row * 256 + h * 64 + 32 * ks + 8 * fq);
            const float gi = GC[iq]; f32x4 s[4];
#pragma unroll
            for (int jt = 0; jt < 4; ++jt) { s[jt] = (f32x4){0.f, 0.f, 0.f, 0.f};
#pragma unroll
                for (int ks = 0; ks < 2; ++ks) { const bf16x8v kf = *(const LASQ bf16x8v*)(KH + (16 * jt + li) * (LT * 2) + (32 * ks + 8 * fq) * 2); s[jt] = MFMA16(kf, qf[ks], s[jt]); }
#pragma unroll
                for (int r = 0; r < 4; ++r) { const int j = 16 * jt + 4 * fq + r; s[jt][r] = (j <= iq) ? s[jt][r] * __expf(gi - GC[j]) * BE[j] : 0.f; } }
            bf16x8v pf[2];
#pragma unroll
            for (int ks = 0; ks < 2; ++ks) pf[ks] = cvt8(s[2 * ks], s[2 * ks + 1]);
            const float eg = __expf(gi); f32x4 o[4]; float ss = 0.f;
#pragma unroll
            for (int vt = 0; vt < 4; ++vt) { f32x4 a1 = {0.f, 0.f, 0.f, 0.f}, a2 = {0.f, 0.f, 0.f, 0.f};
#pragma unroll
                for (int ks = 0; ks < 2; ++ks) { const LASQ unsigned char* ur = UTL + (16 * vt + li) * (LT * 2);
                    const bf16x4v lo = *(const LASQ bf16x4v*)(ur + (32 * ks + 4 * fq) * 2), hi = *(const LASQ bf16x4v*)(ur + (32 * ks + 16 + 4 * fq) * 2);
                    a1 = MFMA16(__builtin_shufflevector(lo, hi, 0, 1, 2, 3, 4, 5, 6, 7), pf[ks], a1);
                    const bf16x8v sf = *(const LASQ bf16x8v*)(ST + (16 * vt + li) * (LT * 2) + (32 * ks + 8 * fq) * 2); a2 = MFMA16(sf, qf[ks], a2); }
                o[vt] = a1 + a2 * eg; ss += (o[vt][0] * o[vt][0] + o[vt][1] * o[vt][1]) + (o[vt][2] * o[vt][2] + o[vt][3] * o[vt][3]); }
            ss += __shfl_xor(ss, 16); ss += __shfl_xor(ss, 32);
            const float rinv = rsq_(ss * (1.f / 64.f) + 1e-6f);
            const float* zr = projp(C) + row * NP + C_DZ + h * 64; bf16* yc = ybuf(C, 2) + row * 256 + h * 64;
#pragma unroll
            for (int vt = 0; vt < 4; ++vt) { const f32x4 g = *(const f32x4*)(zr + 16 * vt + 4 * fq), gn = *(const f32x4*)(gnp + 16 * vt + 4 * fq);
                u32x2 w; w.x = pg8::cvt_pk_bf16(o[vt][0] * rinv * gn.x * silu_(g.x), o[vt][1] * rinv * gn.y * silu_(g.y)); w.y = pg8::cvt_pk_bf16(o[vt][2] * rinv * gn.z * silu_(g.z), o[vt][3] * rinv * gn.w * silu_(g.w));
                *(u32x2*)(yc + 16 * vt + 4 * fq) = w; }
        }
        __syncthreads();
    }
}

constexpr size_t WS_MB = WS_END4;
constexpr size_t MB_Q = WS_MB;
constexpr size_t MB_K = MB_Q + (size_t)MP * 256 * 2;
constexpr size_t MB_VT = MB_K + (size_t)MP * 256 * 2;
constexpr size_t MB_KSUM = MB_VT + (size_t)MP * 256 * 2;
constexpr size_t WS_END5 = MB_KSUM + (size_t)NB * 64 * 256 * 4;
DI void moba_prep_chunk(Ctx& C, int l, int b, int c, const float* ropetab) {
    const int tid = C.tid, lane = C.lane, wave = C.wave; const size_t row0 = (size_t)b * SEQ + (size_t)c * 64;
    LASQ unsigned char* VTL = C.lds; LASQ float* KS = (LASQ float*)(C.lds + 256 * LT * 2);
    const float qnv = inF(C, 29)[l * 64 + lane], knv = inF(C, 30)[l * 64 + lane]; const float qs = 0.125f * 1.4426950408889634f;
    float ks[4] = {0.f, 0.f, 0.f, 0.f};
    float* MQ = tmpbuf(C, T_MQ); bf16* QB = (bf16*)(C.ws + MB_Q); bf16* KB = (bf16*)(C.ws + MB_K); bf16* VB = (bf16*)(C.ws + MB_VT);
#pragma unroll 1
    for (int half = 0; half < 2; ++half) {
        float xq[4][4], xk[4][4], xv[4][4];
#pragma unroll
        for (int i = 0; i < 4; ++i) { const float* pr = projp(C) + (row0 + 8 * wave + 4 * half + i) * NP;
#pragma unroll
            for (int hh = 0; hh < 4; ++hh) { xq[i][hh] = pr[C_MQ + hh * 64 + lane]; xk[i][hh] = pr[C_MK + hh * 64 + lane]; xv[i][hh] = pr[C_MV + hh * 64 + lane]; } }
#pragma unroll
        for (int i = 0; i < 4; ++i) { const int t = 8 * wave + 4 * half + i; const size_t row = row0 + t;
            const float* rt = ropetab + (size_t)(c * 64 + t) * 16; const float cs = rt[lane & 7], sn = rt[8 + (lane & 7)];
            float* MK = C.out + O_PMK + ((size_t)l * MP + row) * 256; float* MV = C.out + O_PMV + ((size_t)l * MP + row) * 256;
#pragma unroll
            for (int hh = 0; hh < 4; ++hh) { float q = xq[i][hh], k = xk[i][hh];
                q = q * rsq_(wsum(q * q) * (1.f / 64.f) + 1e-6f) * qnv; k = k * rsq_(wsum(k * k) * (1.f / 64.f) + 1e-6f) * knv;
                const float pq = __shfl_xor(q, 8), pk = __shfl_xor(k, 8);
                if (lane < 8) { q = q * cs - pq * sn; k = k * cs - pk * sn; } else if (lane < 16) { q = q * cs + pq * sn; k = k * cs + pk * sn; }
                MQ[row * 256 + hh * 64 + lane] = q; QB[row * 256 + hh * 64 + lane] = (bf16)f2bf(q * qs);
                MK[hh * 64 + lane] = k; KB[row * 256 + hh * 64 + lane] = (bf16)f2bf(k); ks[hh] += k;
                MV[hh * 64 + lane] = xv[i][hh]; VB[row * 256 + hh * 64 + lane] = (bf16)f2bf(xv[i][hh]); } }
    }
#pragma unroll
    for (int hh = 0; hh < 4; ++hh) KS[wave * 256 + hh * 64 + lane] = ks[hh];
    __syncthreads();
    if (tid < 256) { float s = 0.f;
#pragma unroll
        for (int w = 0; w < 8; ++w) s += KS[w * 256 + tid];
        ((float*)(C.ws + MB_KSUM))[((size_t)b * 64 + c) * 256 + tid] = s; }
    if (c == 63) { for (int i = tid; i < 3 * 768; i += 512) { const int j = i / 768, ch = i - j * 768; C.out[O_PCONV + (((size_t)l * NB + b) * 3 + j) * 768 + ch] = projp(C)[(row0 + 61 + j) * NP + C_DQ + ch]; } }
    __syncthreads();
}

constexpr size_t WS_KMS2 = WS_END5;
constexpr size_t WS_END6 = WS_KMS2 + (size_t)2 * SB * 32 * 256 * 4;
DI void lds_barrier_() { asm volatile("s_waitcnt lgkmcnt(0)" ::: "memory"); __builtin_amdgcn_s_barrier(); asm volatile("" ::: "memory"); }
DI float skinny_core(const Ctx& C, const bf16* A, const bf16* Bt, int K, int n0, LASQ float* red) {
    const int lane = C.lane, wave = C.wave, li = lane & 15, fq = lane >> 4, kw = K >> 3, k0 = wave * kw + 8 * fq;
    f32x4 acc0 = {0.f, 0.f, 0.f, 0.f}, acc1 = {0.f, 0.f, 0.f, 0.f};
    const bf16* bp = Bt + (size_t)(n0 + li) * K + k0; const bf16* ap0 = A + (size_t)li * K + k0; const bf16* ap1 = A + (size_t)(16 + li) * K + k0;
#pragma unroll 8
    for (int ks = 0; ks < (kw >> 5); ++ks) { const bf16x8v bfr = *(const bf16x8v*)(bp + 32 * ks), a0 = *(const bf16x8v*)(ap0 + 32 * ks), a1 = *(const bf16x8v*)(ap1 + 32 * ks);
        acc0 = MFMA16(bfr, a0, acc0); acc1 = MFMA16(bfr, a1, acc1); }
    *(LASQ f32x4*)(red + wave * 512 + li * 16 + 4 * fq) = acc0; *(LASQ f32x4*)(red + wave * 512 + (16 + li) * 16 + 4 * fq) = acc1;
    __syncthreads();
    float v = 0.f;
#pragma unroll
    for (int w = 0; w < 8; ++w) v += red[w * 512 + C.tid];
    __syncthreads();
    return v;
}
DI void kmean_unit(Ctx& C, int l, int u) {
    const int tid = C.tid, cc = tid & 63, tg = tid >> 6; LASQ float* red = (LASQ float*)C.lds;
    const int r = u, bs = r >> 5, blk = r & 31; const int page = inI(C, 4)[bs * 64 + blk * 2 + (tg >> 2)];
    const float* src = inF(C, 2) + (((size_t)l * NPOOL + page) * 128 + (tg & 3) * 32) * 256; float* dst = (float*)(C.ws + WS_KMS2) + ((size_t)l * SB * 32 + r) * 256;
    f32x4 s = {0.f, 0.f, 0.f, 0.f};
#pragma unroll 8
    for (int j = 0; j < 32; ++j) s += __builtin_nontemporal_load((const f32x4*)(src + (size_t)j * 256 + 4 * cc));
    *(LASQ f32x4*)(red + tg * 256 + 4 * cc) = s;
    __syncthreads();
    if (tid < 256) { float t = 0.f;
#pragma unroll
        for (int g = 0; g < 8; ++g) t += red[g * 256 + tid];
        dst[tid] = t * (1.f / 256.f); }
    __syncthreads();
}
DI void moba_decode_unit(Ctx& C, int l, int bs, int h) {
    const int tid = C.tid, lane = C.lane, wave = C.wave; const size_t m = (size_t)MP + bs;
    LASQ float* QL = (LASQ float*)C.lds; LASQ float* GT = QL + 64; LASQ float* LG = QL + 128; LASQ float* PO = QL + 1024;
    const float q = tmpbuf(C, T_MQ)[m * 256 + h * 64 + lane];
    if (wave == 0) QL[lane] = q;
#pragma unroll
    for (int i = 0; i < 4; ++i) { const int n = 4 * wave + i; const float g = wsum(q * ((const float*)(C.ws + WS_KMS2))[(((size_t)l * SB + bs) * 32 + n) * 256 + h * 64 + lane]); if (lane == 0) GT[n] = g; }
    __syncthreads();
    int sel[3];
    { float myg = (lane < 32) ? GT[lane] : -3.0e38f;
#pragma unroll
      for (int r = 0; r < 3; ++r) { const float mx = wmaxf(myg); const unsigned long long bal = __ballot(myg == mx); const int idx = __ffsll((long long)bal) - 1; sel[r] = __builtin_amdgcn_readfirstlane(idx); if (lane == idx) myg = -3.0e38f; } }
    const int* pt = inI(C, 4) + bs * 64; const float* ck = inF(C, 2) + (size_t)l * NPOOL * 128 * 256 + h * 64; const float* cv = inF(C, 3) + (size_t)l * NPOOL * 128 * 256 + h * 64;
#pragma unroll
    for (int rep = 0; rep < 2; ++rep) { const int key = tid + 512 * rep;
        if (key <= 768) { const float* kr;
            if (key < 768) { const int r = key >> 8, kk = key & 255; const int sb = (r == 0) ? sel[0] : ((r == 1) ? sel[1] : sel[2]); const int kp = sb * 256 + kk; kr = ck + ((size_t)pt[kp >> 7] * 128 + (kp & 127)) * 256; }
            else kr = C.out + O_SMK + ((size_t)l * SB + bs) * 256 + h * 64;
            float dot = 0.f;
#pragma unroll
            for (int d4 = 0; d4 < 16; ++d4) { const f32x4 kv = *(const f32x4*)(kr + 4 * d4); const f32x4 qv = *(const LASQ f32x4*)(QL + 4 * d4); dot += (kv.x * qv.x + kv.y * qv.y) + (kv.z * qv.z + kv.w * qv.w); }
            LG[key] = dot * 0.125f; } }
    __syncthreads();
    float mx = -3.0e38f;
    for (int k = lane; k <= 768; k += 64) mx = fmaxf(mx, LG[k]);
    mx = wmaxf(mx);
    float sum = 0.f;
    for (int k = lane; k <= 768; k += 64) sum += __expf(LG[k] - mx);
    sum = wsum(sum);
    float o = 0.f;
    {   const float* vb[3]; float vv[3][32];
#pragma unroll
        for (int gi = 0; gi < 3; ++gi) { const int gk0 = 32 * (3 * wave + gi), r = gk0 >> 8, kk0 = gk0 & 255; const int sb = (r == 0) ? sel[0] : ((r == 1) ? sel[1] : sel[2]); const int kp0 = sb * 256 + kk0;
            vb[gi] = cv + ((size_t)pt[kp0 >> 7] * 128 + (kp0 & 127)) * 256 + lane; }
#pragma unroll
        for (int gi = 0; gi < 3; ++gi)
#pragma unroll
            for (int j = 0; j < 32; ++j) vv[gi][j] = vb[gi][(size_t)j * 256];
#pragma unroll
        for (int gi = 0; gi < 3; ++gi)
#pragma unroll
            for (int j = 0; j < 32; ++j) o += __expf(LG[32 * (3 * wave + gi) + j] - mx) * vv[gi][j]; }
    if (wave == 0) o += __expf(LG[768] - mx) * C.out[O_SMV + ((size_t)l * SB + bs) * 256 + h * 64 + lane];
    PO[wave * 64 + lane] = o;
    __syncthreads();
    if (wave == 0) { float t = 0.f;
#pragma unroll
        for (int w = 0; w < 8; ++w) t += PO[w * 64 + lane];
        ybuf(C, 3)[m * 256 + h * 64 + lane] = (bf16)f2bf(t / sum); }
    __syncthreads();
}

DI void skinny_merge_item(Ctx& C, int l, int n0, LASQ float* red) {
    const int lane = C.lane, wave = C.wave, li = lane & 15, fq = lane >> 4, br = wave >> 1, kh = wave & 1, k0 = 128 * kh + 8 * fq;
    const bf16* A = ybuf(C, br) + (size_t)MP * BW; const bf16* Bt = wptr(C, l, WO_WBR) + (size_t)br * D * BW;
    f32x4 acc0 = {0.f, 0.f, 0.f, 0.f}, acc1 = {0.f, 0.f, 0.f, 0.f};
    const bf16* bp = Bt + (size_t)(n0 + li) * BW + k0; const bf16* ap0 = A + (size_t)li * BW + k0; const bf16* ap1 = A + (size_t)(16 + li) * BW + k0;
#pragma unroll
    for (int ks = 0; ks < 4; ++ks) { const bf16x8v bfr = *(const bf16x8v*)(bp + 32 * ks), a0 = *(const bf16x8v*)(ap0 + 32 * ks), a1 = *(const bf16x8v*)(ap1 + 32 * ks);
        acc0 = MFMA16(bfr, a0, acc0); acc1 = MFMA16(bfr, a1, acc1); }
    *(LASQ f32x4*)(red + wave * 512 + li * 16 + 4 * fq) = acc0; *(LASQ f32x4*)(red + wave * 512 + (16 + li) * 16 + 4 * fq) = acc1;
    lds_barrier_();
    const int row = C.tid >> 4, col = C.tid & 15; float accm = 0.f;
#pragma unroll
    for (int b4 = 0; b4 < 4; ++b4) accm += (red[(2 * b4) * 512 + C.tid] + red[(2 * b4 + 1) * 512 + C.tid]) * bflo((unsigned)gatep(C)[(size_t)(MP + row) * NGATE + b4 * D + n0 + col]);
    lds_barrier_();
    mrgp(C)[(size_t)(MP + row) * D + n0 + col] = (bf16)f2bf(accm);
}

constexpr int MG_AB = 256 * LT * 2, MG_BB = 128 * LT * 2, MG_STAGE = MG_AB + MG_BB;
DI void merge_unit(Ctx& C, int l, int m0, int n0) {
    const int tid = C.tid, lane = C.lane, wave = C.wave, li = lane & 15, fq = lane >> 4, wr = wave >> 1, wc = wave & 1;
    LASQ unsigned char* L = C.lds;
    f32x4 acc[4][4]; u32x2 tot[4][4];
#pragma unroll
    for (int mt = 0; mt < 4; ++mt)
#pragma unroll
        for (int nt = 0; nt < 4; ++nt) { acc[mt][nt] = (f32x4){0.f, 0.f, 0.f, 0.f}; tot[mt][nt] = (u32x2){0u, 0u}; }
    u32x4 ra[4], ra2[4], rb[2], rb2[2];
    const int srow = tid >> 3, sseg = tid & 7;
#define MG_LOADA(s, dst) do { const int br_ = (s) >> 2, kt_ = (s) & 3; const bf16* yb_ = ybuf(C, br_) + (size_t)m0 * BW + kt_ * 64 + 8 * sseg; \
        _Pragma("unroll") for (int j = 0; j < 4; ++j) dst[j] = *(const u32x4*)(yb_ + (size_t)(srow + 64 * j) * BW); } while (0)
#define MG_LOADB(s, bdst) do { const int br_ = (s) >> 2, kt_ = (s) & 3; const bf16* wb_ = wptr(C, l, WO_WBR) + (size_t)br_ * D * BW + (size_t)n0 * BW + kt_ * 64 + 8 * sseg; \
        _Pragma("unroll") for (int j = 0; j < 2; ++j) bdst[j] = *(const u32x4*)(wb_ + (size_t)(srow + 64 * j) * BW); } while (0)
#define MG_STORE(buf, src, bsrc) do { LASQ unsigned char* sb_ = L + (buf) * MG_STAGE; \
        _Pragma("unroll") for (int j = 0; j < 4; ++j) *(LASQ u32x4*)(sb_ + (srow + 64 * j) * (LT * 2) + sseg * 16) = src[j]; \
        _Pragma("unroll") for (int j = 0; j < 2; ++j) *(LASQ u32x4*)(sb_ + MG_AB + (srow + 64 * j) * (LT * 2) + sseg * 16) = bsrc[j]; } while (0)
    u32x2 gv[4][4];
#define MG_STEP(s, RCUR, RPRE, BCUR, BPRE) do { const int buf = (s) & 1, br = (s) >> 2, kt = (s) & 3; \
        if (kt == 2) {     const bf16* gp = gatep(C) + (size_t)(m0 + 64 * wr + li) * NGATE + br * D + n0 + 64 * wc + 4 * fq; \
            _Pragma("unroll") for (int mt = 0; mt < 4; ++mt) _Pragma("unroll") for (int nt = 0; nt < 4; ++nt) gv[mt][nt] = *(const u32x2*)(gp + (size_t)(16 * mt) * NGATE + 16 * nt); } \
        if ((s) + 2 < 16) MG_LOADB((s) + 2, BPRE); \
        if (kt != 3 && (s) + 2 < 16) MG_LOADA((s) + 2, RPRE); \
        const LASQ unsigned char* AL = L + buf * MG_STAGE; const LASQ unsigned char* BL = AL + MG_AB; \
        _Pragma("unroll 1") for (int ks = 0; ks < 2; ++ks) { bf16x8v af[4], bfr[4]; \
            _Pragma("unroll") for (int mt = 0; mt < 4; ++mt) af[mt] = *(const LASQ bf16x8v*)(AL + (64 * wr + 16 * mt + li) * (LT * 2) + (32 * ks + 8 * fq) * 2); \
            _Pragma("unroll") for (int nt = 0; nt < 4; ++nt) bfr[nt] = *(const LASQ bf16x8v*)(BL + (64 * wc + 16 * nt + li) * (LT * 2) + (32 * ks + 8 * fq) * 2); \
            _Pragma("unroll") for (int mt = 0; mt < 4; ++mt) _Pragma("unroll") for (int nt = 0; nt < 4; ++nt) acc[mt][nt] = MFMA16(bfr[nt], af[mt], acc[mt][nt]); } \
        if (kt == 3) { \
            _Pragma("unroll") for (int mt = 0; mt < 4; ++mt) _Pragma("unroll") for (int nt = 0; nt < 4; ++nt) { const u32x2 g = gv[mt][nt]; const u32x2 t_ = tot[mt][nt]; const f32x4 a = acc[mt][nt]; u32x2 o_; \
                    o_.x = pg8::cvt_pk_bf16(bflo(t_.x) + a[0] * bflo(g.x), bfhi(t_.x) + a[1] * bfhi(g.x)); o_.y = pg8::cvt_pk_bf16(bflo(t_.y) + a[2] * bflo(g.y), bfhi(t_.y) + a[3] * bfhi(g.y)); \
                    tot[mt][nt] = o_; acc[mt][nt] = (f32x4){0.f, 0.f, 0.f, 0.f}; } \
            if ((s) + 2 < 16) MG_LOADA((s) + 2, RPRE); }     \
        if ((s) + 1 < 16) MG_STORE(buf ^ 1, RCUR, BCUR); \
        lds_barrier_(); } while (0)
    MG_LOADB(0, rb); MG_LOADA(0, ra); MG_STORE(0, ra, rb); MG_LOADB(1, rb); MG_LOADA(1, ra); lds_barrier_();
#pragma unroll 1
    for (int s2 = 0; s2 < 16; s2 += 2) { MG_STEP(s2, ra, ra2, rb, rb2); MG_STEP(s2 + 1, ra2, ra, rb2, rb); }
#undef MG_STEP
#undef MG_LOADA
#undef MG_LOADB
#undef MG_STORE
    bf16* op = mrgp(C) + (size_t)(m0 + 64 * wr + li) * D + n0 + 64 * wc + 4 * fq;
#pragma unroll
    for (int mt = 0; mt < 4; ++mt)
#pragma unroll
        for (int nt = 0; nt < 4; ++nt) *(u32x2*)(op + (size_t)(16 * mt) * D + 16 * nt) = tot[mt][nt];
}


DI void small_proj_chunk(Ctx& C, int l, int b, int c) {
    const int lane = C.lane, wave = C.wave, li = lane & 15, fq = lane >> 4, mt = wave & 3, kh = wave >> 2; const size_t row0 = (size_t)b * SEQ + (size_t)c * 64;
    LASQ float* red = (LASQ float*)C.lds;
    const bf16* wp = wptr(C, l, WO_WIN) + (size_t)(3072 + li) * D + 512 * kh + 8 * fq; const bf16* hp = Hp(C) + (row0 + 16 * mt + li) * D + 512 * kh + 8 * fq;
    f32x4 acc[2] = {{0.f, 0.f, 0.f, 0.f}, {0.f, 0.f, 0.f, 0.f}};
    const f32x4* sq = (const f32x4*)((const float*)(C.ws + WS_SSQ) + (row0 + 16 * mt + li) * 16); const f32x4 q0 = sq[0], q1 = sq[1], q2 = sq[2], q3 = sq[3];
#pragma unroll 4
    for (int ks = 0; ks < 16; ++ks) { const bf16x8v hb = *(const bf16x8v*)(hp + 32 * ks), w0 = *(const bf16x8v*)(wp + 32 * ks), w1 = *(const bf16x8v*)(wp + (size_t)16 * D + 32 * ks);
        acc[0] = MFMA16(w0, hb, acc[0]); acc[1] = MFMA16(w1, hb, acc[1]); }
    if (kh == 1) { *(LASQ f32x4*)(red + ((mt * 2 + 0) * 64 + lane) * 4) = acc[0]; *(LASQ f32x4*)(red + ((mt * 2 + 1) * 64 + lane) * 4) = acc[1]; }
    __syncthreads();
    if (kh == 0) { float* pr = projp(C) + (row0 + 16 * mt + li) * NP + 3072 + 4 * fq;
        const f32x4 qs = (q0 + q1) + (q2 + q3); const float rs = rsq_(((qs.x + qs.y) + (qs.z + qs.w)) * (1.f / D) + 1e-6f);
#pragma unroll
        for (int nt = 0; nt < 2; ++nt) *(f32x4*)(pr + 16 * nt) = (acc[nt] + *(const LASQ f32x4*)(red + ((mt * 2 + nt) * 64 + lane) * 4)) * rs; }
    __syncthreads();
}

#include <hip/hip_bf16.h>
#include <cmath>
namespace attn_body {
using bf16=__hip_bfloat16;
using bf16x8=__attribute__((ext_vector_type(8)))short;
using s16x4=__attribute__((ext_vector_type(4)))short;
using f32x16=__attribute__((ext_vector_type(16)))float;
using u32x4=__attribute__((ext_vector_type(4)))unsigned;
constexpr int BATCH=4,NHEAD=4,SEQ=4096,D=64,DM=NHEAD*D;
constexpr int NW=8,QBLK=32,QB=QBLK*NW,KVBLK=64,NQB=SEQ/QB;
constexpr int ATTN_PITCH=DM, ATTN_UNIT_ROWS=QB;
__device__ __forceinline__ int crow(int r,int hi){return (r&3)+8*(r>>2)+4*hi;}
#define SBAR() __builtin_amdgcn_sched_barrier(0)
__device__ __forceinline__ void cmask(f32x16&p0,f32x16&p1,int jb,int qrel,int hi){
  const float NEG=-INFINITY; int kb=64*jb+4*hi;
  #pragma unroll
  for(int r=0;r<16;++r){int kv=kb+(r&3)+8*(r>>2); if(kv>qrel)p0[r]=NEG; if(kv+32>qrel)p1[r]=NEG;}
}

constexpr int NSLOT=3, SLOTB=8192;
constexpr int LDS_K=0, LDS_V=NSLOT*SLOTB, LDS_WS=2*NSLOT*SLOTB, LDS_OST=LDS_WS+NW*64*4, LDS_BYTES=LDS_OST+NW*4096;
constexpr float C2=0.125f*1.4426950408889634f;
__device__ __forceinline__ void glds16(const void*gsrc,unsigned lds_dst){unsigned keep;
  asm volatile("s_mov_b32 %0, m0\n\ts_mov_b32 m0, %2\n\ts_nop 0\n\tglobal_load_lds_dwordx4 %1, off\n\ts_mov_b32 m0, %0":"=&s"(keep):"v"(gsrc),"s"(lds_dst):"memory");}
__device__ __forceinline__ float max3f(float a,float b,float c){float r;asm("v_max3_f32 %0, %1, %2, %3":"=v"(r):"v"(a),"v"(b),"v"(c));return r;}
__device__ __forceinline__ float max2f(float a,float b){float r;asm("v_max_f32_e32 %0, %1, %2":"=v"(r):"v"(a),"v"(b));return r;}
__device__ __forceinline__ float fadd_s(float a,float b){float r;asm("v_add_f32_e32 %0, %1, %2":"=v"(r):"v"(a),"v"(b));return r;}
__device__ __forceinline__ float fsub_s(float a,float b){float r;asm("v_sub_f32_e32 %0, %1, %2":"=v"(r):"v"(a),"v"(b));return r;}
typedef float f32x2_t __attribute__((ext_vector_type(2))); typedef __bf16 bf16x2_t __attribute__((ext_vector_type(2)));
__device__ __forceinline__ unsigned cvtpk_s(float lo,float hi){f32x2_t v={lo,hi};bf16x2_t b=__builtin_convertvector(v,bf16x2_t);return __builtin_bit_cast(unsigned,b);}
#define WAIT_BAR(N) asm volatile("s_waitcnt vmcnt(" #N ") lgkmcnt(0)\n\ts_barrier":::"memory")

__device__ __forceinline__ void qkt(f32x16&p0,f32x16&p1,const char*Kslot,const bf16x8*qr,const f32x16&negm,int r32,int hi){
  const char*kb=Kslot+hi*1024+r32*16;
  #pragma unroll
  for(int d0=0;d0<4;++d0){
    const bf16x8 b0=*reinterpret_cast<const bf16x8*>(kb+d0*2048);
    const bf16x8 b1=*reinterpret_cast<const bf16x8*>(kb+d0*2048+512);
    if(d0==0){p0=__builtin_amdgcn_mfma_f32_32x32x16_bf16(b0,qr[0],negm,0,0,0);p1=__builtin_amdgcn_mfma_f32_32x32x16_bf16(b1,qr[0],negm,0,0,0);}
    else{p0=__builtin_amdgcn_mfma_f32_32x32x16_bf16(b0,qr[d0],p0,0,0,0);p1=__builtin_amdgcn_mfma_f32_32x32x16_bf16(b1,qr[d0],p1,0,0,0);}}
}
typedef __attribute__((address_space(3))) const char* lds_cptr;
typedef short v4i16_t __attribute__((ext_vector_type(4)));
__device__ __forceinline__ void kload8(bf16x8*kf,lds_cptr kp){
  kf[0]=*(const __attribute__((address_space(3))) bf16x8*)(kp);      kf[1]=*(const __attribute__((address_space(3))) bf16x8*)(kp+512);
  kf[2]=*(const __attribute__((address_space(3))) bf16x8*)(kp+2048); kf[3]=*(const __attribute__((address_space(3))) bf16x8*)(kp+2560);
  kf[4]=*(const __attribute__((address_space(3))) bf16x8*)(kp+4096); kf[5]=*(const __attribute__((address_space(3))) bf16x8*)(kp+4608);
  kf[6]=*(const __attribute__((address_space(3))) bf16x8*)(kp+6144); kf[7]=*(const __attribute__((address_space(3))) bf16x8*)(kp+6656);
}
__device__ __forceinline__ void kload2(bf16x8*kf,lds_cptr kp,int j){ kf[2*j]=*(const __attribute__((address_space(3))) bf16x8*)(kp+j*2048); kf[2*j+1]=*(const __attribute__((address_space(3))) bf16x8*)(kp+j*2048+512); }
__device__ __forceinline__ s16x4 vtr(lds_cptr p){ return __builtin_bit_cast(s16x4,__builtin_amdgcn_ds_read_tr16_b64_v4i16((__attribute__((address_space(3))) v4i16_t*)p)); }
__device__ __forceinline__ float rowmax(const f32x16&p0,const f32x16&p1){
  float a=max3f(p0[0],p0[1],p1[0]),b=max3f(p0[2],p0[3],p1[1]);a=max3f(a,p1[2],p1[3]);
  #pragma unroll
  for(int r=4;r<16;r+=4){a=max3f(a,p0[r],p0[r+1]);b=max3f(b,p0[r+2],p0[r+3]);a=max3f(a,p1[r],p1[r+1]);b=max3f(b,p1[r+2],p1[r+3]);}
  const float m=max2f(a,b);
  auto rr=__builtin_amdgcn_permlane32_swap(__float_as_uint(m),__float_as_uint(m),false,false);
  return max2f(__uint_as_float(rr[0]),__uint_as_float(rr[1]));
}
__device__ __forceinline__ void pv(f32x16*o,int vb,bf16x8 pa0,bf16x8 pa1,bf16x8 pa2,bf16x8 pa3){
  #pragma unroll
  for(int d0=0;d0<2;++d0){s16x4 lo[4],hi[4];
    #pragma unroll
    for(int ks=0;ks<4;++ks){
      asm volatile("ds_read_b64_tr_b16 %0,%1 offset:%c2":"=&v"(lo[ks]):"v"(vb),"i"(d0*4096+ks*1024):"memory");
      asm volatile("ds_read_b64_tr_b16 %0,%1 offset:%c2":"=&v"(hi[ks]):"v"(vb),"i"(d0*4096+ks*1024+512):"memory");}
    asm volatile("s_waitcnt lgkmcnt(0)":::"memory");SBAR();
    #define PK(k) (bf16x8){lo[k][0],lo[k][1],lo[k][2],lo[k][3],hi[k][0],hi[k][1],hi[k][2],hi[k][3]}
    o[d0]=__builtin_amdgcn_mfma_f32_32x32x16_bf16(pa0,PK(0),o[d0],0,0,0);
    o[d0]=__builtin_amdgcn_mfma_f32_32x32x16_bf16(pa1,PK(1),o[d0],0,0,0);
    o[d0]=__builtin_amdgcn_mfma_f32_32x32x16_bf16(pa2,PK(2),o[d0],0,0,0);
    o[d0]=__builtin_amdgcn_mfma_f32_32x32x16_bf16(pa3,PK(3),o[d0],0,0,0);
    #undef PK
  }
}

#ifndef ATTN_STORE16
#define ATTN_STORE16(p,v) (*(u32x4*)(p)=(v))
#endif
template<int THRL> __device__ __forceinline__ void attn_unit(int b,int h,int qb,const bf16*Q,const bf16*__restrict__ K,const bf16*__restrict__ V,bf16*O,char*shm,unsigned selmask){
  int tid_o=threadIdx.x; asm volatile("":"+v"(tid_o));
  const int tid=tid_o,lane=tid&63,r32=lane&31,hi=lane>>5; const int wid=__builtin_amdgcn_readfirstlane(tid>>6);
  const long rowbase=(long)b*SEQ; const int q0=qb*QB;
  const bf16*Qw=Q+(rowbase+q0+wid*QBLK)*DM+h*D;
  const bf16*Kh=K+rowbase*DM+h*D,*Vh=V+rowbase*DM+h*D;
  const unsigned lds0=(unsigned)(uintptr_t)shm;
  float*wsf=(float*)(shm+LDS_WS)+wid*64;
  const bf16*ksrc=Kh+(long)lane*DM+wid*8;
  const bf16*vsrc=Vh+(long)(16*(wid&3)+(lane>>2))*DM+(wid>>2)*32+(lane&3)*8;
  const unsigned kdst=lds0+LDS_K+wid*1024, vdst=lds0+LDS_V+wid*1024;
  #define DMA_K(t,slot) glds16(ksrc+(long)(t)*KVBLK*DM,(unsigned)__builtin_amdgcn_readfirstlane(kdst+(slot)))
  #define DMA_V(t,slot) glds16(vsrc+(long)(t)*KVBLK*DM,(unsigned)__builtin_amdgcn_readfirstlane(vdst+(slot)))
  const int vb0=(int)(lds0+LDS_V)+((lane>>4)&1)*32+(lane&3)*8+(4*hi+((lane&15)>>2))*64;
  const char*Kbase=shm+LDS_K; bf16x8 kf[8];
  const lds_cptr shm3=(lds_cptr)shm; const lds_cptr kp0=shm3+LDS_K+hi*1024+r32*16; const lds_cptr vp0=shm3+LDS_V+((lane>>4)&1)*32+(lane&3)*8+(4*hi+((lane&15)>>2))*64;
  const int NT=(q0+QB)/KVBLK;
  DMA_K(0,0);DMA_V(0,0);DMA_K(1,SLOTB);
  bf16x8 qr[4];
  #pragma unroll
  for(int d0=0;d0<4;++d0)qr[d0]=*reinterpret_cast<const bf16x8*>(&Qw[(long)r32*DM+d0*16+hi*8]);
  float mhat=0.f,l_reg=0.f;f32x16 o[2];o[0]=f32x16{};o[1]=f32x16{};const f32x16 negm=f32x16{};
  const int qrel=wid*QBLK+r32;
  #define CMASK(P0,P1,t) do{int jb_=(t)-(NT-4); if(jb_>=0)cmask(P0,P1,jb_,qrel,hi); else if(!((selmask>>((t)>>2))&1u)){ _Pragma("unroll") for(int r_=0;r_<16;++r_){P0[r_]=-INFINITY;P1[r_]=-INFINITY;} } }while(0)
  bool resc=false;
  #define START(P0,P1) do{ const float rm=rowmax(P0,P1); resc=false; \
    { const float dl=(rm>-1.0e30f)?rm:0.f; mhat=fadd_s(mhat,dl); \
      _Pragma("unroll") for(int r=0;r<16;++r){P0[r]=fsub_s(P0[r],dl);P1[r]=fsub_s(P1[r],dl);} \
      } \
    _Pragma("unroll") for(int r=0;r<16;++r)P0[r]=__builtin_amdgcn_exp2f(P0[r]); }while(0)
  #define RESC() do{ if(resc){ asm volatile("s_waitcnt lgkmcnt(0)":::"memory"); \
      _Pragma("unroll") for(int d_=0;d_<2;++d_) _Pragma("unroll") for(int r=0;r<16;++r)o[d_][r]*=wsf[crow(r,hi)]; } }while(0)
  f32x16 pA0,pA1,pB0,pB1;
  int sl_prev=0,sl_cur=0,sl_next=SLOTB;
  #define ROT() do{sl_prev=sl_cur;sl_cur=sl_next;sl_next=(sl_next==(NSLOT-1)*SLOTB)?0:sl_next+SLOTB;}while(0)
  DMA_K(2,2*SLOTB);
  WAIT_BAR(3);
  qkt(pA0,pA1,Kbase,qr,negm,r32,hi);asm volatile("s_nop 15\n\ts_nop 7":"+v"(pA0),"+v"(pA1));CMASK(pA0,pA1,0);
  START(pA0,pA1);
  _Pragma("unroll") for(int r=0;r<16;++r)pA1[r]=__builtin_amdgcn_exp2f(pA1[r]);
  WAIT_BAR(0);
  DMA_K(3,0);DMA_V(1,SLOTB);
  ROT();
  kload8(kf,kp0+sl_cur);
  WAIT_BAR(2);
  s16x4 vlo[8],vhi[8]; u32x4 pw0,pw1,pw2,pw3;
  #define PKW(P,B) cvtpk_s(P[B],P[B+1])
  #define PAF(k) __builtin_bit_cast(bf16x8,pw##k)
  #define VFR(i) (bf16x8){vlo[i][0],vlo[i][1],vlo[i][2],vlo[i][3],vhi[i][0],vhi[i][1],vhi[i][2],vhi[i][3]}
  #define PIN(x) asm volatile("":"+v"(x))
  #define MX3(a,b,c) __builtin_fmaxf(__builtin_fmaxf((a),(b)),(c))
  #define GAPA(MF,A0,A1,A2,A3,W0,W1,PW) do{ MF; sacc+=A0; sacc+=A1; sacc+=A2; sacc+=A3; PIN(sacc); W0; W1; PIN(PW); SBAR(); }while(0)
  #define EX(v) __builtin_amdgcn_exp2f(v)
  #define GAPB(MF,X,B) do{ MF; X[B]=EX(X[B]); X[B+1]=EX(X[B+1]); X[B+2]=EX(X[B+2]); X[B+3]=EX(X[B+3]); PIN(X); SBAR(); }while(0)
  #define VRD(i) do{ vlo[i]=vtr(vp_+(((i)>>2)*4096+((i)&3)*1024)); vhi[i]=vtr(vp_+(((i)>>2)*4096+((i)&3)*1024+512)); }while(0)
  #define KRD(G,j) do{ if(G){ kload2(kf,kp0+sl_next,j); SBAR(); } }while(0)
  #define STEP(C0,C1,P0,P1,t,GK,GV,GL) do{ SBAR(); \
    const lds_cptr vp_=vp0+sl_prev; \
    VRD(0); SBAR(); float sacc=(P0[0]+P0[1]); \
    GAPA(C0=__builtin_amdgcn_mfma_f32_32x32x16_bf16(kf[0],qr[0],negm,0,0,0), P0[2],P0[3],P0[4],P0[5],     pw0[0]=PKW(P0,0), pw0[1]=PKW(P0,2), pw0); \
    VRD(4); SBAR(); GAPA(C1=__builtin_amdgcn_mfma_f32_32x32x16_bf16(kf[1],qr[0],negm,0,0,0), P0[6],P0[7],P0[8],P0[9],     pw0[2]=PKW(P0,4), pw0[3]=PKW(P0,6), pw0); \
    VRD(1); SBAR(); GAPA(C0=__builtin_amdgcn_mfma_f32_32x32x16_bf16(kf[2],qr[1],C0,0,0,0),   P0[10],P0[11],P0[12],P0[13], pw1[0]=PKW(P0,8), pw1[1]=PKW(P0,10), pw1); \
    VRD(5); SBAR(); GAPA(C1=__builtin_amdgcn_mfma_f32_32x32x16_bf16(kf[3],qr[1],C1,0,0,0),   P0[14],P0[15],P1[0],P1[1],   pw1[2]=PKW(P0,12),pw1[3]=PKW(P0,14), pw1); \
    VRD(2); SBAR(); GAPA(C0=__builtin_amdgcn_mfma_f32_32x32x16_bf16(kf[4],qr[2],C0,0,0,0),   P1[2],P1[3],P1[4],P1[5],     pw2[0]=PKW(P1,0), pw2[1]=PKW(P1,2), pw2); \
    VRD(6); SBAR(); GAPA(C1=__builtin_amdgcn_mfma_f32_32x32x16_bf16(kf[5],qr[2],C1,0,0,0),   P1[6],P1[7],P1[8],P1[9],     pw2[2]=PKW(P1,4), pw2[3]=PKW(P1,6), pw2); \
    VRD(3); SBAR(); GAPA(C0=__builtin_amdgcn_mfma_f32_32x32x16_bf16(kf[6],qr[3],C0,0,0,0),   P1[10],P1[11],P1[12],P1[13], pw3[0]=PKW(P1,8), pw3[1]=PKW(P1,10), pw3); \
    VRD(7); SBAR(); GAPA(C1=__builtin_amdgcn_mfma_f32_32x32x16_bf16(kf[7],qr[3],C1,0,0,0),   P1[14],P1[15],0.f,0.f,       pw3[2]=PKW(P1,12),pw3[3]=PKW(P1,14), pw3); \
    l_reg+=sacc; \
    if(GK){DMA_K((t)+3,sl_cur);} if(GV){DMA_V((t)+1,sl_next);} \
    _Pragma("unroll") for(int r=0;r<16;++r){C0[r]-=mhat;C1[r]-=mhat;} \
    CMASK(C0,C1,t); \
    { float a=MX3(C0[0],C0[1],C1[0]),b=MX3(C0[2],C0[3],C1[1]); a=MX3(a,C1[2],C1[3]); \
      _Pragma("unroll") for(int r=4;r<16;r+=4){a=MX3(a,C0[r],C0[r+1]);b=MX3(b,C0[r+2],C0[r+3]);a=MX3(a,C1[r],C1[r+1]);b=MX3(b,C1[r+2],C1[r+3]);} \
      float rm=__builtin_fmaxf(a,b); { auto rr=__builtin_amdgcn_permlane32_swap(__float_as_uint(rm),__float_as_uint(rm),false,false); rm=__builtin_fmaxf(__uint_as_float(rr[0]),__uint_as_float(rr[1])); } \
      resc=false; \
      if(__builtin_expect(__any(rm>(float)THRL),0)){ const float dl=__builtin_fmaxf(rm,0.f); mhat+=dl; \
        _Pragma("unroll") for(int r=0;r<16;++r){C0[r]-=dl;C1[r]-=dl;} \
        \
        const float f=__builtin_amdgcn_exp2f(-dl); l_reg*=f; if(hi==0)wsf[r32]=f; resc=true; } } \
    SBAR(); \
    GAPB(o[0]=__builtin_amdgcn_mfma_f32_32x32x16_bf16(PAF(0),VFR(0),o[0],0,0,0), C0,0); \
    GAPB(o[1]=__builtin_amdgcn_mfma_f32_32x32x16_bf16(PAF(0),VFR(4),o[1],0,0,0), C0,4); \
    KRD(GL,0); GAPB(o[0]=__builtin_amdgcn_mfma_f32_32x32x16_bf16(PAF(1),VFR(1),o[0],0,0,0), C0,8); \
    KRD(GL,1); GAPB(o[1]=__builtin_amdgcn_mfma_f32_32x32x16_bf16(PAF(1),VFR(5),o[1],0,0,0), C0,12); \
    KRD(GL,2); GAPB(o[0]=__builtin_amdgcn_mfma_f32_32x32x16_bf16(PAF(2),VFR(2),o[0],0,0,0), C1,0); \
    KRD(GL,3); GAPB(o[1]=__builtin_amdgcn_mfma_f32_32x32x16_bf16(PAF(2),VFR(6),o[1],0,0,0), C1,4); \
    GAPB(o[0]=__builtin_amdgcn_mfma_f32_32x32x16_bf16(PAF(3),VFR(3),o[0],0,0,0), C1,8); \
    GAPB(o[1]=__builtin_amdgcn_mfma_f32_32x32x16_bf16(PAF(3),VFR(7),o[1],0,0,0), C1,12); \
    }while(0)
  int t=1;
  #undef CMASK
  #define CMASK(P0,P1,t) do{ if(!((selmask>>((t)>>2))&1u)){ _Pragma("unroll") for(int r_=0;r_<16;++r_){P0[r_]=-INFINITY;P1[r_]=-INFINITY;} } }while(0)
  for(;t+5<NT;t+=2){
    STEP(pB0,pB1,pA0,pA1,t,true,true,true);     WAIT_BAR(2); RESC(); ROT();
    STEP(pA0,pA1,pB0,pB1,t+1,true,true,true);   WAIT_BAR(2); RESC(); ROT();
  }
  #undef CMASK
  #define CMASK(P0,P1,t) do{int jb_=(t)-(NT-4); if(jb_>=0)cmask(P0,P1,jb_,qrel,hi); else if(!((selmask>>((t)>>2))&1u)){ _Pragma("unroll") for(int r_=0;r_<16;++r_){P0[r_]=-INFINITY;P1[r_]=-INFINITY;} } }while(0)
  #define ENDW(tt) do{ if((tt)+3<NT){WAIT_BAR(2);} else if((tt)+2<NT){WAIT_BAR(1);} else {WAIT_BAR(0);} }while(0)
  for(;t+1<NT;t+=2){
    STEP(pB0,pB1,pA0,pA1,t,(t+3<NT),(t+1<NT),(t+1<NT));       ENDW(t);   RESC(); ROT();
    STEP(pA0,pA1,pB0,pB1,t+1,(t+4<NT),(t+2<NT),(t+2<NT));     ENDW(t+1); RESC(); ROT();
  }
  STEP(pB0,pB1,pA0,pA1,NT-1,false,false,false); RESC();
  { float sacc=pB0[0]+pB0[1]; _Pragma("unroll") for(int r=2;r<16;++r)sacc+=pB0[r]; _Pragma("unroll") for(int r=0;r<16;++r)sacc+=pB1[r]; l_reg+=sacc;
    pw0=(u32x4){PKW(pB0,0),PKW(pB0,2),PKW(pB0,4),PKW(pB0,6)};pw1=(u32x4){PKW(pB0,8),PKW(pB0,10),PKW(pB0,12),PKW(pB0,14)};pw2=(u32x4){PKW(pB1,0),PKW(pB1,2),PKW(pB1,4),PKW(pB1,6)};pw3=(u32x4){PKW(pB1,8),PKW(pB1,10),PKW(pB1,12),PKW(pB1,14)};
    SBAR(); pv(o,vb0+sl_cur,PAF(0),PAF(1),PAF(2),PAF(3)); }
  #undef PKW
  #undef PAF
  #undef VFR
  #undef PIN
  #undef MX3
  #undef GAPA
  #undef GAPB
  #undef EX
  #undef VRD
  #undef KRD
  #undef STEP
  #undef ENDW
  {auto rr=__builtin_amdgcn_permlane32_swap(__float_as_uint(l_reg),__float_as_uint(l_reg),false,false);l_reg=__uint_as_float(rr[0])+__uint_as_float(rr[1]);}
  if(hi==0)wsf[32+r32]=l_reg;asm volatile("s_waitcnt lgkmcnt(0)":::"memory");
  float rli[16];
  #pragma unroll
  for(int r=0;r<16;++r)rli[r]=__builtin_amdgcn_rcpf(wsf[32+crow(r,hi)]);
  bf16*Ow=O+(rowbase+q0+wid*QBLK)*DM+h*D;
  { bf16*stg=(bf16*)(shm+LDS_OST)+wid*2048;
    #pragma unroll
    for(int r=0;r<16;++r){const int orow=crow(r,hi);
      #pragma unroll
      for(int d0=0;d0<2;++d0)stg[orow*64+d0*32+r32]=__float2bfloat16(o[d0][r]*rli[r]);}
    asm volatile("s_waitcnt lgkmcnt(0)":::"memory");
    #pragma unroll
    for(int i=0;i<4;++i){const int row=i*8+(lane>>3),ch=lane&7; const u32x4 v=*(const u32x4*)(stg+row*64+ch*8); ATTN_STORE16(Ow+(long)row*DM+ch*8,v);} }
  asm volatile("s_waitcnt lgkmcnt(0)\n\ts_barrier":::"memory");
  #undef DMA_K
  #undef DMA_V
  #undef CMASK
  #undef START
  #undef RESC
  #undef ROT
}
constexpr int ATTN_LDS_BYTES=LDS_BYTES;
#undef SBAR
#undef WAIT_BAR
}

DI void moba_attn_unit256(Ctx& C, int l, int b, int h, int qb) {
    const int lane = C.lane, wave = C.wave, r32 = lane & 31, hi = lane >> 5;
    unsigned selmask = 0u;
    if (qb > 0) {
        LASQ float* KML = (LASQ float*)(C.lds + 90112);
        const float* ksum = (const float*)(C.ws + MB_KSUM) + (size_t)b * 64 * 256 + h * 64;
        for (int idx = C.tid; idx < qb * 64; idx += 512) { const int n = idx >> 6, d = idx & 63; const float* kp = ksum + (size_t)(4 * n) * 256 + d;
            KML[idx] = (kp[0] + kp[256]) + (kp[512] + kp[768]); }
        const size_t rowq = (size_t)b * SEQ + qb * 256 + wave * 32 + r32;
        const float* mq = tmpbuf(C, T_MQ) + rowq * 256 + h * 64 + 32 * hi;
        f32x4 qg[8];
#pragma unroll
        for (int j = 0; j < 8; ++j) qg[j] = *(const f32x4*)(mq + 4 * j);
        __syncthreads();
        float v1 = -3.0e38f, v2 = -3.0e38f, v3 = -3.0e38f; int i1 = -1, i2 = -1, i3 = -1;
        for (int n = 0; n < qb; ++n) { float g = 0.f;
#pragma unroll
            for (int j = 0; j < 8; ++j) { const f32x4 kv = *(const LASQ f32x4*)(KML + n * 64 + 32 * hi + 4 * j); g += (qg[j].x * kv.x + qg[j].y * kv.y) + (qg[j].z * kv.z + qg[j].w * kv.w); }
            g += __shfl_xor(g, 32);
            if (g > v1) { v3 = v2; i3 = i2; v2 = v1; i2 = i1; v1 = g; i1 = n; } else if (g > v2) { v3 = v2; i3 = i2; v2 = g; i2 = n; } else if (g > v3) { v3 = g; i3 = n; } }
        if (i1 >= 0) selmask |= 1u << i1; if (i2 >= 0) selmask |= 1u << i2; if (i3 >= 0) selmask |= 1u << i3;
        __syncthreads();
    }
    attn_body::attn_unit<8>(b, h, qb, (const attn_body::bf16*)(C.ws + MB_Q), (const attn_body::bf16*)(C.ws + MB_K), (const attn_body::bf16*)(C.ws + MB_VT), (attn_body::bf16*)ybuf(C, 3), (char*)C.lds, selmask);
}

constexpr size_t WS_TOTAL = WS_END6;

constexpr int PH_PER_LAYER = 8, N_PHASES = 1 + 2 * PH_PER_LAYER;
#ifndef MK_ONE_LAUNCH
#define MK_ONE_LAUNCH 1
#endif

__global__ void __launch_bounds__(512, 2) fwd(Args a) {
    extern __shared__ __attribute__((aligned(16))) unsigned char lds_raw[];
    Ctx C;
    C.out = a.out; C.ws = a.ws; C.outb = a.out; C.wsb = a.ws; C.lds = (LASQ unsigned char*)lds_raw;
    C.tid = threadIdx.x; C.lane = C.tid & 63; C.wave = __builtin_amdgcn_readfirstlane(C.tid >> 6);
    C.G = gridDim.x; { const int bx = blockIdx.x; C.vcu = (C.G % 8 == 0) ? (bx % 8) * (C.G / 8) + bx / 8 : bx; }
    C.gw = C.wave * C.G + C.vcu; C.NGW = C.G * 8;
    volatile LASQ unsigned* MISC = (volatile LASQ unsigned*)(C.lds + MISC_OFF);
    if (C.tid < 32) MISC[C.tid] = 0u;
    if (C.tid < 40) *(LASQ unsigned long long*)(C.lds + PTAB_OFF + 8 * C.tid) = (unsigned long long)a.in[C.tid];
    __syncthreads();
    unsigned* ctl = (unsigned*)(a.ws + WS_CTL);
    XcdBarrier bar = xcd_barrier_post(ctl + CW_BAR + a.li * XCD_BAR_WORDS, (volatile LAS unsigned*)(MISC + 8));
    const int lo = a.ph_lo, hi = a.ph_hi; int ph = 0;
    LASQ unsigned char* ring = C.lds;
    const int bid = (int)blockIdx.x;
#ifndef REP_MASK
#define REP_MASK 0
#endif
#define PH_BEGIN(slot) if (ph >= lo && ph < hi) { constexpr int nrep_ = ((REP_MASK >> (slot)) & 1) ? 2 : 1; for (int rep_ = 0; rep_ < nrep_; ++rep_) { refresh(C);
#define PH_END   if (rep_ + 1 < nrep_) xcd_barrier(bar); } if (ph + 1 < hi) xcd_barrier(bar); } ++ph;

    PH_BEGIN(0)
#if !defined(SKIP_PH0)
        if (C.vcu & 1) { for (int u = C.vcu; u < 2 * SB * 32; u += C.G) kmean_unit(C, u / (SB * 32), u % (SB * 32)); }
        prologue(C);
        __syncthreads();
        if (!(C.vcu & 1)) { for (int u = C.vcu; u < 2 * SB * 32; u += C.G) kmean_unit(C, u / (SB * 32), u % (SB * 32)); }
        if (FAST_S5) { LASQ float* scr = (LASQ float*)(C.lds + C.wave * 16384);
            for (int it = C.gw; it < 32 + 64 + (SEQ / 4 + 1); it += C.NGW) { if (it < 32) s5_param_item(C, it);
                else if (it >= 96) rope_item(C, it - 96);
                else { const int r = it - 32, l2 = r >> 5; tr_item<false>(inF(C, 20) + (size_t)l2 * 256 * 256, 256, 256, 256, (bf16*)(C.ws + S5_WGT) + (size_t)l2 * 256 * 256, scr, r & 31, C.lane); } } }
    #endif
    PH_END

    for (int l = 0; l < 2; ++l) {
        PH_BEGIN(1)
#if !defined(SKIP_PH1)
            pg8::StaticOrder S1; S1.init(MP, 3072, C.G, bid); pg8::StaticOrder S2; S2.init(MP, NGATE, C.G, C.G - 1 - bid);
            const int n1 = (MP / 256 * 12 + C.G - 1) / C.G;
            fill_rs(C, S1, 0); fill_rs(C, S2, n1);
            {   LASQ float* red = (LASQ float*)C.lds; const bf16* As = Hp(C) + (size_t)MP * D; const int row = C.tid >> 4, col = C.tid & 15; const float rss = sample_rs(C);
                for (int it = C.vcu; it < NP / 16 + NGATE / 16; it += C.G) {
                    if (it < NP / 16) { const float v = skinny_core(C, As, wptr(C, l, WO_WIN), D, 16 * it, red) * rss; projp(C)[(size_t)(MP + row) * NP + 16 * it + col] = v; }
                    else { const int n0 = 16 * (it - NP / 16); const float v = skinny_core(C, As, wptr(C, l, WO_WG), D, n0, red) * rss; gatep(C)[(size_t)(MP + row) * NGATE + n0 + col] = (bf16)f2bf(sigmoid_(v)); } } }
            { __syncthreads();
              { pg8::Gemm g{Hp(C), wptr(C, l, WO_WIN), MP, 3072, D};     pg8::EpiStoreF32<NP> E{projp(C), (const LASQ float*)(C.lds + RS_OFF), 0};
                pg8::gemm_phase<pg8::EpiStoreF32<NP>, pg8::StaticOrder>(ring, g, S1, E, nullptr); }
              { pg8::Gemm g{Hp(C), wptr(C, l, WO_WG), MP, NGATE, D}; pg8::EpiActBf16<0, NGATE> E{gatep(C), (const LASQ float*)(C.lds + RS_OFF) + n1 * 256, 0};
                pg8::gemm_phase<pg8::EpiActBf16<0, NGATE>, pg8::StaticOrder>(ring, g, S2, E, nullptr); } }
        #endif
    PH_END
        PH_BEGIN(2)
#if !defined(SKIP_PH2)
            for (int m = MP + C.vcu; m < MR; m += C.G) pre_row(C, l, m, (const float*)(C.ws + ROPE_TAB), C.wave);
            __syncthreads();
#ifndef REPS
#define REPS 0
#endif
#define RPT(bit) for (int rr_ = 0; rr_ < (((REPS) >> (bit)) & 1 ? 3 : 1); ++rr_)
            refresh(C);
            for (int u = C.vcu; u < 256; u += C.G) small_proj_chunk(C, l, u >> 6, u & 63);
            refresh(C);
            RPT(1) for (int u = C.vcu; u < 256; u += C.G) moba_prep_chunk(C, l, u >> 6, u & 63, (const float*)(C.ws + ROPE_TAB));
            refresh(C);
            for (int u = C.vcu; u < 256; u += C.G) s5_pass1_chunk(C, l, u >> 6, u & 63);
            refresh(C);
            for (int u = C.vcu; u < 256; u += C.G) gla_prep_chunk(C, l, u >> 6, u & 63);
            refresh(C);
            for (int u = C.vcu; u < 256; u += C.G) gdn_prep_chunk(C, l, u >> 6, u & 63);
            refresh(C);
            refresh(C);

        #endif
    PH_END
        PH_BEGIN(3)
#if !defined(SKIP_PH4)
            {
                constexpr int nD = SB * 16, nShort = SB * 16 + SB * 32 + SB * 32;
                const bool full = (C.G == 256);
                const int qb0 = C.vcu & 15; const bool light = !full || qb0 < 12; const int lidx = full ? (C.vcu >> 4) * 12 + qb0 : C.vcu, nl = full ? 192 : C.G;
                if (light) {
                    if (full) {
                        constexpr int nGen = NB * 256 + NB * 16 + nShort, nWav = 192 * 7 + 128;
                        if (C.wave == 0 && qb0 < 4) gdn_scan_item(C, l, (C.vcu >> 4) * 4 + qb0);
                        else { const int gi = (C.wave >= 1) ? (C.wave - 1) * 192 + lidx : 192 * 7 + (C.vcu >> 4) * 8 + (qb0 - 4);
                            for (int it = gi; it < nGen; it += nWav) { int r = it;
                                if (r < NB * 256) { gla_scan_item(C, l, r); continue; } r -= NB * 256;
                                if (r < NB * 16) { s5_carry_item(C, l, r); continue; } r -= NB * 16;
                                if (r < 512) { gla_naive(C, l, NB + (r >> 5), (r >> 3) & 3, r & 7); continue; } r -= 512;
                                if (r < nD) { s5_naive(C, l, NB + (r >> 4), r & 15, (const float*)(C.ws + S5_P), (bf16*)(C.ws + S5_YSB)); continue; } r -= nD;
                                if (r < 512) { r += 512; gla_naive(C, l, NB + (r >> 5), (r >> 3) & 3, r & 7); continue; } r -= 512;
                                gdn_naive(C, l, NB + (r >> 5), (r >> 3) & 3, r & 7); } }
                    } else {
                        for (int it = C.wave * nl + lidx; it < NB * 16; it += nl * 8) gdn_scan_item(C, l, it);
                        for (int it = lidx * 8 + C.wave; it < NB * 16; it += nl * 8) s5_carry_item(C, l, it);
                        for (int it = lidx * 8 + C.wave; it < NB * 256; it += nl * 8) gla_scan_item(C, l, it);
                        for (int it = C.wave * nl + lidx; it < nShort; it += nl * 8) { int r = it;
                            if (r < 512) { gla_naive(C, l, NB + (r >> 5), (r >> 3) & 3, r & 7); continue; } r -= 512;
                            if (r < nD) { s5_naive(C, l, NB + (r >> 4), r & 15, (const float*)(C.ws + S5_P), (bf16*)(C.ws + S5_YSB)); continue; } r -= nD;
                            if (r < 512) { r += 512; gla_naive(C, l, NB + (r >> 5), (r >> 3) & 3, r & 7); continue; } r -= 512;
                            gdn_naive(C, l, NB + (r >> 5), (r >> 3) & 3, r & 7); }
                    }
                }
                __syncthreads(); refresh(C);
                for (int p = C.vcu; p < 256; p += C.G) { const int qb = p & 15;
                    const int dslot = (qb == 0) ? 0 : (qb == 1) ? 1 : (qb >= 4 && qb <= 8) ? qb - 2 : (qb == 12) ? 7 : -1;
                    if (dslot >= 0) { const int u = (p >> 4) * 8 + dslot; moba_decode_unit(C, l, u >> 2, u & 3); refresh(C); }
                    moba_attn_unit256(C, l, p >> 6, (p >> 4) & 3, qb); }
            }
#endif
    PH_END
        PH_BEGIN(4)
#if !defined(SKIP_PH5)
            for (int m = MP + C.vcu; m < MR; m += C.G) post_row(C, l, m, C.wave);
            {   LASQ float* red = (LASQ float*)C.lds; const int row = C.tid >> 4, col = C.tid & 15;
                for (int it = C.vcu; it < BW / 16; it += C.G) { const float v = skinny_core(C, (const bf16*)(C.ws + S5_YSB), (const bf16*)(C.ws + S5_WGT) + (size_t)l * 256 * 256, BW, 16 * it, red);
                    const int n = 16 * it + col; ybuf(C, 0)[(size_t)(MP + row) * 256 + n] = (bf16)f2bf(tmpbuf(C, T_YPRE)[(size_t)(MP + row) * 256 + n] * sigmoid_(v + inF(C, 21)[l * 256 + n])); } }
            refresh(C);
            if (FAST_S5) { for (int u = C.vcu; u < 256; u += C.G) s5_out_chunk(C, l, u >> 6, u & 63); }
            refresh(C);
            if (FAST_GLA) { for (int u = C.vcu; u < 256; u += C.G) gla_out_chunk(C, l, u >> 6, u & 63); }
            refresh(C);
            if (FAST_GDN) { for (int u = C.vcu; u < 256; u += C.G) gdn_out_chunk(C, l, u >> 6, u & 63); }
        #endif
    PH_END
        PH_BEGIN(5)
#if !defined(SKIP_PH6)
            {   LASQ float* red = (LASQ float*)C.lds; const int row = C.tid >> 4, col = C.tid & 15;
                for (int it = C.vcu; it < D / 16; it += C.G) skinny_merge_item(C, l, 16 * it, red); (void)row; (void)col; }
            refresh(C);
            for (int u = C.vcu; u < (MP / 256) * (D / 128); u += C.G) merge_unit(C, l, (u >> 3) * 256, (u & 7) * 128);
#endif
    PH_END
        PH_BEGIN(6)
#if !defined(SKIP_PH7)
            { const float* xin_p = (l == 0) ? inF(C, 0) : X2p(C); const float* xin_s = (l == 0) ? inF(C, 1) : X2p(C) + (size_t)MP * D;
              {   LASQ float* red = (LASQ float*)C.lds; const int row = C.tid >> 4, col = C.tid & 15;
                  for (int it = C.vcu; it < D / 16; it += C.G) { const float v = xin_s[(size_t)row * D + 16 * it + col] + skinny_core(C, mrgp(C) + (size_t)MP * D, wptr(C, l, WO_WOUT), D, 16 * it, red);
                      X1p(C)[(size_t)(MP + row) * D + 16 * it + col] = v; Hp(C)[(size_t)(MP + row) * D + 16 * it + col] = (bf16)f2bf(v);
                      float s = v * v; s += __shfl_xor(s, 1); s += __shfl_xor(s, 2); s += __shfl_xor(s, 4); s += __shfl_xor(s, 8); if (col == 0) ((float*)(C.ws + WS_SSQS))[row * 64 + it] = s; } }
              pg8::Gemm g{mrgp(C), wptr(C, l, WO_WOUT), MP, D, D}; pg8::StaticOrder S; S.init(MP, D, C.G, bid); pg8::EpiRes E{xin_p, X1p(C), (pg8::bf16_t*)Hp(C), (float*)(C.ws + WS_SSQ)};
              pg8::gemm_phase<pg8::EpiRes, pg8::StaticOrder>(ring, g, S, E, nullptr); }
        #endif
    PH_END
        PH_BEGIN(7)
#if !defined(SKIP_PH9)
            pg8::StaticOrder SH; SH.init(MP, DFF, C.G, bid); fill_rs(C, SH, 0);
            {   LASQ float* red = (LASQ float*)C.lds; const int row = C.tid >> 4, col = C.tid & 15; const float rss = sample_rs(C);
                for (int it = C.vcu; it < DFF / 16; it += C.G) { const float v = fmaxf(skinny_core(C, Hp(C) + (size_t)MP * D, wptr(C, l, WO_FF1), D, 16 * it, red) * rss, 0.f);
                    Zp(C)[(size_t)(MP + row) * DFF + 16 * it + col] = (bf16)f2bf(v * v); } }
            { pg8::Gemm g{Hp(C), wptr(C, l, WO_FF1), MP, DFF, D}; const pg8::StaticOrder& S = SH; __syncthreads();
              pg8::EpiActBf16<1, DFF> E{Zp(C), (const LASQ float*)(C.lds + RS_OFF), 0};
              pg8::gemm_phase<pg8::EpiActBf16<1, DFF>, pg8::StaticOrder>(ring, g, S, E, nullptr); }
        #endif
    PH_END
        PH_BEGIN(8)
#if !defined(SKIP_PH10)
            { float* xout_p = (l == 0) ? X2p(C) : C.out + O_YP; float* xout_s = (l == 0) ? X2p(C) + (size_t)MP * D : C.out + O_YS;
              {   LASQ float* red = (LASQ float*)C.lds; const int row = C.tid >> 4, col = C.tid & 15;
                  for (int it = C.vcu; it < D / 16; it += C.G) { const float v = X1p(C)[(size_t)(MP + row) * D + 16 * it + col] + skinny_core(C, Zp(C) + (size_t)MP * DFF, wptr(C, l, WO_FF2), DFF, 16 * it, red);
                      xout_s[(size_t)row * D + 16 * it + col] = v;
                      if (l == 0) { Hp(C)[(size_t)(MP + row) * D + 16 * it + col] = (bf16)f2bf(v);
                          float s = v * v; s += __shfl_xor(s, 1); s += __shfl_xor(s, 2); s += __shfl_xor(s, 4); s += __shfl_xor(s, 8); if (col == 0) ((float*)(C.ws + WS_SSQS))[row * 64 + it] = s; } } }
              pg8::Gemm g{Zp(C), wptr(C, l, WO_FF2), MP, D, DFF}; pg8::StaticOrder S; S.init(MP, D, C.G, bid); pg8::EpiRes E{X1p(C), xout_p, (l == 0) ? (pg8::bf16_t*)Hp(C) : (pg8::bf16_t*)nullptr, (float*)(C.ws + WS_SSQ)};
              pg8::gemm_phase<pg8::EpiRes, pg8::StaticOrder>(ring, g, S, E, nullptr); }
        #endif
    PH_END
    }
#undef PH_BEGIN
#undef PH_END
}

extern "C" void kernel_launch(void* const* d_in, const int* in_sizes, int n_in, void* d_out, int out_size, void* d_ws, size_t ws_size, hipStream_t stream) {
    static int grid = 0;
    if (grid == 0) {
        if (n_in != 40 || out_size != (int)O_END || ws_size < WS_TOTAL) { fprintf(stderr, "kernel_launch: unexpected shapes: n_in %d out %d ws %zu (need %zu)\n", n_in, out_size, ws_size, (size_t)WS_TOTAL); grid = -1; return; }
        int dev = 0, cus = 0, per_cu = 0;
        if (hipGetDevice(&dev) != hipSuccess || hipDeviceGetAttribute(&cus, hipDeviceAttributeMultiprocessorCount, dev) != hipSuccess) { grid = -1; return; }
        if (hipFuncSetAttribute((const void*)fwd, hipFuncAttributeMaxDynamicSharedMemorySize, LDS_BYTES) != hipSuccess) { fprintf(stderr, "kernel_launch: hipFuncSetAttribute failed\n"); grid = -1; return; }
        if (hipOccupancyMaxActiveBlocksPerMultiprocessor(&per_cu, (const void*)fwd, 512, LDS_BYTES) != hipSuccess || per_cu < 1) fprintf(stderr, "kernel_launch: occupancy query reports %d\n", per_cu);
        (void)hipGetLastError();
        grid = cus;
    }
    if (grid < 0) return;
    if (hipMemsetAsync((char*)d_ws + WS_CTL, 0, MK_ONE_LAUNCH ? (size_t)32768 : CTL_BYTES, stream) != hipSuccess) return;
    Args a{};
    for (int i = 0; i < 40; ++i) a.in[i] = d_in[i];
    a.out = (float*)d_out; a.ws = (unsigned char*)d_ws; a.pad = 0;
#if MK_ONE_LAUNCH
    a.ph_lo = 0; a.ph_hi = N_PHASES; a.li = 0;
    hipLaunchKernelGGL(fwd, dim3(grid), dim3(512), LDS_BYTES, stream, a);
#else
    for (int p = 0; p < N_PHASES; ++p) { a.ph_lo = p; a.ph_hi = p + 1; a.li = p; hipLaunchKernelGGL(fwd, dim3(grid), dim3(512), LDS_BYTES, stream, a); }
#endif
}
```

```cpp
#include <hip/hip_runtime.h>
#include <cstdio>
#include <cstdint>
namespace pg8 {
#define PG8_LAS __attribute__((address_space(3)))
typedef unsigned short bf16_t;
typedef short bf16x8 __attribute__((ext_vector_type(8)));
typedef float f32x4 __attribute__((ext_vector_type(4)));
typedef unsigned u32x4 __attribute__((ext_vector_type(4)));
constexpr int BM = 256, BK = 64, HALF = 128, HTB = HALF * BK * 2  , STAGE_BYTES = 8 * HTB, NXCD = 8, WGM = 8;

__host__ __device__ __forceinline__ int lds_byte(int r, int c) { const int st = (r >> 4) * 2 + (c >> 5), rr = r & 15, cc = c & 31, ob = rr * 64 + cc * 2; return st * 1024 + (ob ^ (((ob >> 9) & 1) << 5)); }
__host__ __device__ __forceinline__ void stage_rc(int b, int& R, int& C) { const int st = b / 1024, sb = b % 1024, swz = sb ^ (((sb >> 9) & 1) << 5); R = (st >> 1) * 16 + swz / 64; C = (st & 1) * 32 + (swz % 64) / 2; }
__host__ __device__ __forceinline__ int perm32(int rho) { const int n = rho >> 4, i = rho & 15; return 8 * (i >> 2) + 4 * n + (i & 3); }

struct Unit { int pm, pn; };
struct Gemm { const bf16_t* A; const bf16_t* Bt; int M, N, K; };

struct StaticOrder {
    int nM, nN, nwg, G, c;
    __host__ __device__ void init(int M, int N, int G_, int c_) { nM = M / BM; nN = N / BM; nwg = nM * nN; G = G_; c = c_; }
    __host__ __device__ bool next(int i, Unit& u) const {
        const long L = (long)i * G + c; if (L >= nwg) return false;
        int wgid = (int)L; { const int q = nwg / NXCD, r = nwg % NXCD, xcd = wgid % NXCD, off = wgid / NXCD; wgid = (xcd < r ? xcd * (q + 1) : r * (q + 1) + (xcd - r) * q) + off; }
        const int nig = WGM * nN, gid = wgid / nig, fm = gid * WGM, gsz = (nM - fm) < WGM ? (nM - fm) : WGM;
        u.pm = fm + ((wgid % nig) % gsz); u.pn = (wgid % nig) / gsz; return true;
    }
    __device__ __forceinline__ void a_ready(const Unit&) const {}
    __device__ __forceinline__ void done(const Unit&) const {}
};
struct CountedOrder : StaticOrder {
    const unsigned* ready; unsigned need; unsigned* tmo;
    __device__ __forceinline__ void a_ready(const Unit& u) const {
        if (threadIdx.x < 64) {
            const unsigned long long t0 = __builtin_amdgcn_s_memrealtime(); unsigned polls = 0;
            while ((unsigned)__builtin_amdgcn_readfirstlane(__hip_atomic_load(ready + 64 * u.pm, __ATOMIC_RELAXED, __HIP_MEMORY_SCOPE_AGENT)) < need) {
                if ((++polls & 255u) == 0u && __builtin_amdgcn_readfirstlane(__hip_atomic_load(tmo, __ATOMIC_RELAXED, __HIP_MEMORY_SCOPE_AGENT)) != 0u) break;
                if (__builtin_amdgcn_s_memrealtime() - t0 > 2000000ull) {
                    if (threadIdx.x == 0) { unsigned expect = 0u; __hip_atomic_compare_exchange_strong(tmo + 1, &expect, 0x600u | (unsigned)(u.pm & 0xff), __ATOMIC_RELAXED, __ATOMIC_RELAXED, __HIP_MEMORY_SCOPE_AGENT); __hip_atomic_store(tmo, 1u, __ATOMIC_RELAXED, __HIP_MEMORY_SCOPE_AGENT); }
                    break; }
                __builtin_amdgcn_s_sleep(2); }
            __builtin_amdgcn_fence(__ATOMIC_ACQUIRE, "agent");
            asm volatile("s_waitcnt vmcnt(0)" ::: "memory");
        }
#if !defined(BROKEN_HOOK_NO_BARRIER)
        asm volatile("" ::: "memory"); __builtin_amdgcn_s_barrier(); asm volatile("" ::: "memory");
#endif
    }
};

__device__ __forceinline__ unsigned cvt_pk_bf16(float lo, float hi) { unsigned r; asm volatile("v_cvt_pk_bf16_f32 %0, %1, %2" : "=v"(r) : "v"(lo), "v"(hi)); return r; }
typedef float f32x2 __attribute__((ext_vector_type(2)));
__device__ __forceinline__ f32x2 gelu_pk(f32x2 v) {
    const f32x2 av = __builtin_elementwise_abs(v), d = av * 0.2316418882f + 1.0f;
    f32x2 t; t.x = __builtin_amdgcn_rcpf(d.x); t.y = __builtin_amdgcn_rcpf(d.y);
    f32x2 q = t * 0.5307027145f + (-0.7265760135f); q = q * t + 0.7107068705f; q = q * t + (-0.142248368f); q = q * t + 0.127414796f; q = q * t;
    const f32x2 s = (v * v) * (-0.72134752044f);
    f32x2 e; e.x = __builtin_amdgcn_exp2f(s.x); e.y = __builtin_amdgcn_exp2f(s.y);
    const f32x2 m = v * (q * e), r = v - m;
    f32x2 o; o.x = v.x < 0.f ? m.x : r.x; o.y = v.y < 0.f ? m.y : r.y; return o;
}

struct EpiF32 {
    static constexpr bool PERM = false, AFTER_DRAIN = false;
    float* C; int ldc; const float* bias;
    __device__ __forceinline__ void operator()(const f32x4 (&acc)[2][2][4][2], const Unit& u, int wr, int wc, int fr, int fq) const {
        const int row0 = u.pm * BM + wr * 64 + fr, col0 = u.pn * BM + wc * 32 + 4 * fq;
        f32x4 bv[2][2];
#pragma unroll
        for (int bj = 0; bj < 2; ++bj)
#pragma unroll
            for (int n = 0; n < 2; ++n) bv[bj][n] = bias ? *(const f32x4*)(bias + col0 + bj * HALF + n * 16) : (f32x4){0.f, 0.f, 0.f, 0.f};
#pragma unroll
        for (int ai = 0; ai < 2; ++ai)
#pragma unroll
            for (int m = 0; m < 4; ++m) { float* rowp = C + (size_t)(row0 + ai * HALF + m * 16) * ldc + col0;
#pragma unroll
                for (int bj = 0; bj < 2; ++bj)
#pragma unroll
                    for (int n = 0; n < 2; ++n) *(f32x4*)(rowp + bj * HALF + n * 16) = acc[ai][bj][m][n] + bv[bj][n]; }
    }
};
template <int ACT  > struct EpiBf16 {
    static constexpr bool PERM = true, AFTER_DRAIN = false;
    bf16_t* O; int ldc; const float* bias; int split_cols; size_t split_stride;
    __device__ __forceinline__ void operator()(const f32x4 (&acc)[2][2][4][2], const Unit& u, int wr, int wc, int fr, int fq) const {
        const int row0 = u.pm * BM + wr * 64 + fr; int colt = u.pn * BM; bf16_t* base = O;
        if (split_cols) { const int t = colt / split_cols; base += (size_t)t * split_stride; colt -= t * split_cols; }
        const int col0 = colt + wc * 32 + 8 * fq, bcol0 = u.pn * BM + wc * 32 + 8 * fq;
        f32x4 bv[2][2];
#pragma unroll
        for (int bj = 0; bj < 2; ++bj)
#pragma unroll
            for (int n = 0; n < 2; ++n) bv[bj][n] = bias ? *(const f32x4*)(bias + bcol0 + bj * HALF + 4 * n) : (f32x4){0.f, 0.f, 0.f, 0.f};
#pragma unroll
        for (int ai = 0; ai < 2; ++ai)
#pragma unroll
            for (int m = 0; m < 4; ++m) { bf16_t* rowp = base + (size_t)(row0 + ai * HALF + m * 16) * ldc + col0;
#pragma unroll
                for (int bj = 0; bj < 2; ++bj) { f32x4 v0 = acc[ai][bj][m][0] + bv[bj][0], v1 = acc[ai][bj][m][1] + bv[bj][1];
                    if (ACT == 1) { f32x2 a = gelu_pk((f32x2){v0[0], v0[1]}), b = gelu_pk((f32x2){v0[2], v0[3]}), c = gelu_pk((f32x2){v1[0], v1[1]}), d = gelu_pk((f32x2){v1[2], v1[3]});
                        v0 = (f32x4){a.x, a.y, b.x, b.y}; v1 = (f32x4){c.x, c.y, d.x, d.y}; }
                    if (ACT == 2) {
#pragma unroll
                        for (int j = 0; j < 4; ++j) { v0[j] = 0.5f * v0[j] * (1.0f + erff(v0[j] * 0.70710678f)); v1[j] = 0.5f * v1[j] * (1.0f + erff(v1[j] * 0.70710678f)); } }
                    u32x4 w; w.x = cvt_pk_bf16(v0[0], v0[1]); w.y = cvt_pk_bf16(v0[2], v0[3]); w.z = cvt_pk_bf16(v1[0], v1[1]); w.w = cvt_pk_bf16(v1[2], v1[3]);
                    *(u32x4*)(rowp + bj * HALF) = w; } }
    }
};

struct PanelStats {
    unsigned* xbuf;
    unsigned* cnt;
    unsigned* tmo;
    int ntn; float eps;
    unsigned code;
    __device__ __forceinline__ bool run(const f32x4 (&v)[2][2][4][2], const Unit& u, int wr, int wc, int fr, int fq, PG8_LAS unsigned char* lds, int wid, int lane) const {
        typedef float f32x2v __attribute__((ext_vector_type(2)));
        PG8_LAS f32x2v* P = (PG8_LAS f32x2v*)lds;
        PG8_LAS f32x2v* S = (PG8_LAS f32x2v*)(lds + 8192);
        PG8_LAS unsigned* flag = (PG8_LAS unsigned*)(lds + 8192 + 2048);
#pragma unroll
        for (int ai = 0; ai < 2; ++ai)
#pragma unroll
            for (int m = 0; m < 4; ++m) {
                float s = 0.f;
#pragma unroll
                for (int bj = 0; bj < 2; ++bj)
#pragma unroll
                    for (int n = 0; n < 2; ++n) { const f32x4 x = v[ai][bj][m][n]; s += (x[0] + x[1]) + (x[2] + x[3]); }
                s += __shfl_xor(s, 16); s += __shfl_xor(s, 32);
                const float mw = s * (1.0f / 64.0f); float q = 0.f;
#pragma unroll
                for (int bj = 0; bj < 2; ++bj)
#pragma unroll
                    for (int n = 0; n < 2; ++n) { const f32x4 d = v[ai][bj][m][n] - mw; q += (d[0] * d[0] + d[1] * d[1]) + (d[2] * d[2] + d[3] * d[3]); }
                q += __shfl_xor(q, 16); q += __shfl_xor(q, 32);
                if (fq == 0) P[(ai * HALF + wr * 64 + m * 16 + fr) * 4 + wc] = (f32x2v){mw, q};
            }
        asm volatile("s_waitcnt lgkmcnt(0)" ::: "memory"); __builtin_amdgcn_s_barrier(); asm volatile("" ::: "memory");
#if defined(BROKEN_NO_WAIT)
        if (blockIdx.x >= 64) { const long long t0 = clock64(); while (clock64() - t0 < 60000) __builtin_amdgcn_s_sleep(8); }
#endif
        const int row = wid * 32 + (lane & 31);
        if (lane < 32) {
            const f32x2v a = P[row * 4 + 0], b = P[row * 4 + 1], c = P[row * 4 + 2], d = P[row * 4 + 3];
            const float mt = (a.x + b.x + c.x + d.x) * 0.25f;
            const float da = a.x - mt, db = b.x - mt, dc = c.x - mt, dd = d.x - mt;
            const float m2 = (a.y + b.y) + (c.y + d.y) + 64.0f * ((da * da + db * db) + (dc * dc + dd * dd));
            unsigned long long* slot = (unsigned long long*)xbuf + ((size_t)(u.pm * BM + row) * 4 + u.pn);
            __hip_atomic_store(slot, ((unsigned long long)__float_as_uint(m2) << 32) | __float_as_uint(mt), __ATOMIC_RELAXED, __HIP_MEMORY_SCOPE_AGENT);
        }
        asm volatile("s_waitcnt vmcnt(0)" ::: "memory");
        if (lane == 0) __hip_atomic_fetch_add(cnt + 64 * u.pm, 1u, __ATOMIC_RELAXED, __HIP_MEMORY_SCOPE_AGENT);
        if (wid == 0) {
            bool dead = false; const unsigned long long t0 = __builtin_amdgcn_s_memrealtime(); const unsigned want = 8u * (unsigned)ntn;
            for (;;) {
#if defined(BROKEN_NO_WAIT)
                break;
#endif
                if ((unsigned)__builtin_amdgcn_readfirstlane(__hip_atomic_load(cnt + 64 * u.pm, __ATOMIC_RELAXED, __HIP_MEMORY_SCOPE_AGENT)) >= want) break;
                if (__builtin_amdgcn_s_memrealtime() - t0 > 2000000ull) {
                    if (lane == 0) { unsigned expect = 0u; __hip_atomic_compare_exchange_strong(tmo + 1, &expect, code | (unsigned)(u.pm & 0xff), __ATOMIC_RELAXED, __ATOMIC_RELAXED, __HIP_MEMORY_SCOPE_AGENT);
                                     __hip_atomic_store(tmo, 1u, __ATOMIC_RELAXED, __HIP_MEMORY_SCOPE_AGENT); }
                    dead = true; break; }
                __builtin_amdgcn_s_sleep(2);
            }
            __builtin_amdgcn_fence(__ATOMIC_ACQUIRE, "agent");
            if (lane == 0) flag[0] = dead ? 1u : 0u;
        }
        asm volatile("s_waitcnt vmcnt(0) lgkmcnt(0)" ::: "memory"); __builtin_amdgcn_s_barrier(); asm volatile("" ::: "memory");
        const bool bad = flag[0] != 0u;
        if (lane < 32) {
            const unsigned long long* slot = (const unsigned long long*)xbuf + (size_t)(u.pm * BM + row) * 4; float mt[4], m2[4]; float ms = 0.f;
#pragma unroll
            for (int t = 0; t < 4; ++t) { if (t < ntn) { const unsigned long long w = __hip_atomic_load(slot + t, __ATOMIC_RELAXED, __HIP_MEMORY_SCOPE_AGENT); mt[t] = __uint_as_float((unsigned)w); m2[t] = __uint_as_float((unsigned)(w >> 32)); } else { mt[t] = 0.f; m2[t] = 0.f; } ms += mt[t]; }
            const float mean = ms / (float)ntn; float q = 0.f;
#pragma unroll
            for (int t = 0; t < 4; ++t) if (t < ntn) { const float dm = mt[t] - mean; q += m2[t] + 256.0f * dm * dm; }
            S[row] = (f32x2v){mean, 1.0f / sqrtf(q / (256.0f * (float)ntn) + eps)};
        }
        asm volatile("s_waitcnt lgkmcnt(0)" ::: "memory"); __builtin_amdgcn_s_barrier(); asm volatile("" ::: "memory");
        return bad;
    }
};
struct EpiLnRes {
    static constexpr bool PERM = false, AFTER_DRAIN = true;
    const float* base; float* out; int ldc; const float* bias; PanelStats st; unsigned poison;
    __device__ __forceinline__ void refuse(size_t i0, size_t stride, int M, int N) const { const float q = __builtin_nanf(""); for (size_t i = i0; i < (size_t)M * N; i += stride) out[(i / N) * ldc + i % N] = q;
        if (i0 == 0) { unsigned expect = 0u; __hip_atomic_compare_exchange_strong(st.tmo + 1, &expect, 0x7f0u, __ATOMIC_RELAXED, __ATOMIC_RELAXED, __HIP_MEMORY_SCOPE_AGENT); __hip_atomic_store(st.tmo, 1u, __ATOMIC_RELAXED, __HIP_MEMORY_SCOPE_AGENT); } }
    __device__ __forceinline__ void fused(f32x4 (&acc)[2][2][4][2], const Unit& u, int wr, int wc, int fr, int fq, PG8_LAS unsigned char* lds, int wid, int lane) const {
        typedef float f32x2v __attribute__((ext_vector_type(2)));
        const PG8_LAS f32x2v* S = (const PG8_LAS f32x2v*)(lds + 8192);
        const int col0 = u.pn * BM + wc * 32 + 4 * fq;
#pragma unroll
        for (int bj = 0; bj < 2; ++bj)
#pragma unroll
            for (int n = 0; n < 2; ++n) { const f32x4 bv = bias ? *(const f32x4*)(bias + col0 + bj * HALF + n * 16) : (f32x4){0.f, 0.f, 0.f, 0.f};
#pragma unroll
                for (int ai = 0; ai < 2; ++ai)
#pragma unroll
                    for (int m = 0; m < 4; ++m) acc[ai][bj][m][n] += bv; }
        const bool bad = st.run(acc, u, wr, wc, fr, fq, lds, wid, lane) || poison != 0u;
        const float qnan = __builtin_nanf("");
#pragma unroll
        for (int ai = 0; ai < 2; ++ai)
#pragma unroll
            for (int m = 0; m < 4; ++m) { const int r = ai * HALF + wr * 64 + m * 16 + fr; const f32x2v sr = S[r]; const size_t off = (size_t)(u.pm * BM + r) * ldc + col0;
#pragma unroll
                for (int bj = 0; bj < 2; ++bj)
#pragma unroll
                    for (int n = 0; n < 2; ++n) { const f32x4 bs = *(const f32x4*)(base + off + bj * HALF + n * 16); f32x4 o = bs + (acc[ai][bj][m][n] - sr.x) * sr.y;
                        if (bad) o = (f32x4){qnan, qnan, qnan, qnan}; *(f32x4*)(out + off + bj * HALF + n * 16) = o; }
                asm volatile("" ::: "memory"); }
    }
};
struct EpiLnResLn {
    static constexpr bool PERM = false, AFTER_DRAIN = true;
    const float* base; float* out; bf16_t* xn; int ldc; const float* bias; PanelStats st1, st2; unsigned poison;
    __device__ __forceinline__ void refuse(size_t i0, size_t stride, int M, int N) const { const float q = __builtin_nanf(""); for (size_t i = i0; i < (size_t)M * N; i += stride) { const size_t o = (i / N) * ldc + i % N; out[o] = q; xn[o] = (bf16_t)0x7fc0u; }
        if (i0 == 0) { unsigned expect = 0u; __hip_atomic_compare_exchange_strong(st1.tmo + 1, &expect, 0x7f0u, __ATOMIC_RELAXED, __ATOMIC_RELAXED, __HIP_MEMORY_SCOPE_AGENT); __hip_atomic_store(st1.tmo, 1u, __ATOMIC_RELAXED, __HIP_MEMORY_SCOPE_AGENT); } }
    __device__ __forceinline__ void fused(f32x4 (&acc)[2][2][4][2], const Unit& u, int wr, int wc, int fr, int fq, PG8_LAS unsigned char* lds, int wid, int lane) const {
        typedef float f32x2v __attribute__((ext_vector_type(2))); typedef unsigned u32x2v __attribute__((ext_vector_type(2)));
        const PG8_LAS f32x2v* S = (const PG8_LAS f32x2v*)(lds + 8192);
        const int col0 = u.pn * BM + wc * 32 + 4 * fq;
#pragma unroll
        for (int bj = 0; bj < 2; ++bj)
#pragma unroll
            for (int n = 0; n < 2; ++n) { const f32x4 bv = bias ? *(const f32x4*)(bias + col0 + bj * HALF + n * 16) : (f32x4){0.f, 0.f, 0.f, 0.f};
#pragma unroll
                for (int ai = 0; ai < 2; ++ai)
#pragma unroll
                    for (int m = 0; m < 4; ++m) acc[ai][bj][m][n] += bv; }
        bool bad = st1.run(acc, u, wr, wc, fr, fq, lds, wid, lane) || poison != 0u;
        const float qnan = __builtin_nanf("");
#pragma unroll
        for (int ai = 0; ai < 2; ++ai)
#pragma unroll
            for (int m = 0; m < 4; ++m) { const int r = ai * HALF + wr * 64 + m * 16 + fr; const f32x2v sr = S[r]; const size_t off = (size_t)(u.pm * BM + r) * ldc + col0;
#pragma unroll
                for (int bj = 0; bj < 2; ++bj)
#pragma unroll
                    for (int n = 0; n < 2; ++n) { const f32x4 bs = *(const f32x4*)(base + off + bj * HALF + n * 16); acc[ai][bj][m][n] = bs + (acc[ai][bj][m][n] - sr.x) * sr.y; }
                asm volatile("" : "+v"(acc[ai][0][m][0]), "+v"(acc[ai][0][m][1]), "+v"(acc[ai][1][m][0]), "+v"(acc[ai][1][m][1]));
                if (m & 1) asm volatile("" ::: "memory"); }
        const bool bad1 = bad;
        bad = st2.run(acc, u, wr, wc, fr, fq, lds, wid, lane) || bad;
#pragma unroll
        for (int ai = 0; ai < 2; ++ai)
#pragma unroll
            for (int m = 0; m < 4; ++m) { const int r = ai * HALF + wr * 64 + m * 16 + fr; const f32x2v sr = S[r]; const size_t off = (size_t)(u.pm * BM + r) * ldc + col0;
#pragma unroll
                for (int bj = 0; bj < 2; ++bj)
#pragma unroll
                    for (int n = 0; n < 2; ++n) { const f32x4 x1 = acc[ai][bj][m][n]; *(f32x4*)(out + off + bj * HALF + n * 16) = bad1 ? (f32x4){qnan, qnan, qnan, qnan} : x1;
                        const f32x4 o = (x1 - sr.x) * sr.y; u32x2v w; w.x = cvt_pk_bf16(o[0], o[1]); w.y = cvt_pk_bf16(o[2], o[3]);
                        if (bad) { w.x = 0x7fc07fc0u; w.y = 0x7fc07fc0u; } *(u32x2v*)(xn + off + bj * HALF + n * 16) = w; }
                asm volatile("" ::: "memory"); }
    }
};

template <class Epi, class Sched, bool STAMP = false>
__device__ __forceinline__ void gemm_phase(PG8_LAS unsigned char* lds, const Gemm g, const Sched& S, const Epi& E, unsigned long long* stamps) {
    int tid_o = threadIdx.x; asm volatile("" : "+v"(tid_o));
    const int tid = tid_o, wid = __builtin_amdgcn_readfirstlane(tid >> 6), lane = tid & 63, wr = wid >> 2, wc = wid & 3, fr = lane & 15, fq = lane >> 4;
    const int K = g.K, nt = K / BK;
    int ts_lo = 0, ts_hi = 0, nts = 0; const unsigned long long rt_entry = STAMP ? (unsigned long long)wall_clock64() : 0ull;
#define PG8_STAMP() do { if (STAMP && wid == 0 && nts < 64) { const unsigned long long _c = (unsigned long long)clock64(); \
        ts_lo = (lane == nts) ? (int)(unsigned)_c : ts_lo; ts_hi = (lane == nts) ? (int)(unsigned)(_c >> 32) : ts_hi; ++nts; } } while (0)
    PG8_STAMP();
    unsigned voffA[2], voffB[2];
#pragma unroll
    for (int i = 0; i < 2; ++i) { int R, C; stage_rc(tid * 16 + i * 8192, R, C); const int Rb = Epi::PERM ? ((R & ~31) + perm32(R & 31)) : R;
        voffA[i] = (unsigned)(R * K + C) * 2u; voffB[i] = (unsigned)(Rb * K + C) * 2u; }
    const size_t kstep = (size_t)(BK * 2);
    const size_t hstep = (size_t)HALF * K * 2;
    const size_t tstep = 2 * hstep;
    const unsigned ldsw = (unsigned)wid * 1024u;
    const int aoff = lds_byte(wr * 64 + fr, fq * 8), boff = lds_byte(wc * 32 + fr, fq * 8);
#define PG8_SA(b, h) (((b) * 2 + (h)) * HTB)
#define PG8_SB(b, h) ((4 + (b) * 2 + (h)) * HTB)
#define PG8_STAGE(bufoff, gbase, voff) do { _Pragma("unroll") for (int _i = 0; _i < 2; ++_i) \
        __builtin_amdgcn_global_load_lds((const unsigned*)((const char*)(gbase) + (voff)[_i]), (PG8_LAS unsigned*)(lds + (bufoff) + ldsw + _i * 8192), 16, 0, 0); } while (0)
#define PG8_LDA(dst, b, h) do { _Pragma("unroll") for (int m = 0; m < 4; ++m) _Pragma("unroll") for (int k = 0; k < 2; ++k) dst[m][k] = *(const PG8_LAS bf16x8*)(lds + PG8_SA(b, h) + aoff + m * 2048 + k * 1024); } while (0)
#define PG8_LDB(dst, b, h) do { _Pragma("unroll") for (int n = 0; n < 2; ++n) _Pragma("unroll") for (int k = 0; k < 2; ++k) dst[n][k] = *(const PG8_LAS bf16x8*)(lds + PG8_SB(b, h) + boff + n * 2048 + k * 1024); } while (0)
#define PG8_MMA(ai, bj, At, Bt) do { __builtin_amdgcn_s_setprio(1); _Pragma("unroll") for (int m = 0; m < 4; ++m) _Pragma("unroll") for (int n = 0; n < 2; ++n) _Pragma("unroll") for (int k = 0; k < 2; ++k) \
        acc[ai][bj][m][n] = __builtin_amdgcn_mfma_f32_16x16x32_bf16(Bt[n][k], At[m][k], acc[ai][bj][m][n], 0, 0, 0); __builtin_amdgcn_s_setprio(0); } while (0)
#define PG8_WAIT_V(n) asm volatile("s_waitcnt vmcnt(" #n ")" ::: "memory")
#define PG8_WAIT_L(n) asm volatile("s_waitcnt lgkmcnt(" #n ")" ::: "memory")
#define PG8_BAR __builtin_amdgcn_s_barrier()
#define PG8_SCHED __builtin_amdgcn_sched_barrier(0)
    Unit cur, nxt; int ui = 0;
    if (!S.next(0, cur)) return;
    f32x4 acc[2][2][4][2];
#pragma unroll
    for (int a = 0; a < 2; ++a)
#pragma unroll
        for (int b = 0; b < 2; ++b)
#pragma unroll
            for (int m = 0; m < 4; ++m)
#pragma unroll
                for (int n = 0; n < 2; ++n) acc[a][b][m][n] = (f32x4){0.f, 0.f, 0.f, 0.f};
    bf16x8 At[4][2], B0[2][2], B1[2][2];
    const char* cA = (const char*)g.A + (size_t)cur.pm * tstep; const char* cB = (const char*)g.Bt + (size_t)cur.pn * tstep;
    S.a_ready(cur);
    PG8_STAGE(PG8_SB(0, 0), cB, voffB); PG8_STAGE(PG8_SA(0, 0), cA, voffA); PG8_STAGE(PG8_SB(0, 1), cB + hstep, voffB); PG8_STAGE(PG8_SA(0, 1), cA + hstep, voffA);
    if (wr == 1) PG8_BAR;
    PG8_WAIT_V(4); PG8_BAR;
    PG8_STAGE(PG8_SB(1, 0), cB + kstep, voffB); PG8_STAGE(PG8_SA(1, 0), cA + kstep, voffA); PG8_STAGE(PG8_SB(1, 1), cB + hstep + kstep, voffB);
    PG8_WAIT_V(6); PG8_BAR;
    PG8_STAMP();
    for (;;) {
        const bool has_next = S.next(ui + 1, nxt);
        const char* nA = has_next ? (const char*)g.A + (size_t)nxt.pm * tstep : cA; const char* nB = has_next ? (const char*)g.Bt + (size_t)nxt.pn * tstep : cB;
        for (int t = 0; t < nt; t += 2) {
            const bool last = (t == nt - 2);
            const char* a1 = cA + (size_t)(t + 1) * kstep;
            const char* a2 = last ? nA : cA + (size_t)(t + 2) * kstep; const char* b2 = last ? nB : cB + (size_t)(t + 2) * kstep;
            const char* a3 = a2 + kstep; const char* b3 = b2 + kstep;
            if (last && has_next) S.a_ready(nxt);
            PG8_LDB(B0, 0, 0); PG8_SCHED; PG8_LDA(At, 0, 0); PG8_STAGE(PG8_SA(1, 1), a1 + hstep, voffA);
            PG8_WAIT_L(8); PG8_BAR; PG8_WAIT_L(0); PG8_MMA(0, 0, At, B0); PG8_BAR; PG8_SCHED;
            PG8_LDB(B1, 0, 1); PG8_STAGE(PG8_SB(0, 0), b2, voffB);
            PG8_BAR; PG8_WAIT_L(0); PG8_MMA(0, 1, At, B1); PG8_BAR;
            PG8_LDA(At, 0, 1); PG8_STAGE(PG8_SA(0, 0), a2, voffA);
            PG8_BAR; PG8_WAIT_L(0); PG8_MMA(1, 0, At, B0); PG8_BAR; PG8_SCHED;
            PG8_STAGE(PG8_SB(0, 1), b2 + hstep, voffB);
            PG8_WAIT_V(6); PG8_BAR; PG8_MMA(1, 1, At, B1); PG8_BAR;
            PG8_LDB(B0, 1, 0); PG8_SCHED; PG8_LDA(At, 1, 0); PG8_STAGE(PG8_SA(0, 1), a2 + hstep, voffA);
            PG8_WAIT_L(8); PG8_BAR; PG8_WAIT_L(0); PG8_MMA(0, 0, At, B0); PG8_BAR; PG8_SCHED;
            PG8_LDB(B1, 1, 1); PG8_STAGE(PG8_SB(1, 0), b3, voffB);
            PG8_BAR; PG8_WAIT_L(0); PG8_MMA(0, 1, At, B1); PG8_BAR;
            PG8_LDA(At, 1, 1); PG8_STAGE(PG8_SA(1, 0), a3, voffA);
            PG8_BAR; PG8_WAIT_L(0); PG8_MMA(1, 0, At, B0); PG8_BAR; PG8_SCHED;
            PG8_STAGE(PG8_SB(1, 1), b3 + hstep, voffB);
            PG8_WAIT_V(6); PG8_BAR; PG8_MMA(1, 1, At, B1); PG8_BAR;
        }
        PG8_STAMP();
        if constexpr (!Epi::AFTER_DRAIN) { E(acc, cur, wr, wc, fr, fq); S.done(cur); }
        PG8_STAMP();
        if (!has_next) break;
#pragma unroll
        for (int a = 0; a < 2; ++a)
#pragma unroll
            for (int b = 0; b < 2; ++b)
#pragma unroll
                for (int m = 0; m < 4; ++m)
#pragma unroll
                    for (int n = 0; n < 2; ++n) acc[a][b][m][n] = (f32x4){0.f, 0.f, 0.f, 0.f};
        cur = nxt; cA = nA; cB = nB; ++ui;
    }
    PG8_WAIT_V(0);
    if (wr == 0) PG8_BAR;
    PG8_BAR;
    if constexpr (Epi::AFTER_DRAIN) { E.fused(acc, cur, wr, wc, fr, fq, lds, wid, lane); S.done(cur); }
    PG8_STAMP();
    if (STAMP && wid == 0) { stamps[lane] = lane < nts ? (((unsigned long long)(unsigned)ts_hi << 32) | (unsigned)ts_lo) : 0ull;
        if (lane == 62) stamps[62] = rt_entry; if (lane == 63) stamps[63] = (unsigned long long)wall_clock64(); }
#undef PG8_STAMP
#undef PG8_SA
#undef PG8_SB
#undef PG8_STAGE
#undef PG8_LDA
#undef PG8_LDB
#undef PG8_MMA
#undef PG8_WAIT_V
#undef PG8_WAIT_L
#undef PG8_BAR
#undef PG8_SCHED
}
}
#define XB_TMO      128
#define XB_XCNT(j)  (256  + 64 * (j))
#define XB_XSUB(j)  (1280 + 64 * (j))
#define XB_XGEN(j)  (2304 + 64 * (j))
#define XB_TOP      3328
#define XB_TOPGEN   3392
#define XCD_BAR_WORDS 3456
#define XB_SPIN_CAP (1u << 22)
#define LAS __attribute__((address_space(3)))

__device__ __forceinline__ unsigned xb_ld(unsigned* p)              { return __hip_atomic_load(p, __ATOMIC_RELAXED, __HIP_MEMORY_SCOPE_AGENT); }
__device__ __forceinline__ unsigned xb_add(unsigned* p, unsigned v) { return __hip_atomic_fetch_add(p, v, __ATOMIC_RELAXED, __HIP_MEMORY_SCOPE_AGENT); }
__device__ __forceinline__ unsigned xb_xcc_id() { return (unsigned)__builtin_amdgcn_s_getreg((3 << 11) | 20) & 0xFu; }
#define XB_SPIN(cond, bar) do { unsigned _sp = 0; while (cond) { __builtin_amdgcn_s_sleep(1); \
    if ((++_sp & 255u) == 0u) { if (xb_ld(&(bar)[XB_TMO])) break; if (_sp > XB_SPIN_CAP) { atomicAdd(&(bar)[XB_TMO], 1u); break; } } } } while (0)

struct XcdBarrier {
    unsigned* bar; unsigned x;
    volatile LAS unsigned* st;
};

__device__ __forceinline__ XcdBarrier xcd_barrier_post(unsigned* bar, volatile LAS unsigned* st) {
    XcdBarrier b; b.bar = bar; b.x = xb_xcc_id(); b.st = st;
    if (threadIdx.x == 0) (void)xb_add(&bar[XB_XCNT(b.x)], 1u);
    return b;
}
__device__ __forceinline__ void xcd_barrier_complete(unsigned* bar, unsigned x, unsigned& nloc, unsigned& nx) {
    const unsigned G = gridDim.x * gridDim.y * gridDim.z;
    unsigned sum, cnt, mine, sp = 0u;
    for (;;) {
        sum = 0u; cnt = 0u; mine = 0u;
#pragma unroll
        for (unsigned j = 0; j < 16; ++j) { const unsigned c = xb_ld(&bar[XB_XCNT(j)]); sum += c; cnt += (c > 0u) ? 1u : 0u; mine = (j == x) ? c : mine; }
        if (sum == G) break;
        __builtin_amdgcn_s_sleep(1);
        if ((++sp & 255u) == 0u) { if (xb_ld(&bar[XB_TMO])) break; if (sp > XB_SPIN_CAP) { atomicAdd(&bar[XB_TMO], 1u); break; } }
    }
    nloc = mine > 0u ? mine : 1u; nx = cnt > 0u ? cnt : 1u;
}

__device__ __forceinline__ void xcd_barrier(const XcdBarrier& b) {
    asm volatile("s_waitcnt vmcnt(0)" ::: "memory");
    __syncthreads();
    if (threadIdx.x == 0) {
        unsigned* bar = b.bar;
        __builtin_amdgcn_s_waitcnt(0);
        unsigned nloc = b.st[0], nx = b.st[1];
        if (nloc == 0u) { xcd_barrier_complete(bar, b.x, nloc, nx); b.st[0] = nloc; b.st[1] = nx; }
        const unsigned old = xb_add(&bar[XB_XSUB(b.x)], 1u);
        const unsigned gen = old / nloc;
        if (old + 1u == (gen + 1u) * nloc) {
            __builtin_amdgcn_fence(__ATOMIC_RELEASE, "agent");
            asm volatile("s_waitcnt vmcnt(0)" ::: "memory");
            const unsigned og = xb_add(&bar[XB_TOP], 1u);
            const unsigned tg = og / nx;
            if (og + 1u == (tg + 1u) * nx) xb_add(&bar[XB_TOPGEN], 1u);
            else XB_SPIN(xb_ld(&bar[XB_TOPGEN]) == tg, bar);
            __builtin_amdgcn_fence(__ATOMIC_ACQUIRE, "agent");
            xb_add(&bar[XB_XGEN(b.x)], 1u);
            asm volatile("s_waitcnt vmcnt(0)" ::: "memory");
        } else {
            XB_SPIN(xb_ld(&bar[XB_XGEN(b.x)]) == gen, bar);
            __builtin_amdgcn_fence(__ATOMIC_ACQUIRE, "agent");
            asm volatile("s_waitcnt vmcnt(0)" ::: "memory");
        }
    }
    __syncthreads();
}

#define DI __device__ __forceinline__
typedef unsigned short bf16;
typedef float f32x4 __attribute__((ext_vector_type(4)));
typedef unsigned u32x4 __attribute__((ext_vector_type(4)));
typedef unsigned u32x2 __attribute__((ext_vector_type(2)));

constexpr int D = 1024, NB = 4, SEQ = 4096, MP = NB * SEQ, SB = 32, MR = MP + SB, MPAD = MP + 256;
constexpr int PAST = 8192, NPOOL = 2560;
constexpr int NP = 3328, DFF = 4096, NGATE = 4096, BW = 256;
constexpr int C_S5U = 0, C_AQ = 256, C_AK = 512, C_AV = 768, C_AR = 1024, C_DQ = 1280, C_DK = 1536, C_DV = 1792, C_DZ = 2048, C_MQ = 2304, C_MK = 2560, C_MV = 2816, C_LR = 3072, C_DB = 3088, C_DA = 3092;
constexpr size_t O_YP = 0, O_YS = O_YP + (size_t)MP * D, O_PMK = O_YS + (size_t)SB * D, O_PMV = O_PMK + (size_t)2 * MP * 256, O_PS5R = O_PMV + (size_t)2 * MP * 256,
                 O_PS5I = O_PS5R + 2 * NB * 1024, O_PGLA = O_PS5I + 2 * NB * 1024, O_PGDN = O_PGLA + 2 * NB * 16384, O_PCONV = O_PGDN + 2 * NB * 16384,
                 O_SMK = O_PCONV + 2 * NB * 3 * 768, O_SMV = O_SMK + 2 * SB * 256, O_SS5R = O_SMV + 2 * SB * 256, O_SS5I = O_SS5R + 2 * SB * 1024,
                 O_SGLA = O_SS5I + 2 * SB * 1024, O_SGDN = O_SGLA + (size_t)2 * SB * 16384, O_SCONV = O_SGDN + (size_t)2 * SB * 16384, O_END = O_SCONV + 2 * SB * 3 * 768;
static_assert(O_END == 36292608, "output size");
constexpr size_t al256(size_t x) { return (x + 255) & ~(size_t)255; }
constexpr size_t WS_CTL = 0, CTL_BYTES = 1u << 20;
constexpr size_t WSZ_WIN = (size_t)NP * D * 2, WSZ_WG = (size_t)NGATE * D * 2, WSZ_WBR = (size_t)4 * D * BW * 2, WSZ_WOUT = (size_t)D * D * 2, WSZ_FF1 = (size_t)DFF * D * 2, WSZ_FF2 = (size_t)D * DFF * 2;
constexpr size_t WO_WIN = 0, WO_WG = WO_WIN + WSZ_WIN, WO_WBR = WO_WG + WSZ_WG, WO_WOUT = WO_WBR + WSZ_WBR, WO_FF1 = WO_WOUT + WSZ_WOUT, WO_FF2 = WO_FF1 + WSZ_FF1, W_LAYER = al256(WO_FF2 + WSZ_FF2);
constexpr size_t WS_W = CTL_BYTES;
constexpr size_t WS_H = WS_W + 2 * W_LAYER;
constexpr size_t WS_PROJ = WS_H + (size_t)MPAD * D * 2;
constexpr size_t WS_GATE = WS_PROJ + (size_t)MPAD * NP * 4;
constexpr size_t WS_Y = WS_GATE + (size_t)MPAD * NGATE * 2;
constexpr size_t YSTRIDE = (size_t)MPAD * BW * 2;
constexpr size_t WS_M32 = WS_Y + 4 * YSTRIDE;
constexpr size_t WS_MRG = WS_M32 + (size_t)MPAD * D * 4;
constexpr size_t WS_SSQ = WS_M32;
constexpr size_t WS_SSQS = WS_SSQ + (size_t)MP * 16 * 4;
constexpr size_t WS_X1 = WS_MRG + (size_t)MPAD * D * 2;
constexpr size_t WS_X2 = WS_X1 + (size_t)MPAD * D * 4;
constexpr size_t WS_Z = WS_X2 + (size_t)MPAD * D * 4;
constexpr size_t WS_TMP = WS_Z + (size_t)MPAD * DFF * 2;
constexpr size_t TSTRIDE = (size_t)MPAD * BW * 4;
constexpr int T_LA = 0, T_GQ = 1, T_GK = 2, T_GV = 3, T_MQ = 4, T_YPRE = 5, T_OGLA = 6, T_OGDN = 7, T_N = 8;
constexpr size_t WS_GB = WS_TMP + T_N * TSTRIDE;
constexpr size_t WS_KM = WS_GB + 2 * (size_t)MPAD * 4 * 4;
constexpr size_t WS_KMS = WS_KM + 4 * 16 * 256 * 4;
constexpr size_t WS_END = WS_KMS + 32 * 32 * 256 * 4;
constexpr int CW_BAR = 1024;
constexpr int RING_BYTES = 131072, MISC_OFF = RING_BYTES + 320, LDS_BYTES = 147456;
constexpr int RS_OFF = RING_BYTES + 1024;
#define LASQ __attribute__((address_space(3)))

DI float wsum(float v) {
#pragma unroll
    for (int o = 32; o >= 1; o >>= 1) v += __shfl_xor(v, o);
    return v;
}
DI float wmaxf(float v) {
#pragma unroll
    for (int o = 32; o >= 1; o >>= 1) v = fmaxf(v, __shfl_xor(v, o));
    return v;
}
DI unsigned f2bf(float f) { unsigned u = __builtin_bit_cast(unsigned, f); return (u + 0x7fffu + ((u >> 16) & 1u)) >> 16; }
DI unsigned pk2(float lo, float hi) { return f2bf(lo) | (f2bf(hi) << 16); }
DI float bflo(unsigned w) { return __builtin_bit_cast(float, w << 16); }
DI float bfhi(unsigned w) { return __builtin_bit_cast(float, w & 0xffff0000u); }
DI float rcp_(float x) { return __builtin_amdgcn_rcpf(x); }
DI float rsq_(float x) { return __builtin_amdgcn_rsqf(x); }
DI float sigmoid_(float x) { return rcp_(1.f + __expf(-x)); }
DI float silu_(float x) { return x * sigmoid_(x); }
DI float softplus_(float x) { return x > 20.f ? x : __logf(1.f + __expf(x)); }
DI float logsigmoid_(float x) { return -softplus_(-x); }
DI float gelu_tanh_(float x) { const float u = 0.7978845608028654f * (x + 0.044715f * x * x * x); return x * rcp_(1.f + __expf(-2.f * u)); }

namespace pg8 {
#define EPI_OPAQUE_LANE() int fr = fr_, fq = fq_; asm volatile("" : "+v"(fr), "+v"(fq))
template <unsigned LDC> struct EpiStoreF32 {
    static constexpr bool PERM = false, AFTER_DRAIN = false;
    float* C; const LASQ float* rs; mutable int k;
    __device__ __forceinline__ void operator()(const f32x4 (&acc)[2][2][4][2], const Unit& u, int wr, int wc, int fr_, int fq_) const {
        EPI_OPAQUE_LANE();
        const unsigned row0 = (unsigned)(u.pm * BM + wr * 64 + fr), col0 = (unsigned)(u.pn * BM + wc * 32 + 4 * fq);
        const unsigned o0 = (row0 * LDC + col0) * 4u; char* cb = (char*)C;
        const LASQ float* rp = rs + k * 256 + wr * 64 + fr; ++k;
#pragma unroll
        for (int ai = 0; ai < 2; ++ai)
#pragma unroll
            for (int m = 0; m < 4; ++m) { const float sc = rp[ai * HALF + m * 16];
#pragma unroll
                for (int bj = 0; bj < 2; ++bj)
#pragma unroll
                    for (int n = 0; n < 2; ++n) *(f32x4*)(cb + (o0 + ((unsigned)(ai * HALF + m * 16) * LDC + (unsigned)(bj * HALF + n * 16)) * 4u)) = acc[ai][bj][m][n] * sc; }
    }
};
template <int ACT, unsigned LDC> struct EpiActBf16 {
    static constexpr bool PERM = true, AFTER_DRAIN = false;
    bf16_t* O; const LASQ float* rs; mutable int k;
    __device__ __forceinline__ void operator()(const f32x4 (&acc)[2][2][4][2], const Unit& u, int wr, int wc, int fr_, int fq_) const {
        EPI_OPAQUE_LANE();
        const unsigned row0 = (unsigned)(u.pm * BM + wr * 64 + fr), col0 = (unsigned)(u.pn * BM + wc * 32 + 8 * fq);
        const unsigned o0 = (row0 * LDC + col0) * 2u; char* ob = (char*)O;
        const LASQ float* rp = rs + k * 256 + wr * 64 + fr; ++k;
#pragma unroll
        for (int ai = 0; ai < 2; ++ai)
#pragma unroll
            for (int m = 0; m < 4; ++m) { const float sc = rp[ai * HALF + m * 16];
#pragma unroll
                for (int bj = 0; bj < 2; ++bj) { f32x4 v0 = acc[ai][bj][m][0] * sc, v1 = acc[ai][bj][m][1] * sc;
#pragma unroll
                    for (int j = 0; j < 4; ++j) {
                        if (ACT == 0) { v0[j] = __builtin_amdgcn_rcpf(1.f + __expf(-v0[j])); v1[j] = __builtin_amdgcn_rcpf(1.f + __expf(-v1[j])); }
                        else { const float a = fmaxf(v0[j], 0.f), b = fmaxf(v1[j], 0.f); v0[j] = a * a; v1[j] = b * b; } }
                    u32x4 w; w.x = cvt_pk_bf16(v0[0], v0[1]); w.y = cvt_pk_bf16(v0[2], v0[3]); w.z = cvt_pk_bf16(v1[0], v1[1]); w.w = cvt_pk_bf16(v1[2], v1[3]);
                    *(u32x4*)(ob + (o0 + ((unsigned)(ai * HALF + m * 16) * LDC + (unsigned)(bj * HALF)) * 2u)) = w; } }
    }
};
template <int MODE> struct EpiGate {
    static constexpr bool PERM = true, AFTER_DRAIN = false;
    static constexpr unsigned LDG = 4096, LD = 1024;
    const bf16_t* gate; float* m32; bf16_t* mrg;
    __device__ __forceinline__ void operator()(const f32x4 (&acc)[2][2][4][2], const Unit& u, int wr, int wc, int fr_, int fq_) const {
        EPI_OPAQUE_LANE();
        const unsigned row0 = (unsigned)(u.pm * BM + wr * 64 + fr), col0 = (unsigned)(u.pn * BM + wc * 32 + 8 * fq);
        const unsigned g0 = (row0 * LDG + col0) * 2u, m0 = (row0 * LD + col0) * 4u, b0 = (row0 * LD + col0) * 2u;
        const char* gb = (const char*)gate; char* mb = (char*)m32; char* bb = (char*)mrg;
#pragma unroll
        for (int ai = 0; ai < 2; ++ai)
#pragma unroll
            for (int m = 0; m < 4; ++m) { const unsigned dr = (unsigned)(ai * HALF + m * 16);
#pragma unroll
                for (int bj = 0; bj < 2; ++bj) { const unsigned dc = (unsigned)(bj * HALF);
                    const u32x4 gw = *(const u32x4*)(gb + (g0 + (dr * LDG + dc) * 2u));
                    f32x4 v0 = acc[ai][bj][m][0], v1 = acc[ai][bj][m][1];
                    v0[0] *= __builtin_bit_cast(float, gw.x << 16); v0[1] *= __builtin_bit_cast(float, gw.x & 0xffff0000u);
                    v0[2] *= __builtin_bit_cast(float, gw.y << 16); v0[3] *= __builtin_bit_cast(float, gw.y & 0xffff0000u);
                    v1[0] *= __builtin_bit_cast(float, gw.z << 16); v1[1] *= __builtin_bit_cast(float, gw.z & 0xffff0000u);
                    v1[2] *= __builtin_bit_cast(float, gw.w << 16); v1[3] *= __builtin_bit_cast(float, gw.w & 0xffff0000u);
                    const unsigned mo = m0 + (dr * LD + dc) * 4u;
                    if (MODE != 0) { v0 += *(const f32x4*)(mb + mo); v1 += *(const f32x4*)(mb + mo + 16u); }
                    if (MODE != 2) { *(f32x4*)(mb + mo) = v0; *(f32x4*)(mb + mo + 16u) = v1; }
                    else { u32x4 w; w.x = cvt_pk_bf16(v0[0], v0[1]); w.y = cvt_pk_bf16(v0[2], v0[3]); w.z = cvt_pk_bf16(v1[0], v1[1]); w.w = cvt_pk_bf16(v1[2], v1[3]);
                           *(u32x4*)(bb + (b0 + (dr * LD + dc) * 2u)) = w; }
                    asm volatile("" ::: "memory"); } }
    }
};
struct EpiRes {
    static constexpr bool PERM = false, AFTER_DRAIN = false;
    static constexpr unsigned LD = 1024;
    const float* base_p; float* out_p; bf16_t* hb; float* ssq;
    __device__ __forceinline__ void operator()(const f32x4 (&acc)[2][2][4][2], const Unit& u, int wr, int wc, int fr_, int fq_) const {
        EPI_OPAQUE_LANE();
        const char* bb = (const char*)base_p; char* ob = (char*)out_p; char* hbb = (char*)hb;
        const int rl0 = u.pm * BM + wr * 64 + fr; const unsigned col0 = (unsigned)(u.pn * BM + wc * 32 + 4 * fq);
#pragma unroll
        for (int ai = 0; ai < 2; ++ai) {
            f32x4 b[4][2][2];
#pragma unroll
            for (int m = 0; m < 4; ++m) { const unsigned off = ((unsigned)(rl0 + ai * HALF + m * 16) * LD + col0) * 4u;
#pragma unroll
                for (int bj = 0; bj < 2; ++bj)
#pragma unroll
                    for (int n = 0; n < 2; ++n) b[m][bj][n] = *(const f32x4*)(bb + off + (unsigned)(bj * HALF + n * 16) * 4u); }
#pragma unroll
            for (int m = 0; m < 4; ++m) { const int row = rl0 + ai * HALF + m * 16;
                const unsigned off = ((unsigned)row * LD + col0) * 4u; float s = 0.f;
#pragma unroll
                for (int bj = 0; bj < 2; ++bj)
#pragma unroll
                    for (int n = 0; n < 2; ++n) { const unsigned o = off + (unsigned)(bj * HALF + n * 16) * 4u; const f32x4 v = b[m][bj][n] + acc[ai][bj][m][n]; *(f32x4*)(ob + o) = v;
                        if (hb) { s += (v.x * v.x + v.y * v.y) + (v.z * v.z + v.w * v.w); u32x2 w; w.x = cvt_pk_bf16(v.x, v.y); w.y = cvt_pk_bf16(v.z, v.w); *(u32x2*)(hbb + (o >> 1)) = w; } }
                if (hb) { s += __shfl_xor(s, 16); s += __shfl_xor(s, 32); if (fq == 0) ssq[(unsigned)row * 16u + (unsigned)(u.pn * 4 + wc)] = s; } }
            asm volatile("" ::: "memory"); }
    }
};
}

#ifndef FAST_GLA
#define FAST_GLA 1
#endif
#ifndef FAST_S5
#define FAST_S5 1
#endif
#ifndef FAST_GDN
#define FAST_GDN 1
#endif
struct Args { const void* in[40]; float* out; unsigned char* ws; int ph_lo, ph_hi, li, pad; };
struct Ctx {
    float* out; unsigned char* ws;
    float* outb; unsigned char* wsb;
    LASQ unsigned char* lds;
    int tid, lane, wave, vcu, G, gw, NGW;
};
constexpr int PTAB_OFF = RING_BYTES;
DI unsigned long long inU(const Ctx& C, int i) { const u32x2 v = *(const LASQ u32x2*)(C.lds + PTAB_OFF + 8 * i);
    return ((unsigned long long)(unsigned)__builtin_amdgcn_readfirstlane((int)v.y) << 32) | (unsigned)__builtin_amdgcn_readfirstlane((int)v.x); }
#define GASQ __attribute__((address_space(1)))
DI const float* inF(const Ctx& C, int i) { return (const float*)(const GASQ float*)inU(C, i); }
DI const int* inI(const Ctx& C, int i) { return (const int*)(const GASQ int*)inU(C, i); }
DI float* tmpbuf(const Ctx& C, int i) { return (float*)(C.ws + WS_TMP + (size_t)i * TSTRIDE); }
DI bf16* ybuf(const Ctx& C, int i) { return (bf16*)(C.ws + WS_Y + (size_t)i * YSTRIDE); }
DI float* projp(const Ctx& C) { return (float*)(C.ws + WS_PROJ); }
DI bf16* Hp(const Ctx& C) { return (bf16*)(C.ws + WS_H); }
DI bf16* gatep(const Ctx& C) { return (bf16*)(C.ws + WS_GATE); }
DI float* m32p(const Ctx& C) { return (float*)(C.ws + WS_M32); }
DI bf16* mrgp(const Ctx& C) { return (bf16*)(C.ws + WS_MRG); }
DI float* X1p(const Ctx& C) { return (float*)(C.ws + WS_X1); }
DI float* X2p(const Ctx& C) { return (float*)(C.ws + WS_X2); }
DI bf16* Zp(const Ctx& C) { return (bf16*)(C.ws + WS_Z); }
DI float* GBp(const Ctx& C) { return (float*)(C.ws + WS_GB); }
DI float* GGp(const Ctx& C) { return (float*)(C.ws + WS_GB) + (size_t)MPAD * 4; }
DI float* KMp(const Ctx& C) { return (float*)(C.ws + WS_KM); }
DI float* KMSp(const Ctx& C) { return (float*)(C.ws + WS_KMS); }
DI bf16* wptr(const Ctx& C, int l, size_t off) { return (bf16*)(C.ws + WS_W + (size_t)l * W_LAYER + off); }

DI void refresh(Ctx& C) { int t_ = threadIdx.x; asm volatile("" : "+v"(t_)); C.tid = t_; C.lane = t_ & 63; int v_ = C.vcu, w_ = C.wave; size_t z_ = 0; asm volatile("" : "+s"(v_), "+s"(w_), "+s"(z_)); C.vcu = v_; C.wave = w_; C.ws = C.wsb + z_; C.out = C.outb + z_; C.gw = w_ * C.G + v_; }
DI int winmap(int c) {
    if (c < 1024) return c;
    if (c < 1280) return 1040 + (c - 1024);
    if (c < 2048) return 1296 + (c - 1280);
    if (c < 2304) return 2072 + (c - 2048);
    if (c < 3072) return 2328 + (c - 2304);
    if (c < 3088) return 1024 + (c - 3072);
    if (c < 3096) return 2064 + (c - 3088);
    return -1;
}
template <bool MAP, bool GAIN = false> DI void tr_item(const float* W, int K, int Nsrc, int Ndst, bf16* WT, LASQ float* scr, int item, int lane, const float* gn = nullptr) {
    const int nblk = Ndst / 32, kb = item / nblk, nb = item % nblk, k0 = 64 * kb, n0 = 32 * nb;
    const int nd = n0 + (lane & 31); const int ns = MAP ? winmap(nd) : nd;
    const int c = lane & 7;
    f32x4 ga = {1.f, 1.f, 1.f, 1.f}, gb = ga; if (GAIN) { ga = *(const f32x4*)(gn + k0 + 8 * c); gb = *(const f32x4*)(gn + k0 + 8 * c + 4); }
#pragma unroll
    for (int i = 0; i < 32; ++i) { const int kk = 2 * i + (lane >> 5); scr[kk * 33 + (lane & 31)] = (ns >= 0) ? __builtin_nontemporal_load(W + (size_t)(k0 + kk) * Nsrc + ns) : 0.f; }
    asm volatile("s_waitcnt lgkmcnt(0)" ::: "memory");
#pragma unroll
    for (int j = 0; j < 4; ++j) { const int n = (lane >> 3) + 8 * j; const LASQ float* s = scr + (8 * c) * 33 + n;
        u32x4 o; if (GAIN) { o.x = pk2(s[0 * 33] * ga.x, s[1 * 33] * ga.y); o.y = pk2(s[2 * 33] * ga.z, s[3 * 33] * ga.w); o.z = pk2(s[4 * 33] * gb.x, s[5 * 33] * gb.y); o.w = pk2(s[6 * 33] * gb.z, s[7 * 33] * gb.w); }
        else { o.x = pk2(s[0 * 33], s[1 * 33]); o.y = pk2(s[2 * 33], s[3 * 33]); o.z = pk2(s[4 * 33], s[5 * 33]); o.w = pk2(s[6 * 33], s[7 * 33]); }
        *(u32x4*)(WT + (size_t)(n0 + n) * K + k0 + 8 * c) = o; }
    asm volatile("s_waitcnt lgkmcnt(0)" ::: "memory");
}
DI void rms_row(const float* xrow, const float* g, bf16* orow, int lane) {
    const f32x4* xr = (const f32x4*)xrow + lane; const f32x4* gr = (const f32x4*)g + lane;
    f32x4 v[4]; float s = 0.f;
#pragma unroll
    for (int j = 0; j < 4; ++j) { v[j] = xr[64 * j]; s += (v[j].x * v[j].x + v[j].y * v[j].y) + (v[j].z * v[j].z + v[j].w * v[j].w); }
    const float r = 1.f / sqrtf(wsum(s) * (1.f / D) + 1e-6f);
    unsigned long long* o8 = (unsigned long long*)orow + lane;
#pragma unroll
    for (int j = 0; j < 4; ++j) { const f32x4 gg = gr[64 * j];
        o8[64 * j] = (unsigned long long)pk2(v[j].x * r * gg.x, v[j].y * r * gg.y) | ((unsigned long long)pk2(v[j].z * r * gg.z, v[j].w * r * gg.w) << 32); }
}
DI void cast_rows(Ctx& C, const float* xp, const float* xs) {
    const int lane = C.lane;
    for (int m0 = 4 * C.gw; m0 < MR; m0 += 4 * C.NGW) {
        const float* x0 = (m0 < MP) ? xp + (size_t)m0 * D : xs + (size_t)(m0 - MP) * D;
        f32x4 v[4][4];
#pragma unroll
        for (int i = 0; i < 4; ++i)
#pragma unroll
            for (int j = 0; j < 4; ++j) v[i][j] = __builtin_nontemporal_load((const f32x4*)(x0 + (size_t)i * D) + lane + 64 * j);
#pragma unroll
        for (int i = 0; i < 4; ++i) { float s = 0.f;
#pragma unroll
            for (int j = 0; j < 4; ++j) s += (v[i][j].x * v[i][j].x + v[i][j].y * v[i][j].y) + (v[i][j].z * v[i][j].z + v[i][j].w * v[i][j].w);
            s = wsum(s);
            if (m0 < MP) { if (lane < 16) ((float*)(C.ws + WS_SSQ))[(size_t)(m0 + i) * 16 + lane] = (lane == 0) ? s : 0.f; }
            else ((float*)(C.ws + WS_SSQS))[(size_t)(m0 + i - MP) * 64 + lane] = (lane == 0) ? s : 0.f;
            unsigned long long* o8 = (unsigned long long*)(Hp(C) + (size_t)(m0 + i) * D) + lane;
#pragma unroll
            for (int j = 0; j < 4; ++j) o8[64 * j] = (unsigned long long)pk2(v[i][j].x, v[i][j].y) | ((unsigned long long)pk2(v[i][j].z, v[i][j].w) << 32); }
    }
}
template <class Order> DI void fill_rs(Ctx& C, const Order& S, int slot0) {
    LASQ float* rsl = (LASQ float*)(C.lds + RS_OFF) + slot0 * 256; const float* sq = (const float*)(C.ws + WS_SSQ) + (size_t)(C.tid >> 1) * 16 + (C.tid & 1) * 8;
    constexpr int NU = 4; f32x4 a[NU], b[NU]; bool ok[NU];
#pragma unroll
    for (int i = 0; i < NU; ++i) { pg8::Unit u; ok[i] = S.next(i, u); const float* p = sq + (size_t)(ok[i] ? u.pm : 0) * 256 * 16; a[i] = ((const f32x4*)p)[0]; b[i] = ((const f32x4*)p)[1]; }
#pragma unroll
    for (int i = 0; i < NU; ++i) { float s = ((a[i].x + a[i].y) + (a[i].z + a[i].w)) + ((b[i].x + b[i].y) + (b[i].z + b[i].w)); s += __shfl_xor(s, 1);
        if (ok[i] && !(C.tid & 1)) rsl[i * 256 + (C.tid >> 1)] = rsq_(s * (1.f / D) + 1e-6f); }
    pg8::Unit u;
    for (int i = NU; S.next(i, u); ++i) { const float* p = sq + (size_t)u.pm * 256 * 16;
        const f32x4 a2 = ((const f32x4*)p)[0], b2 = ((const f32x4*)p)[1]; float s = ((a2.x + a2.y) + (a2.z + a2.w)) + ((b2.x + b2.y) + (b2.z + b2.w)); s += __shfl_xor(s, 1);
        if (!(C.tid & 1)) rsl[i * 256 + (C.tid >> 1)] = rsq_(s * (1.f / D) + 1e-6f); }
}
DI float sample_rs(Ctx& C) { const f32x4 a = *((const f32x4*)(C.ws + WS_SSQS) + C.tid); float s = (a.x + a.y) + (a.z + a.w);
#pragma unroll
    for (int o = 1; o < 16; o <<= 1) s += __shfl_xor(s, o);
    return rsq_(s * (1.f / D) + 1e-6f); }
DI void prologue(Ctx& C) {
    LASQ float* scr = (LASQ float*)(C.lds + C.wave * 16384);
    constexpr int I_IN = (D / 64) * (NP / 32), I_G = (D / 64) * (NGATE / 32), I_BR = (BW / 64) * (D / 32), I_O = (D / 64) * (D / 32), I_1 = (D / 64) * (DFF / 32), I_2 = (DFF / 64) * (D / 32);
    constexpr int PER_L = I_IN + I_G + 4 * I_BR + I_O + I_1 + I_2;
    for (int it = C.gw; it < 2 * PER_L; it += C.NGW) {
        const int l = it / PER_L; int r = it % PER_L;
        if (r < I_IN) { tr_item<true, true>(inF(C, 11) + (size_t)l * D * 3096, D, 3096, NP, wptr(C, l, WO_WIN), scr, r, C.lane, inF(C, 10) + l * D); continue; } r -= I_IN;
        if (r < I_G) { tr_item<false, true>(inF(C, 31) + (size_t)l * D * NGATE, D, NGATE, NGATE, wptr(C, l, WO_WG), scr, r, C.lane, inF(C, 10) + l * D); continue; } r -= I_G;
        if (r < 4 * I_BR) { const int br = r / I_BR; tr_item<false>(inF(C, 32 + br) + (size_t)l * BW * D, BW, D, D, wptr(C, l, WO_WBR) + (size_t)br * D * BW, scr, r % I_BR, C.lane); continue; } r -= 4 * I_BR;
        if (r < I_O) { tr_item<false>(inF(C, 36) + (size_t)l * D * D, D, D, D, wptr(C, l, WO_WOUT), scr, r, C.lane); continue; } r -= I_O;
        if (r < I_1) { tr_item<false, true>(inF(C, 38) + (size_t)l * D * DFF, D, DFF, DFF, wptr(C, l, WO_FF1), scr, r, C.lane, inF(C, 37) + l * D); continue; } r -= I_1;
        tr_item<false>(inF(C, 39) + (size_t)l * DFF * D, DFF, D, D, wptr(C, l, WO_FF2), scr, r, C.lane);
    }
    cast_rows(C, inF(C, 0), inF(C, 1));
}

DI void pre_row(Ctx& C, int l, int m, const float* ropetab, int piece) {
    const int lane = C.lane; const bool smp = m >= MP; const int bs = m - MP, t = smp ? 0 : (m & (SEQ - 1)), pos = smp ? PAST : t;
    const float* pr = projp(C) + (size_t)m * NP;
    if ((!FAST_GLA || smp) && piece == 0) {
        const float* Wg = inF(C, 22) + (size_t)l * 16 * 256; const float* bg = inF(C, 23) + l * 256; float* LA = tmpbuf(C, T_LA) + (size_t)m * 256;
        float lr[16];
#pragma unroll
        for (int r = 0; r < 16; ++r) lr[r] = pr[C_LR + r];
#pragma unroll
        for (int i = 0; i < 4; ++i) { const int c = lane + 64 * i; float x = bg[c];
#pragma unroll
            for (int r = 0; r < 16; ++r) x += lr[r] * Wg[r * 256 + c];
            LA[c] = logsigmoid_(x) * (1.f / 16.f); }
    }
    if (piece >= 1 && piece <= 3) {
        const float* cw = inF(C, 25) + (size_t)l * 4 * 768; const float* cst = inF(C, 9) + ((size_t)l * SB + (smp ? bs : 0)) * 3 * 768;
        if (!FAST_GDN || smp) {
        { const int grp = piece - 1;
            float vals[4];
#pragma unroll
            for (int i = 0; i < 4; ++i) { const int c = grp * 256 + lane + 64 * i; float acc = 0.f;
#pragma unroll
                for (int j = 0; j < 4; ++j) { const int tt = t - 3 + j; float xin;
                    if (tt >= 0) xin = projp(C)[(size_t)(m - 3 + j) * NP + C_DQ + c]; else xin = smp ? cst[(tt + 3) * 768 + c] : 0.f;
                    acc += cw[j * 768 + c] * xin; }
                vals[i] = silu_(acc); }
            if (grp < 2) {
#pragma unroll
                for (int i = 0; i < 4; ++i) { const float ss = wsum(vals[i] * vals[i]); vals[i] *= (1.f / sqrtf(ss + 1e-6f)) * (grp == 0 ? 0.125f : 1.f); } }
            float* GO = tmpbuf(C, T_GQ + grp) + (size_t)m * 256;
#pragma unroll
            for (int i = 0; i < 4; ++i) GO[i * 64 + lane] = vals[i];
            asm volatile("" ::: "memory");
        }
        if (lane < 4 && piece == 1) { GBp(C)[(size_t)m * 4 + lane] = sigmoid_(pr[C_DB + lane]);
                        GGp(C)[(size_t)m * 4 + lane] = -expf(inF(C, 26)[l * 4 + lane]) * softplus_(pr[C_DA + lane] + inF(C, 27)[l * 4 + lane]); }
        }
        if (!smp && t >= SEQ - 3 && piece == 3) { float* o = C.out + O_PCONV + (((size_t)l * NB + (m >> 12)) * 3 + (t - (SEQ - 3))) * 768;
#pragma unroll
            for (int i = 0; i < 12; ++i) o[lane + 64 * i] = pr[C_DQ + lane + 64 * i]; }
        if (smp && piece == 3) { float* o = C.out + O_SCONV + ((size_t)l * SB + bs) * 3 * 768;
#pragma unroll
            for (int i = 0; i < 12; ++i) { const int c = lane + 64 * i; o[c] = cst[768 + c]; o[768 + c] = cst[2 * 768 + c]; o[2 * 768 + c] = pr[C_DQ + c]; } }
    }
    if (piece >= 4) {
        const float* qn = inF(C, 29) + l * 64; const float* kn = inF(C, 30) + l * 64;
        const float* rt = ropetab + (size_t)(smp ? SEQ : t) * 16; const float cs = rt[lane & 7], sn = rt[8 + (lane & 7)];
        float* MQ = tmpbuf(C, T_MQ) + (size_t)m * 256;
        float* MK = smp ? C.out + O_SMK + ((size_t)l * SB + bs) * 256 : C.out + O_PMK + ((size_t)l * MP + m) * 256;
        float* MV = smp ? C.out + O_SMV + ((size_t)l * SB + bs) * 256 : C.out + O_PMV + ((size_t)l * MP + m) * 256;
        { const int i = piece - 4;
            float xq = pr[C_MQ + i * 64 + lane], xk = pr[C_MK + i * 64 + lane];
            xq = xq * (1.f / sqrtf(wsum(xq * xq) * (1.f / 64.f) + 1e-6f)) * qn[lane];
            xk = xk * (1.f / sqrtf(wsum(xk * xk) * (1.f / 64.f) + 1e-6f)) * kn[lane];
            const float pq = __shfl_xor(xq, 8), pk = __shfl_xor(xk, 8);
            if (lane < 8) { xq = xq * cs - pq * sn; xk = xk * cs - pk * sn; } else if (lane < 16) { xq = xq * cs + pq * sn; xk = xk * cs + pk * sn; }
            MQ[i * 64 + lane] = xq; MK[i * 64 + lane] = xk; MV[i * 64 + lane] = pr[C_MV + i * 64 + lane]; }
    }
}
DI void kmean_item(Ctx& C, int l, int it) {
    const int lane = C.lane; float s[4] = {0.f, 0.f, 0.f, 0.f};
    if (it < NB * 16) { const int b = it >> 4, blk = it & 15; const float* k = C.out + O_PMK + ((size_t)l * MP + (size_t)b * SEQ + blk * 256) * 256;
        for (int j = 0; j < 256; ++j) {
#pragma unroll
            for (int i = 0; i < 4; ++i) s[i] += k[(size_t)j * 256 + lane + 64 * i]; }
#pragma unroll
        for (int i = 0; i < 4; ++i) KMp(C)[(size_t)it * 256 + lane + 64 * i] = s[i] * (1.f / 256.f);
    } else { const int r = it - NB * 16, bs = r >> 5, blk = r & 31; const int* pt = inI(C, 4) + bs * 64 + blk * 2; const float* ck = inF(C, 2) + (size_t)l * NPOOL * 128 * 256;
        for (int pg = 0; pg < 2; ++pg) { const float* k = ck + (size_t)pt[pg] * 128 * 256;
            for (int j = 0; j < 128; ++j) {
#pragma unroll
                for (int i = 0; i < 4; ++i) s[i] += k[(size_t)j * 256 + lane + 64 * i]; } }
#pragma unroll
        for (int i = 0; i < 4; ++i) KMSp(C)[(size_t)r * 256 + lane + 64 * i] = s[i] * (1.f / 256.f);
    }
}
DI void s5_naive(Ctx& C, int l, int s, int g, const float* s5p, bf16* ysb) {
    const int lane = C.lane;
    const float* P = s5p + (size_t)(l * 16 + g) * 36 * 64 + lane; const float are = P[0], aim = P[64];
    float bre[16], bim[16], cre[16], cim[16];
#pragma unroll
    for (int c = 0; c < 16; ++c) { bre[c] = P[(4 + c) * 64]; bim[c] = P[(20 + c) * 64];
        cre[c] = inF(C, 17)[((size_t)(l * 16 + g) * 16 + c) * 64 + lane]; cim[c] = inF(C, 18)[((size_t)(l * 16 + g) * 16 + c) * 64 + lane]; }
    const float dd = inF(C, 19)[l * 256 + g * 16 + (lane & 15)];
    int L, row0; float hr = 0.f, hi = 0.f;
    if (s < NB) { L = SEQ; row0 = s * SEQ; } else { L = 1; row0 = MP + (s - NB); hr = inF(C, 5)[((size_t)(l * SB + s - NB) * 16 + g) * 64 + lane]; hi = inF(C, 6)[((size_t)(l * SB + s - NB) * 16 + g) * 64 + lane]; }
    float* YPRE = tmpbuf(C, T_YPRE);
    for (int t = 0; t < L; ++t) {
        const float* up = projp(C) + (size_t)(row0 + t) * NP + C_S5U + g * 16;
        float xr = 0.f, xi = 0.f;
#pragma unroll
        for (int c = 0; c < 16; ++c) { const float u = up[c]; xr += bre[c] * u; xi += bim[c] * u; }
        const float nhr = are * hr - aim * hi + xr, nhi = are * hi + aim * hr + xi; hr = nhr; hi = nhi;
        float myy = 0.f;
#pragma unroll
        for (int c = 0; c < 16; ++c) { const float yc = wsum(hr * cre[c] - hi * cim[c]); if (lane == c) myy = yc; }
        if (lane < 16) { const float yv = gelu_tanh_(myy + dd * up[lane]); YPRE[(size_t)(row0 + t) * 256 + g * 16 + lane] = yv; if (s >= NB) ysb[(size_t)(s - NB) * 256 + g * 16 + lane] = (bf16)f2bf(yv); }
    }
    const size_t so = (s < NB) ? ((size_t)(l * NB + s) * 16 + g) * 64 + lane : ((size_t)(l * SB + s - NB) * 16 + g) * 64 + lane;
    if (s < NB) { C.out[O_PS5R + so] = hr; C.out[O_PS5I + so] = hi; } else { C.out[O_SS5R + so] = hr; C.out[O_SS5I + so] = hi; }
}
DI void gla_naive(Ctx& C, int l, int s, int h, int j) {
    const int lane = C.lane; float S[8]; int L, row0; size_t sto;
    if (s < NB) { L = SEQ; row0 = s * SEQ; sto = O_PGLA + (((size_t)(l * NB + s) * 4 + h) * 64 + lane) * 64 + 8 * j;
#pragma unroll
        for (int i = 0; i < 8; ++i) S[i] = 0.f; }
    else { L = 1; row0 = MP + s - NB; sto = O_SGLA + (((size_t)(l * SB + s - NB) * 4 + h) * 64 + lane) * 64 + 8 * j; const float* st = inF(C, 7) + (((size_t)(l * SB + s - NB) * 4 + h) * 64 + lane) * 64 + 8 * j;
#pragma unroll
        for (int i = 0; i < 8; ++i) S[i] = st[i]; }
    const float* LA = tmpbuf(C, T_LA); float* OG = tmpbuf(C, T_OGLA);
    for (int t = 0; t < L; ++t) { const size_t m = row0 + t; const float* pr = projp(C) + m * NP;
        const float q = pr[C_AQ + h * 64 + lane] * 0.125f, k = pr[C_AK + h * 64 + lane], a = __expf(LA[m * 256 + h * 64 + lane]);
        float myo = 0.f;
#pragma unroll
        for (int i = 0; i < 8; ++i) { S[i] = a * S[i] + k * pr[C_AV + h * 64 + 8 * j + i]; const float o = wsum(q * S[i]); if (lane == i) myo = o; }
        if (lane < 8) OG[m * 256 + h * 64 + 8 * j + lane] = myo; }
#pragma unroll
    for (int i = 0; i < 8; ++i) C.out[sto + i] = S[i];
}
DI void gdn_naive(Ctx& C, int l, int s, int h, int j) {
    const int lane = C.lane; float S[8]; int L, row0; size_t sto;
    if (s < NB) { L = SEQ; row0 = s * SEQ; sto = O_PGDN + (((size_t)(l * NB + s) * 4 + h) * 64 + lane) * 64 + 8 * j;
#pragma unroll
        for (int i = 0; i < 8; ++i) S[i] = 0.f; }
    else { L = 1; row0 = MP + s - NB; sto = O_SGDN + (((size_t)(l * SB + s - NB) * 4 + h) * 64 + lane) * 64 + 8 * j; const float* st = inF(C, 8) + (((size_t)(l * SB + s - NB) * 4 + h) * 64 + lane) * 64 + 8 * j;
#pragma unroll
        for (int i = 0; i < 8; ++i) S[i] = st[i]; }
    const float* GQ = tmpbuf(C, T_GQ); const float* GK = tmpbuf(C, T_GK); const float* GV = tmpbuf(C, T_GV); float* OG = tmpbuf(C, T_OGDN);
    for (int t = 0; t < L; ++t) { const size_t m = row0 + t;
        const float q = GQ[m * 256 + h * 64 + lane], k = GK[m * 256 + h * 64 + lane], beta = GBp(C)[m * 4 + h], a = __expf(GGp(C)[m * 4 + h]);
        float myo = 0.f;
#pragma unroll
        for (int i = 0; i < 8; ++i) { S[i] *= a; const float ks = wsum(k * S[i]); S[i] += beta * k * (GV[m * 256 + h * 64 + 8 * j + i] - ks); const float o = wsum(q * S[i]); if (lane == i) myo = o; }
        if (lane < 8) OG[m * 256 + h * 64 + 8 * j + lane] = myo; }
#pragma unroll
    for (int i = 0; i < 8; ++i) C.out[sto + i] = S[i];
}
DI const float* moba_kv_row(const Ctx& C, int l, bool smp, int b, int kp, int h, bool isv) {
    if (!smp) return C.out + (isv ? O_PMV : O_PMK) + ((size_t)l * MP + (size_t)b * SEQ + kp) * 256 + h * 64;
    if (kp >= PAST) return C.out + (isv ? O_SMV : O_SMK) + ((size_t)l * SB + b) * 256 + h * 64;
    const int page = (inI(C, 4))[b * 64 + (kp >> 7)];
    return inF(C, isv ? 3 : 2) + (((size_t)l * NPOOL + page) * 128 + (kp & 127)) * 256 + h * 64;
}
DI void moba_naive(Ctx& C, int l, int m, int h, LASQ float* wl) {
    const int lane = C.lane; const bool smp = m >= MP; const int b = smp ? m - MP : (m >> 12), t = smp ? 0 : (m & (SEQ - 1)), pos = smp ? PAST : t, own = pos >> 8;
    const float q = tmpbuf(C, T_MQ)[(size_t)m * 256 + h * 64 + lane];
    wl[lane] = q;
    const float* km = smp ? KMSp(C) + (size_t)b * 32 * 256 + h * 64 : KMp(C) + (size_t)b * 16 * 256 + h * 64;
    float myg = -3.0e38f;
    for (int n = 0; n < own; ++n) { const float gs = wsum(q * km[(size_t)n * 256 + lane]); if (lane == n) myg = gs; }
    int sel[4];
#pragma unroll
    for (int r = 0; r < 3; ++r) { if (r < own) { const float mx = wmaxf(myg); const unsigned long long bal = __ballot(myg == mx); const int idx = __ffsll((long long)bal) - 1; sel[r] = idx; if (lane == idx) myg = -3.0e38f; } else sel[r] = -1; }
    sel[3] = own;
    asm volatile("s_waitcnt lgkmcnt(0)" ::: "memory");
    float lg[4][4]; float mx = -3.0e38f;
#pragma unroll
    for (int r = 0; r < 4; ++r) {
#pragma unroll
        for (int i = 0; i < 4; ++i) { lg[r][i] = -3.0e38f;
            const int kp = sel[r] * 256 + lane + 64 * i;
            if (sel[r] >= 0 && kp <= pos) { const f32x4* kr = (const f32x4*)moba_kv_row(C, l, smp, b, kp, h, false); float dot = 0.f;
#pragma unroll
                for (int d4 = 0; d4 < 16; ++d4) { const f32x4 kv = kr[d4]; const f32x4 qv = *(const LASQ f32x4*)(wl + 4 * d4); dot += (kv.x * qv.x + kv.y * qv.y) + (kv.z * qv.z + kv.w * qv.w); }
                lg[r][i] = dot * 0.125f; mx = fmaxf(mx, lg[r][i]); } } }
    mx = wmaxf(mx); float sum = 0.f;
#pragma unroll
    for (int r = 0; r < 4; ++r)
#pragma unroll
        for (int i = 0; i < 4; ++i) { const float p = (lg[r][i] > -1.0e38f) ? __expf(lg[r][i] - mx) : 0.f; sum += p; wl[64 + r * 256 + lane + 64 * i] = p; }
    sum = wsum(sum);
    asm volatile("s_waitcnt lgkmcnt(0)" ::: "memory");
    float o = 0.f;
#pragma unroll
    for (int r = 0; r < 4; ++r) { if (sel[r] < 0) continue; const int nk = (r == 3) ? (pos - own * 256 + 1) : 256;
        for (int key = 0; key < nk; ++key) { const float* vr = moba_kv_row(C, l, smp, b, sel[r] * 256 + key, h, true); o += wl[64 + r * 256 + key] * vr[lane]; } }
    ybuf(C, 3)[(size_t)m * 256 + h * 64 + lane] = (bf16)f2bf(o / sum);
    asm volatile("s_waitcnt lgkmcnt(0)" ::: "memory");
}
DI void post_row(Ctx& C, int l, int m, int piece) {
    const int lane = C.lane; const float* pr = projp(C) + (size_t)m * NP;
    if (piece < 4) {   const float* og = tmpbuf(C, T_OGLA) + (size_t)m * 256; const float gn = inF(C, 24)[l * 64 + lane];
        { const int i = piece; const float o = og[i * 64 + lane]; const float r = 1.f / sqrtf(wsum(o * o) * (1.f / 64.f) + 1e-6f);
            ybuf(C, 1)[(size_t)m * 256 + i * 64 + lane] = (bf16)f2bf(o * r * gn * silu_(pr[C_AR + i * 64 + lane])); } }
    if (piece >= 4) {   const float* og = tmpbuf(C, T_OGDN) + (size_t)m * 256; const float gn = inF(C, 28)[l * 64 + lane];
        { const int i = piece - 4; const float o = og[i * 64 + lane]; const float r = 1.f / sqrtf(wsum(o * o) * (1.f / 64.f) + 1e-6f);
            ybuf(C, 2)[(size_t)m * 256 + i * 64 + lane] = (bf16)f2bf(o * r * gn * silu_(pr[C_DZ + i * 64 + lane])); } }
}

typedef short bf16x8v __attribute__((ext_vector_type(8)));
typedef short bf16x4v __attribute__((ext_vector_type(4)));
DI bf16x8v cvt8(f32x4 a, f32x4 b) { u32x4 w; w.x = pg8::cvt_pk_bf16(a.x, a.y); w.y = pg8::cvt_pk_bf16(a.z, a.w); w.z = pg8::cvt_pk_bf16(b.x, b.y); w.w = pg8::cvt_pk_bf16(b.z, b.w); return __builtin_bit_cast(bf16x8v, w); }
#define MFMA16(a, b, c) __builtin_amdgcn_mfma_f32_16x16x32_bf16((a), (b), (c), 0, 0, 0)
constexpr int AT_KS = 144, AT_VS = 144, AT_KB = 64 * AT_KS, AT_VB = 64 * AT_VS;
DI void moba_attn_qtile(Ctx& C, int l, int b, int h, int qt, const bf16* QB, const bf16* KBp, const bf16* VTp, const float* KSUM) {
    const int tid = C.tid, lane = C.lane, wave = C.wave, li = lane & 15, fq = lane >> 4;
    const int qb = qt >> 1, qpos = qt * 128 + wave * 16 + li;
    const size_t rowq = (size_t)b * SEQ + qpos;
    const float* mq = tmpbuf(C, T_MQ) + rowq * 256 + h * 64;
    const bf16* Kg = KBp + (size_t)b * SEQ * 256 + h * 64;
    const bf16* Vg = VTp + (size_t)(b * 4 + h) * 64 * SEQ;
    bf16x8v qf[2];
#pragma unroll
    for (int ks = 0; ks < 2; ++ks) qf[ks] = *(const bf16x8v*)(QB + rowq * 256 + h * 64 + 32 * ks + 8 * fq);
    unsigned selmask = 0u;
    if (qb > 0) {
        f32x4 qg[4];
#pragma unroll
        for (int j = 0; j < 4; ++j) qg[j] = *(const f32x4*)(mq + 16 * fq + 4 * j);
        float v1 = -3.0e38f, v2 = -3.0e38f, v3 = -3.0e38f; int i1 = -1, i2 = -1, i3 = -1;
        const float* km = KSUM + (size_t)b * 64 * 256 + h * 64 + 16 * fq;
        for (int n = 0; n < qb; ++n) { float g = 0.f;
#pragma unroll
            for (int c4 = 0; c4 < 4; ++c4)
#pragma unroll
            for (int j = 0; j < 4; ++j) { const f32x4 kv = *(const f32x4*)(km + (size_t)(4 * n + c4) * 256 + 4 * j); g += (qg[j].x * kv.x + qg[j].y * kv.y) + (qg[j].z * kv.z + qg[j].w * kv.w); }
            g += __shfl_xor(g, 16); g += __shfl_xor(g, 32);
            if (g > v1) { v3 = v2; i3 = i2; v2 = v1; i2 = i1; v1 = g; i1 = n; } else if (g > v2) { v3 = v2; i3 = i2; v2 = g; i2 = n; } else if (g > v3) { v3 = g; i3 = n; } }
        if (i1 >= 0) selmask |= 1u << i1; if (i2 >= 0) selmask |= 1u << i2; if (i3 >= 0) selmask |= 1u << i3;
    }
    const int ntile = qt * 2 + 2;
    f32x4 O[4]; float m = -1.0e30f, lsum = 0.f;
#pragma unroll
    for (int dt = 0; dt < 4; ++dt) O[dt] = (f32x4){0.f, 0.f, 0.f, 0.f};
    const int kkey = tid >> 3, kseg = tid & 7;
    LASQ unsigned char* L = C.lds;
    constexpr int AT_TB = AT_KB + AT_VB;
    u32x4 ka, va;
#define AT_LOAD(t) do { const int tl_ = ((t) < ntile) ? (t) : ntile - 1; ka = *(const GASQ u32x4*)(Kg + (size_t)(tl_ * 64 + kkey) * 256 + 8 * kseg); va = *(const GASQ u32x4*)(Vg + (size_t)kkey * SEQ + tl_ * 64 + 8 * kseg); } while (0)
#define AT_STORE(bo) do { *(LASQ u32x4*)(L + (bo) + kkey * AT_KS + kseg * 16) = ka; *(LASQ u32x4*)(L + (bo) + AT_KB + kkey * AT_VS + kseg * 16) = va; } while (0)
#define AT_QK(dst, bo) do { _Pragma("unroll") for (int nt = 0; nt < 4; ++nt) { dst[nt] = (f32x4){0.f, 0.f, 0.f, 0.f}; \
            _Pragma("unroll") for (int ks = 0; ks < 2; ++ks) { const bf16x8v kf = *(const LASQ bf16x8v*)(L + (bo) + (16 * nt + li) * AT_KS + (32 * ks + 8 * fq) * 2); dst[nt] = MFMA16(kf, qf[ks], dst[nt]); } } } while (0)
#define AT_BAR() do { asm volatile("s_waitcnt lgkmcnt(0)" ::: "memory"); __builtin_amdgcn_s_barrier(); asm volatile("" ::: "memory"); } while (0)
#define AT_STEP(OWN, t) do { \
        f32x4 sn[4]; \
        AT_QK(sn, b1); \
        const int key0 = (t) * 64; const float ninf = -__builtin_inff(); bool ok = true; \
        if (OWN) { _Pragma("unroll") for (int nt = 0; nt < 4; ++nt) _Pragma("unroll") for (int r = 0; r < 4; ++r) s[nt][r] = (key0 + 16 * nt + 4 * fq + r <= qpos) ? s[nt][r] : ninf; } \
        else ok = (selmask >> (key0 >> 8)) & 1u; \
        float mx = fmaxf(fmaxf(fmaxf(s[0][0], s[0][1]), fmaxf(s[0][2], s[0][3])), fmaxf(fmaxf(s[1][0], s[1][1]), fmaxf(s[1][2], s[1][3]))); \
        mx = fmaxf(mx, fmaxf(fmaxf(fmaxf(s[2][0], s[2][1]), fmaxf(s[2][2], s[2][3])), fmaxf(fmaxf(s[3][0], s[3][1]), fmaxf(s[3][2], s[3][3])))); \
        if (!OWN) mx = ok ? mx : ninf; \
        mx = fmaxf(mx, __shfl_xor(mx, 16)); mx = fmaxf(mx, __shfl_xor(mx, 32)); \
        const float mn = fmaxf(m, mx), alpha = __builtin_amdgcn_exp2f(m - mn); \
        const float mnb = (OWN || ok) ? mn : __builtin_inff(); \
        float ps = 0.f; f32x4 p[4]; \
        _Pragma("unroll") for (int nt = 0; nt < 4; ++nt) _Pragma("unroll") for (int r = 0; r < 4; ++r) { const float e_ = __builtin_amdgcn_exp2f(s[nt][r] - mnb); p[nt][r] = e_; ps += e_; } \
        lsum = lsum * alpha + ps; m = mn; \
        _Pragma("unroll") for (int dt = 0; dt < 4; ++dt) O[dt] *= alpha; \
        bf16x8v pf[2]; \
        _Pragma("unroll") for (int ks = 0; ks < 2; ++ks) pf[ks] = cvt8(p[2 * ks], p[2 * ks + 1]); \
        const LASQ unsigned char* VL = L + b0 + AT_KB; \
        _Pragma("unroll") for (int dt = 0; dt < 4; ++dt) _Pragma("unroll") for (int ks = 0; ks < 2; ++ks) { \
            const bf16x4v lo = *(const LASQ bf16x4v*)(VL + (16 * dt + li) * AT_VS + (32 * ks + 4 * fq) * 2), hi = *(const LASQ bf16x4v*)(VL + (16 * dt + li) * AT_VS + (32 * ks + 16 + 4 * fq) * 2); \
            O[dt] = MFMA16(__builtin_shufflevector(lo, hi, 0, 1, 2, 3, 4, 5, 6, 7), pf[ks], O[dt]); } \
        AT_STORE(b2);              \
        AT_LOAD((t) + 3); \
        AT_BAR(); \
        _Pragma("unroll") for (int nt = 0; nt < 4; ++nt) s[nt] = sn[nt]; \
        { const int bt_ = b0; b0 = b1; b1 = b2; b2 = bt_; } } while (0)
    int b0 = 0, b1 = AT_TB, b2 = 2 * AT_TB;
    AT_LOAD(0); AT_STORE(b0); AT_LOAD(1); AT_STORE(b1); AT_LOAD(2); __syncthreads();
    f32x4 s[4]; AT_QK(s, b0);
    const int npast = qb * 4;
    for (int t = 0; t < npast; ++t) AT_STEP(false, t);
    for (int t = npast; t < ntile; ++t) AT_STEP(true, t);
    __syncthreads();
#undef AT_STEP
#undef AT_QK
#undef AT_BAR
#undef AT_LOAD
#undef AT_STORE
    lsum += __shfl_xor(lsum, 16); lsum += __shfl_xor(lsum, 32);
    const float inv = 1.f / lsum;
    bf16* yd = ybuf(C, 3) + rowq * 256 + h * 64;
#pragma unroll
    for (int dt = 0; dt < 4; ++dt) { u32x2 w; w.x = pg8::cvt_pk_bf16(O[dt][0] * inv, O[dt][1] * inv); w.y = pg8::cvt_pk_bf16(O[dt][2] * inv, O[dt][3] * inv); *(u32x2*)(yd + 16 * dt + 4 * fq) = w; }
}

constexpr size_t WS_GLA = WS_END;
constexpr size_t GLA_VT = WS_GLA, GLA_DST = GLA_VT + (size_t)1024 * 4096 * 2, GLA_SC = GLA_DST + (size_t)1024 * 4096 * 4, GLA_DEC = GLA_SC + (size_t)1024 * 4096 * 4,
                 GLA_Q = GLA_DEC + (size_t)1024 * 64 * 4, GLA_K = GLA_Q + (size_t)MPAD * 256 * 2, WS_END2 = GLA_K + (size_t)MPAD * 256 * 2;
DI bf16* glaQ(const Ctx& C) { return (bf16*)(C.ws + GLA_Q); }
DI bf16* glaK(const Ctx& C) { return (bf16*)(C.ws + GLA_K); }
constexpr int LT = 72;

DI void gla_prep_chunk(Ctx& C, int l, int b, int c) {
    const int tid = C.tid, lane = C.lane, wave = C.wave, h = wave >> 1, rh = wave & 1, li = lane & 15, fq = lane >> 4;
    const size_t row0 = (size_t)b * SEQ + (size_t)c * 64; const int unit = ((b * 64 + c) * 4 + h);
    LASQ unsigned char* L = C.lds;
    LASQ float* LR = (LASQ float*)L; LASQ float* TOT = (LASQ float*)(L + 4096) + h * 64; LASQ float* BL = (LASQ float*)(L + 5120) + h * 64;
    LASQ unsigned char* KT = L + 8192 + h * (2 * 64 * LT * 2); LASQ unsigned char* VT = KT + 64 * LT * 2;
    if (tid < 256) { const int t = tid >> 2, r4 = tid & 3; *(LASQ f32x4*)(LR + t * 16 + 4 * r4) = *(const f32x4*)(projp(C) + (row0 + t) * NP + C_LR + 4 * r4); }
    float wg[16];
#pragma unroll
    for (int r = 0; r < 16; ++r) wg[r] = inF(C, 22)[(size_t)l * 16 * 256 + r * 256 + h * 64 + lane];
    const float bgv = inF(C, 23)[l * 256 + h * 64 + lane];
    __syncthreads();
    float qv[32], kv[32], vv[32];
#pragma unroll
    for (int i = 0; i < 32; ++i) { const float* pr = projp(C) + (row0 + 32 * rh + i) * NP + h * 64 + lane; qv[i] = pr[C_AQ]; kv[i] = pr[C_AK]; vv[i] = pr[C_AV]; }
    float bc[32]; float run = 0.f;
#pragma unroll
    for (int i = 0; i < 32; ++i) { const int t = 32 * rh + i; float x = bgv;
#pragma unroll
        for (int r4 = 0; r4 < 4; ++r4) { const f32x4 lr = *(const LASQ f32x4*)(LR + t * 16 + 4 * r4); x += lr.x * wg[4 * r4] + lr.y * wg[4 * r4 + 1] + lr.z * wg[4 * r4 + 2] + lr.w * wg[4 * r4 + 3]; }
        run += logsigmoid_(x) * (1.f / 16.f); bc[i] = run; }
    if (rh == 0) TOT[lane] = run;
    __syncthreads();
    if (rh == 1) { const float off = TOT[lane];
#pragma unroll
        for (int i = 0; i < 32; ++i) bc[i] += off;
        BL[lane] = bc[31]; }
    __syncthreads();
    float* BCg = tmpbuf(C, T_LA); bf16* Qg = glaQ(C); bf16* Kg = glaK(C);
    bf16* VTg = (bf16*)(C.ws + GLA_VT) + (size_t)unit * 4096;
#pragma unroll
    for (int g8 = 0; g8 < 4; ++g8) {
        float kt[8];
#pragma unroll
        for (int e = 0; e < 8; ++e) { const int i = 8 * g8 + e; const size_t row = row0 + 32 * rh + i;
            BCg[row * 256 + h * 64 + lane] = bc[i];
            const float ep = __expf(bc[i]), en = __expf(-bc[i]); kt[e] = kv[i] * en;
            Qg[row * 256 + h * 64 + lane] = (bf16)f2bf(qv[i] * 0.125f * ep); Kg[row * 256 + h * 64 + lane] = (bf16)f2bf(kt[e]); }
        u32x4 kw, vw; kw.x = pk2(kt[0], kt[1]); kw.y = pk2(kt[2], kt[3]); kw.z = pk2(kt[4], kt[5]); kw.w = pk2(kt[6], kt[7]);
        vw.x = pk2(vv[8 * g8], vv[8 * g8 + 1]); vw.y = pk2(vv[8 * g8 + 2], vv[8 * g8 + 3]); vw.z = pk2(vv[8 * g8 + 4], vv[8 * g8 + 5]); vw.w = pk2(vv[8 * g8 + 6], vv[8 * g8 + 7]);
        *(LASQ u32x4*)(KT + lane * (LT * 2) + (32 * rh + 8 * g8) * 2) = kw; *(LASQ u32x4*)(VT + lane * (LT * 2) + (32 * rh + 8 * g8) * 2) = vw;
        *(u32x4*)(VTg + lane * 64 + 32 * rh + 8 * g8) = vw; }
    __syncthreads();
    float* DSTg = (float*)(C.ws + GLA_DST) + (size_t)unit * 4096;
#pragma unroll
    for (int at = 0; at < 2; ++at) { const int d0 = 16 * (2 * rh + at);
        bf16x8v af[2];
#pragma unroll
        for (int ks = 0; ks < 2; ++ks) af[ks] = *(const LASQ bf16x8v*)(KT + (d0 + li) * (LT * 2) + (32 * ks + 8 * fq) * 2);
        const f32x4 eb = {__expf(BL[d0 + 4 * fq]), __expf(BL[d0 + 4 * fq + 1]), __expf(BL[d0 + 4 * fq + 2]), __expf(BL[d0 + 4 * fq + 3])};
#pragma unroll
        for (int bt = 0; bt < 4; ++bt) { f32x4 acc = {0.f, 0.f, 0.f, 0.f};
#pragma unroll
            for (int ks = 0; ks < 2; ++ks) { const bf16x8v bf = *(const LASQ bf16x8v*)(VT + (16 * bt + li) * (LT * 2) + (32 * ks + 8 * fq) * 2); acc = MFMA16(af[ks], bf, acc); }
            *(f32x4*)(DSTg + (16 * bt + li) * 64 + d0 + 4 * fq) = acc * eb; } }
    if (rh == 0) ((float*)(C.ws + GLA_DEC))[(size_t)unit * 64 + lane] = __expf(BL[lane]);
    __syncthreads();
}
DI void gla_scan_item(Ctx& C, int l, int it) {
    const int lane = C.lane, b = it >> 8, h = (it >> 6) & 3, v = it & 63;
    const float* DST = (const float*)(C.ws + GLA_DST); float* SC = (float*)(C.ws + GLA_SC); const float* DEC = (const float*)(C.ws + GLA_DEC);
    float S = 0.f;
    for (int c0 = 0; c0 < 64; c0 += 8) { float ds[8], de[8];
#pragma unroll
        for (int e = 0; e < 8; ++e) { const size_t u = (size_t)((b * 64 + c0 + e) * 4 + h); ds[e] = DST[u * 4096 + v * 64 + lane]; de[e] = DEC[u * 64 + lane]; }
#pragma unroll
        for (int e = 0; e < 8; ++e) { const size_t u = (size_t)((b * 64 + c0 + e) * 4 + h); SC[u * 4096 + v * 64 + lane] = S; S = de[e] * S + ds[e]; } }
    C.out[O_PGLA + (((size_t)(l * NB + b) * 4 + h) * 64 + lane) * 64 + v] = S;
}
DI void gla_out_chunk(Ctx& C, int l, int b, int c) {
    const int tid = C.tid, lane = C.lane, wave = C.wave, h = wave >> 1, rh = wave & 1, li = lane & 15, fq = lane >> 4;
    const size_t row0 = (size_t)b * SEQ + (size_t)c * 64; const int unit = ((b * 64 + c) * 4 + h);
    LASQ unsigned char* L = C.lds; constexpr int TB = 64 * LT * 2;
    LASQ unsigned char* KL = L + h * (3 * TB); LASQ unsigned char* VT = KL + TB; LASQ unsigned char* ST = VT + TB;
    {
        const int x = (rh << 6) | lane, r = x >> 1, hf = x & 1;
        const bf16* kg = glaK(C) + (row0 + r) * 256 + h * 64 + 32 * hf; const bf16* vg = (const bf16*)(C.ws + GLA_VT) + (size_t)unit * 4096 + r * 64 + 32 * hf;
        const float* sg = (const float*)(C.ws + GLA_SC) + (size_t)unit * 4096 + r * 64 + 32 * hf;
#pragma unroll
        for (int e = 0; e < 4; ++e) { *(LASQ u32x4*)(KL + r * (LT * 2) + (32 * hf + 8 * e) * 2) = *(const u32x4*)(kg + 8 * e); *(LASQ u32x4*)(VT + r * (LT * 2) + (32 * hf + 8 * e) * 2) = *(const u32x4*)(vg + 8 * e);
            const f32x4 s0 = *(const f32x4*)(sg + 8 * e), s1 = *(const f32x4*)(sg + 8 * e + 4); *(LASQ bf16x8v*)(ST + r * (LT * 2) + (32 * hf + 8 * e) * 2) = cvt8(s0, s1); }
    }
    __syncthreads();
    const float* gnp = inF(C, 24) + l * 64;
#pragma unroll 1
    for (int bt = 0; bt < 2; ++bt) { const int iq = 32 * rh + 16 * bt + li; const size_t row = row0 + iq;
        bf16x8v qf[2];
#pragma unroll
        for (int ks = 0; ks < 2; ++ks) qf[ks] = *(const bf16x8v*)(glaQ(C) + row * 256 + h * 64 + 32 * ks + 8 * fq);
        f32x4 s[4];
#pragma unroll
        for (int jt = 0; jt < 4; ++jt) { s[jt] = (f32x4){0.f, 0.f, 0.f, 0.f};
#pragma unroll
            for (int ks = 0; ks < 2; ++ks) { const bf16x8v kf = *(const LASQ bf16x8v*)(KL + (16 * jt + li) * (LT * 2) + (32 * ks + 8 * fq) * 2); s[jt] = MFMA16(kf, qf[ks], s[jt]); }
#pragma unroll
            for (int r = 0; r < 4; ++r) s[jt][r] = (16 * jt + 4 * fq + r <= iq) ? s[jt][r] : 0.f; }
        bf16x8v pf[2];
#pragma unroll
        for (int ks = 0; ks < 2; ++ks) pf[ks] = cvt8(s[2 * ks], s[2 * ks + 1]);
        f32x4 o[4]; float ss = 0.f;
#pragma unroll
        for (int vt = 0; vt < 4; ++vt) { o[vt] = (f32x4){0.f, 0.f, 0.f, 0.f};
#pragma unroll
            for (int ks = 0; ks < 2; ++ks) { const LASQ unsigned char* vr = VT + (16 * vt + li) * (LT * 2);
                const bf16x4v lo = *(const LASQ bf16x4v*)(vr + (32 * ks + 4 * fq) * 2), hi = *(const LASQ bf16x4v*)(vr + (32 * ks + 16 + 4 * fq) * 2);
                o[vt] = MFMA16(__builtin_shufflevector(lo, hi, 0, 1, 2, 3, 4, 5, 6, 7), pf[ks], o[vt]);
                const bf16x8v sf = *(const LASQ bf16x8v*)(ST + (16 * vt + li) * (LT * 2) + (32 * ks + 8 * fq) * 2); o[vt] = MFMA16(sf, qf[ks], o[vt]); }
            ss += (o[vt][0] * o[vt][0] + o[vt][1] * o[vt][1]) + (o[vt][2] * o[vt][2] + o[vt][3] * o[vt][3]); }
        ss += __shfl_xor(ss, 16); ss += __shfl_xor(ss, 32);
        const float rinv = rsq_(ss * (1.f / 64.f) + 1e-6f);
        const float* ar = projp(C) + row * NP + C_AR + h * 64; bf16* yb = ybuf(C, 1) + row * 256 + h * 64;
#pragma unroll
        for (int vt = 0; vt < 4; ++vt) { const f32x4 g = *(const f32x4*)(ar + 16 * vt + 4 * fq), gn = *(const f32x4*)(gnp + 16 * vt + 4 * fq);
            u32x2 w; w.x = pg8::cvt_pk_bf16(o[vt][0] * rinv * gn.x * silu_(g.x), o[vt][1] * rinv * gn.y * silu_(g.y)); w.y = pg8::cvt_pk_bf16(o[vt][2] * rinv * gn.z * silu_(g.z), o[vt][3] * rinv * gn.w * silu_(g.w));
            *(u32x2*)(yb + 16 * vt + 4 * fq) = w; } }
    __syncthreads();
}

typedef float f32x2 __attribute__((ext_vector_type(2)));
constexpr size_t WS_S5 = WS_END2;
constexpr size_t S5_P = WS_S5;
constexpr size_t S5_CC = S5_P + (size_t)2 * 16 * 36 * 64 * 4;
constexpr size_t S5_WGT = S5_CC + (size_t)2 * 16 * 16 * 128 * 2;
constexpr size_t S5_E = S5_WGT + (size_t)2 * 256 * 256 * 2;
constexpr size_t S5_HIN = S5_E + (size_t)256 * 16 * 128 * 4;
constexpr size_t S5_YSB = S5_HIN + (size_t)256 * 16 * 128 * 4;
constexpr size_t ROPE_TAB = S5_YSB + 32 * 256 * 2;
constexpr size_t WS_END3 = ROPE_TAB + (size_t)(SEQ + 1) * 16 * 4;
DI void rope_item(Ctx& C, int it) {
    const int lane = C.lane, idx = 4 * it + (lane >> 4), j = lane & 15; if (idx > SEQ) return;
    const float pos = (idx == SEQ) ? (float)PAST : (float)idx; const float ang = pos * powf(500000.f, -(float)(j & 7) * 0.125f);
    ((float*)(C.ws + ROPE_TAB))[(size_t)idx * 16 + j] = (j < 8) ? cosf(ang) : sinf(ang);
}
DI void s5_param_item(Ctx& C, int it) {
    const int lane = C.lane, l = it >> 4, g = it & 15, pg = (l * 16 + g) * 64 + lane;
    const float dt = expf(inF(C, 14)[l * 16 + g]); const float ar = inF(C, 12)[pg], ai = inF(C, 13)[pg];
    const float mag = expf(ar * dt), ang = ai * dt, are = mag * cosf(ang), aim = mag * sinf(ang);
    const float den = ar * ar + ai * ai, nr = are - 1.f, fre = (nr * ar + aim * ai) / den, fim = (aim * ar - nr * ai) / den;
    float* P = (float*)(C.ws + S5_P) + (size_t)(l * 16 + g) * 36 * 64 + lane;
    float pr = are, pi = aim;
#pragma unroll
    for (int k = 0; k < 6; ++k) { const float nr2 = pr * pr - pi * pi, ni2 = 2.f * pr * pi; pr = nr2; pi = ni2; }
    P[0] = are; P[64] = aim; P[128] = pr; P[192] = pi;
#pragma unroll
    for (int c = 0; c < 16; ++c) { const float br = inF(C, 15)[(size_t)pg * 16 + c], bi = inF(C, 16)[(size_t)pg * 16 + c]; P[(4 + c) * 64] = fre * br - fim * bi; P[(20 + c) * 64] = fre * bi + fim * br; }
    unsigned* CC = (unsigned*)(C.ws + S5_CC) + (size_t)(l * 16 + g) * 16 * 64;
#pragma unroll
    for (int c = 0; c < 16; ++c) CC[c * 64 + lane] = pk2(inF(C, 17)[((size_t)(l * 16 + g) * 16 + c) * 64 + lane], -inF(C, 18)[((size_t)(l * 16 + g) * 16 + c) * 64 + lane]);
}
DI void s5_pass1_chunk(Ctx& C, int l, int b, int c) {
    const int lane = C.lane, wave = C.wave; const size_t row0 = (size_t)b * SEQ + (size_t)c * 64;
    LASQ float* US = (LASQ float*)(C.lds + wave * 4096);
#pragma unroll 1
    for (int gi = 0; gi < 2; ++gi) { const int g = 2 * wave + gi;
        { const float* up = projp(C) + (row0 + lane) * NP + C_S5U + g * 16;
#pragma unroll
          for (int j = 0; j < 4; ++j) *(LASQ f32x4*)(US + lane * 16 + 4 * j) = *(const f32x4*)(up + 4 * j); }
        const float* P = (const float*)(C.ws + S5_P) + (size_t)(l * 16 + g) * 36 * 64 + lane;
        const float are = P[0], aim = P[64]; f32x2 bb[16];
#pragma unroll
        for (int k = 0; k < 16; ++k) { bb[k].x = P[(4 + k) * 64]; bb[k].y = P[(20 + k) * 64]; }
        asm volatile("s_waitcnt lgkmcnt(0)" ::: "memory");
        float hr = 0.f, hi = 0.f;
#pragma unroll 4
        for (int t = 0; t < 64; ++t) { f32x2 xa = {0.f, 0.f}, xb = {0.f, 0.f};
#pragma unroll
            for (int j = 0; j < 4; ++j) { const f32x4 u = *(const LASQ f32x4*)(US + t * 16 + 4 * j);
                xa += bb[4 * j] * u.x + bb[4 * j + 1] * u.y; xb += bb[4 * j + 2] * u.z + bb[4 * j + 3] * u.w; }
            const float xr = xa.x + xb.x, xi = xa.y + xb.y;
            const float nhr = are * hr - aim * hi + xr, nhi = are * hi + aim * hr + xi; hr = nhr; hi = nhi; }
        float* E = (float*)(C.ws + S5_E) + ((size_t)((b * 64 + c) * 16 + g)) * 128; E[lane] = hr; E[64 + lane] = hi;
        asm volatile("s_waitcnt lgkmcnt(0)" ::: "memory");
    }
    __syncthreads();
}
DI void s5_carry_item(Ctx& C, int l, int it) {
    const int lane = C.lane, b = it >> 4, g = it & 15;
    const float* P = (const float*)(C.ws + S5_P) + (size_t)(l * 16 + g) * 36 * 64 + lane; const float a6r = P[128], a6i = P[192];
    const float* E = (const float*)(C.ws + S5_E); float* HIN = (float*)(C.ws + S5_HIN);
    float hr = 0.f, hi = 0.f;
    for (int c0 = 0; c0 < 64; c0 += 8) { float er[8], ei[8];
#pragma unroll
        for (int e = 0; e < 8; ++e) { const size_t o = ((size_t)((b * 64 + c0 + e) * 16 + g)) * 128; er[e] = E[o + lane]; ei[e] = E[o + 64 + lane]; }
#pragma unroll
        for (int e = 0; e < 8; ++e) { const size_t o = ((size_t)((b * 64 + c0 + e) * 16 + g)) * 128; HIN[o + lane] = hr; HIN[o + 64 + lane] = hi;
            const float nr = a6r * hr - a6i * hi + er[e], ni = a6r * hi + a6i * hr + ei[e]; hr = nr; hi = ni; } }
    const size_t so = ((size_t)(l * NB + b) * 16 + g) * 64 + lane; C.out[O_PS5R + so] = hr; C.out[O_PS5I + so] = hi;
}
constexpr int S5_HP = 136, S5_YP = 264;
DI void s5_out_chunk(Ctx& C, int l, int b, int c) {
    const int lane = C.lane, wave = C.wave, li = lane & 15, fq = lane >> 4; const size_t row0 = (size_t)b * SEQ + (size_t)c * 64;
    LASQ float* US = (LASQ float*)(C.lds + wave * 8448); LASQ unsigned char* HS = C.lds + wave * 8448 + 4096; LASQ unsigned char* Y = C.lds + 8 * 8448;
#pragma unroll 1
    for (int gi = 0; gi < 2; ++gi) { const int g = 2 * wave + gi;
        { const float* up = projp(C) + (row0 + lane) * NP + C_S5U + g * 16;
#pragma unroll
          for (int j = 0; j < 4; ++j) *(LASQ f32x4*)(US + lane * 16 + 4 * j) = *(const f32x4*)(up + 4 * j); }
        const float* P = (const float*)(C.ws + S5_P) + (size_t)(l * 16 + g) * 36 * 64 + lane;
        const float are = P[0], aim = P[64]; f32x2 bb[16];
#pragma unroll
        for (int k = 0; k < 16; ++k) { bb[k].x = P[(4 + k) * 64]; bb[k].y = P[(20 + k) * 64]; }
        bf16x8v cf[4];
        { const bf16* cc = (const bf16*)(C.ws + S5_CC) + ((size_t)(l * 16 + g) * 16 + li) * 128;
#pragma unroll
          for (int ks = 0; ks < 4; ++ks) cf[ks] = *(const bf16x8v*)(cc + 32 * ks + 8 * fq); }
        const f32x4 dd = *(const f32x4*)(inF(C, 19) + l * 256 + g * 16 + 4 * fq);
        const float* HIN = (const float*)(C.ws + S5_HIN) + ((size_t)((b * 64 + c) * 16 + g)) * 128; float hr = HIN[lane], hi = HIN[64 + lane];
        asm volatile("s_waitcnt lgkmcnt(0)" ::: "memory");
#pragma unroll 1
        for (int tb = 0; tb < 4; ++tb) {
#pragma unroll 4
            for (int i = 0; i < 16; ++i) { const int t = 16 * tb + i; f32x2 xa = {0.f, 0.f}, xb = {0.f, 0.f};
#pragma unroll
                for (int j = 0; j < 4; ++j) { const f32x4 u = *(const LASQ f32x4*)(US + t * 16 + 4 * j);
                    xa += bb[4 * j] * u.x + bb[4 * j + 1] * u.y; xb += bb[4 * j + 2] * u.z + bb[4 * j + 3] * u.w; }
                const float xr = xa.x + xb.x, xi = xa.y + xb.y;
                const float nhr = are * hr - aim * hi + xr, nhi = are * hi + aim * hr + xi; hr = nhr; hi = nhi;
                *(LASQ unsigned*)(HS + i * (S5_HP * 2) + 4 * lane) = pk2(hr, hi); }
            asm volatile("s_waitcnt lgkmcnt(0)" ::: "memory");
            f32x4 acc = {0.f, 0.f, 0.f, 0.f};
#pragma unroll
            for (int ks = 0; ks < 4; ++ks) { const bf16x8v hf = *(const LASQ bf16x8v*)(HS + li * (S5_HP * 2) + (32 * ks + 8 * fq) * 2); acc = MFMA16(cf[ks], hf, acc); }
            const f32x4 u = *(const LASQ f32x4*)(US + (16 * tb + li) * 16 + 4 * fq);
            u32x2 w; w.x = pg8::cvt_pk_bf16(gelu_tanh_(acc[0] + dd.x * u.x), gelu_tanh_(acc[1] + dd.y * u.y)); w.y = pg8::cvt_pk_bf16(gelu_tanh_(acc[2] + dd.z * u.z), gelu_tanh_(acc[3] + dd.w * u.w));
            *(LASQ u32x2*)(Y + (16 * tb + li) * (S5_YP * 2) + (g * 16 + 4 * fq) * 2) = w;
            asm volatile("s_waitcnt lgkmcnt(0)" ::: "memory");
        }
    }
    __syncthreads();
    f32x4 z[2][4];
#pragma unroll
    for (int at = 0; at < 2; ++at)
#pragma unroll
        for (int bt = 0; bt < 4; ++bt) z[at][bt] = (f32x4){0.f, 0.f, 0.f, 0.f};
    const bf16* wg = (const bf16*)(C.ws + S5_WGT) + (size_t)l * 256 * 256;
#pragma unroll 2
    for (int ks = 0; ks < 8; ++ks) { bf16x8v af[2], bfr[4];
#pragma unroll
        for (int at = 0; at < 2; ++at) af[at] = *(const bf16x8v*)(wg + (size_t)(32 * wave + 16 * at + li) * 256 + 32 * ks + 8 * fq);
#pragma unroll
        for (int bt = 0; bt < 4; ++bt) bfr[bt] = *(const LASQ bf16x8v*)(Y + (16 * bt + li) * (S5_YP * 2) + (32 * ks + 8 * fq) * 2);
#pragma unroll
        for (int at = 0; at < 2; ++at)
#pragma unroll
            for (int bt = 0; bt < 4; ++bt) z[at][bt] = MFMA16(af[at], bfr[bt], z[at][bt]); }
#pragma unroll
    for (int at = 0; at < 2; ++at) { const int n0 = 32 * wave + 16 * at + 4 * fq; const f32x4 bg = *(const f32x4*)(inF(C, 21) + l * 256 + n0);
#pragma unroll
        for (int bt = 0; bt < 4; ++bt) { const int t = 16 * bt + li; const u32x2 yw = *(const LASQ u32x2*)(Y + t * (S5_YP * 2) + n0 * 2);
            u32x2 w; w.x = pg8::cvt_pk_bf16(bflo(yw.x) * sigmoid_(z[at][bt][0] + bg.x), bfhi(yw.x) * sigmoid_(z[at][bt][1] + bg.y)); w.y = pg8::cvt_pk_bf16(bflo(yw.y) * sigmoid_(z[at][bt][2] + bg.z), bfhi(yw.y) * sigmoid_(z[at][bt][3] + bg.w));
            *(u32x2*)(ybuf(C, 0) + (row0 + t) * 256 + n0) = w; } }
    __syncthreads();
}
#ifndef GDN_CUT
#define GDN_CUT 4
#endif

constexpr size_t WS_GDN = WS_END3;
constexpr size_t GDN_Q = WS_GDN, GDN_K = GDN_Q + (size_t)MPAD * 256 * 2;
constexpr size_t GDN_GC = GDN_K + (size_t)MPAD * 256 * 2, GDN_BE = GDN_GC + 1024 * 64 * 4;
constexpr size_t GDN_W = GDN_BE + 1024 * 64 * 4;
constexpr size_t GDN_UT = GDN_W + (size_t)1024 * 4096 * 2;
constexpr size_t GDN_AC = GDN_UT + (size_t)1024 * 4096 * 4;
constexpr size_t GDN_BCT = GDN_AC + (size_t)1024 * 4096 * 4;
constexpr size_t GDN_SC = GDN_BCT + (size_t)1024 * 4096 * 4;
constexpr size_t WS_END4 = GDN_SC + (size_t)1024 * 4096 * 4;
constexpr int GD_MP = 72;
constexpr int GD_HSZ = 512 + 64 * LT * 2 + 64 * GD_MP * 4;
DI float wave_incl_scan(float x, int lane) {
#pragma unroll
    for (int o = 1; o < 64; o <<= 1) { const float y = __shfl_up(x, o); if (lane >= o) x += y; }
    return x;
}
#define GDN_CONV64(out, chan_off, cwp)  do { const float w0 = (cwp)[0], w1 = (cwp)[768], w2 = (cwp)[2 * 768], w3 = (cwp)[3 * 768]; \
        const float* p0 = projp(C) + row0 * NP + (chan_off); float x0 = 0.f, x1 = 0.f, x2 = 0.f; \
        if (c > 0) { x0 = *(p0 - 3 * (size_t)NP); x1 = *(p0 - 2 * (size_t)NP); x2 = *(p0 - (size_t)NP); } \
        _Pragma("unroll") for (int t = 0; t < 64; ++t) { const float x3 = p0[(size_t)t * NP]; out[t] = silu_(w0 * x0 + w1 * x1 + w2 * x2 + w3 * x3); x0 = x1; x1 = x2; x2 = x3; } } while (0)
DI void gdn_prep_chunk(Ctx& C, int l, int b, int c) {
    const int lane = C.lane, wave = C.wave, h = wave >> 1, role = wave & 1, li = lane & 15, fq = lane >> 4;
    const size_t row0 = (size_t)b * SEQ + (size_t)c * 64; const int unit = ((b * 64 + c) * 4 + h);
    LASQ unsigned char* HB = C.lds + h * GD_HSZ;
    LASQ float* GC = (LASQ float*)HB; LASQ float* BE = GC + 64; LASQ unsigned char* KH = HB + 512; LASQ float* M = (LASQ float*)(HB + 512 + 64 * LT * 2);
    const float* cw = inF(C, 25) + (size_t)l * 4 * 768;
    float X[64];
    if (role == 0) {
        {
            const float* pr = projp(C) + (row0 + lane) * NP; const float beta = sigmoid_(pr[C_DB + h]);
            const float g = -expf(inF(C, 26)[l * 4 + h]) * softplus_(pr[C_DA + h] + inF(C, 27)[l * 4 + h]);
            const float gc = wave_incl_scan(g, lane); GC[lane] = gc; BE[lane] = beta;
            ((float*)(C.ws + GDN_GC))[(size_t)unit * 64 + lane] = gc; ((float*)(C.ws + GDN_BE))[(size_t)unit * 64 + lane] = beta; }
        GDN_CONV64(X, C_DK + h * 64 + lane, cw + 256 + h * 64 + lane);
        bf16* Kg = (bf16*)(C.ws + GDN_K) + row0 * 256 + h * 64 + lane;
#pragma unroll
        for (int t = 0; t < 64; ++t) { X[t] *= rsq_(wsum(X[t] * X[t]) + 1e-6f); const unsigned short kb = (unsigned short)f2bf(X[t]);
            *(LASQ unsigned short*)(KH + t * (LT * 2) + lane * 2) = kb; Kg[(size_t)t * 256] = kb; }
    } else {
        {
            float Qv[64];
            GDN_CONV64(Qv, C_DQ + h * 64 + lane, cw + h * 64 + lane);
            bf16* Qg = (bf16*)(C.ws + GDN_Q) + row0 * 256 + h * 64 + lane;
#pragma unroll
            for (int t = 0; t < 64; ++t) Qg[(size_t)t * 256] = (bf16)f2bf(Qv[t] * (0.125f * rsq_(wsum(Qv[t] * Qv[t]) + 1e-6f)));
        }
        asm volatile("" ::: "memory");
        GDN_CONV64(X, C_DV + h * 64 + lane, cw + 512 + h * 64 + lane);
    }
    __syncthreads();
#if GDN_CUT >= 1
    {
        float zf; asm volatile("v_mov_b32 %0, 0" : "=v"(zf));
#pragma unroll
        for (int it = 0; it < 2; ++it) { const int i0 = 16 * (2 * role + it); bf16x8v bfr[2];
#pragma unroll
            for (int ks = 0; ks < 2; ++ks) bfr[ks] = *(const LASQ bf16x8v*)(KH + (i0 + li) * (LT * 2) + (32 * ks + 8 * fq) * 2);
            const float gi = GC[i0 + li];
#pragma unroll
            for (int jt = 0; jt < 4; ++jt) { f32x4 acc = {0.f, 0.f, 0.f, 0.f};
#pragma unroll
                for (int ks = 0; ks < 2; ++ks) { const bf16x8v af = *(const LASQ bf16x8v*)(KH + (16 * jt + li) * (LT * 2) + (32 * ks + 8 * fq) * 2); acc = MFMA16(af, bfr[ks], acc); }
                f32x4 mv;
#pragma unroll
                for (int r = 0; r < 4; ++r) { const int j = 16 * jt + 4 * fq + r; mv[r] = (i0 + li > j) ? __expf(gi - GC[j]) * BE[j] * acc[r] : zf; }
                *(LASQ f32x4*)(M + (i0 + li) * GD_MP + 16 * jt + 4 * fq) = mv; } }
    }
#endif
    __syncthreads();
    const float glast = GC[63];
#if GDN_CUT >= 2
    if (role == 0) {
#pragma unroll
        for (int j8 = 0; j8 < 8; ++j8) { float kw[8];
#pragma unroll
            for (int e = 0; e < 8; ++e) { const int j = 8 * j8 + e; kw[e] = X[j] * __expf(glast - GC[j]) * BE[j]; }
            u32x4 w; w.x = pk2(kw[0], kw[1]); w.y = pk2(kw[2], kw[3]); w.z = pk2(kw[4], kw[5]); w.w = pk2(kw[6], kw[7]);
            *(LASQ u32x4*)(KH + lane * (LT * 2) + j8 * 16) = w; }
#pragma unroll
        for (int i = 0; i < 64; ++i) X[i] *= __expf(GC[i]);
    }
#endif
#if GDN_CUT >= 3
#pragma unroll
    for (int i = 1; i < 64; ++i) { float s = 0.f;
#pragma unroll
        for (int j4 = 0; j4 < (i + 3) / 4; ++j4) { const f32x4 mr = *(const LASQ f32x4*)(M + i * GD_MP + 4 * j4);
            s += mr.x * X[4 * j4];
            if (4 * j4 + 1 < i) s += mr.y * X[4 * j4 + 1];
            if (4 * j4 + 2 < i) s += mr.z * X[4 * j4 + 2];
            if (4 * j4 + 3 < i) s += mr.w * X[4 * j4 + 3]; }
        X[i] -= s; asm volatile("" : "+v"(X[i]) :: "memory"); }
#endif
    __syncthreads();
    LASQ unsigned char* WT = (LASQ unsigned char*)M; LASQ unsigned char* UT = WT + 64 * LT * 2;
    {   LASQ unsigned char* dst = (role == 0 ? WT : UT) + lane * (LT * 2);
#pragma unroll
        for (int j8 = 0; j8 < 8; ++j8) { u32x4 w; w.x = pk2(X[8 * j8], X[8 * j8 + 1]); w.y = pk2(X[8 * j8 + 2], X[8 * j8 + 3]); w.z = pk2(X[8 * j8 + 4], X[8 * j8 + 5]); w.w = pk2(X[8 * j8 + 6], X[8 * j8 + 7]);
            *(LASQ u32x4*)(dst + j8 * 16) = w; }
        if (role == 0) { bf16* Wg = (bf16*)(C.ws + GDN_W) + (size_t)unit * 4096 + lane;
#pragma unroll
            for (int i = 0; i < 64; ++i) Wg[i * 64] = (bf16)f2bf(X[i]); }
        else { float* Ug = (float*)(C.ws + GDN_UT) + (size_t)unit * 4096 + lane * 64;
#pragma unroll
            for (int i4 = 0; i4 < 16; ++i4) *(f32x4*)(Ug + 4 * i4) = (f32x4){X[4 * i4], X[4 * i4 + 1], X[4 * i4 + 2], X[4 * i4 + 3]}; }
    }
    __syncthreads();
#if GDN_CUT >= 4
    if (role == 0) {
        bf16* ACh = (bf16*)(C.ws + GDN_AC) + (size_t)unit * 4096; bf16* ACl = ACh + (size_t)1024 * 4096; const float eg = __expf(glast);
#pragma unroll 1
        for (int bt = 0; bt < 4; ++bt) { bf16x8v bfr[2];
#pragma unroll
            for (int ks = 0; ks < 2; ++ks) bfr[ks] = *(const LASQ bf16x8v*)(KH + (16 * bt + li) * (LT * 2) + (32 * ks + 8 * fq) * 2);
#pragma unroll
            for (int at = 0; at < 4; ++at) { f32x4 acc = {0.f, 0.f, 0.f, 0.f};
#pragma unroll
                for (int ks = 0; ks < 2; ++ks) { const bf16x8v af = *(const LASQ bf16x8v*)(WT + (16 * at + li) * (LT * 2) + (32 * ks + 8 * fq) * 2); acc = MFMA16(af, bfr[ks], acc); }
                f32x4 o;
#pragma unroll
                for (int r = 0; r < 4; ++r) o[r] = ((16 * at + 4 * fq + r) == (16 * bt + li) ? eg : 0.f) - acc[r];
                u32x2 wh, wl; wh.x = pg8::cvt_pk_bf16(o[0], o[1]); wh.y = pg8::cvt_pk_bf16(o[2], o[3]);
                wl.x = pg8::cvt_pk_bf16(o[0] - bflo(wh.x), o[1] - bfhi(wh.x)); wl.y = pg8::cvt_pk_bf16(o[2] - bflo(wh.y), o[3] - bfhi(wh.y));
                const int pos = (16 * bt + li) * 64 + 32 * (at >> 1) + 8 * fq + 4 * (at & 1);
                *(u32x2*)(ACh + pos) = wh; *(u32x2*)(ACl + pos) = wl; } }
    } else {
        float* BCg = (float*)(C.ws + GDN_BCT) + (size_t)unit * 4096;
#pragma unroll 1
        for (int bt = 0; bt < 4; ++bt) { bf16x8v bfr[2];
#pragma unroll
            for (int ks = 0; ks < 2; ++ks) bfr[ks] = *(const LASQ bf16x8v*)(UT + (16 * bt + li) * (LT * 2) + (32 * ks + 8 * fq) * 2);
#pragma unroll
            for (int at = 0; at < 4; ++at) { f32x4 acc = {0.f, 0.f, 0.f, 0.f};
#pragma unroll
                for (int ks = 0; ks < 2; ++ks) { const bf16x8v af = *(const LASQ bf16x8v*)(KH + (16 * at + li) * (LT * 2) + (32 * ks + 8 * fq) * 2); acc = MFMA16(af, bfr[ks], acc); }
                *(f32x4*)(BCg + (16 * bt + li) * 64 + 16 * at + 4 * fq) = acc; } }
    }
#endif
    __syncthreads();
}
DI void bf_split(const f32x4 a, const f32x4 b, bf16x8v& hi, bf16x8v& lo) {
    u32x4 w; w.x = pg8::cvt_pk_bf16(a.x, a.y); w.y = pg8::cvt_pk_bf16(a.z, a.w); w.z = pg8::cvt_pk_bf16(b.x, b.y); w.w = pg8::cvt_pk_bf16(b.z, b.w);
    hi = __builtin_bit_cast(bf16x8v, w);
    const f32x4 ra = {a.x - bflo(w.x), a.y - bfhi(w.x), a.z - bflo(w.y), a.w - bfhi(w.y)}, rb = {b.x - bflo(w.z), b.y - bfhi(w.z), b.z - bflo(w.w), b.w - bfhi(w.w)};
    lo = cvt8(ra, rb);
}
DI void gdn_scan_item(Ctx& C, int l, int it) {
    const int lane = C.lane, li = lane & 15, fq = lane >> 4, b = it >> 4, h = (it >> 2) & 3, vs = it & 3, v = 16 * vs + li;
    const bf16* ACh = (const bf16*)(C.ws + GDN_AC); const bf16* ACl = ACh + (size_t)1024 * 4096; const float* BCT = (const float*)(C.ws + GDN_BCT); float* SC = (float*)(C.ws + GDN_SC);
    f32x4 S[4];
#pragma unroll
    for (int at = 0; at < 4; ++at) S[at] = (f32x4){0.f, 0.f, 0.f, 0.f};
    bf16x8v Ahn[4][2], Aln[4][2]; f32x4 Bn[4];
#define GDN_SCAN_LOAD(cc) do { const size_t u_ = (size_t)((b * 64 + (cc)) * 4 + h) * 4096; \
        _Pragma("unroll") for (int at = 0; at < 4; ++at) { Bn[at] = *(const f32x4*)(BCT + u_ + v * 64 + 16 * at + 4 * fq); \
            _Pragma("unroll") for (int ks = 0; ks < 2; ++ks) { Ahn[at][ks] = *(const bf16x8v*)(ACh + u_ + (16 * at + li) * 64 + 32 * ks + 8 * fq); Aln[at][ks] = *(const bf16x8v*)(ACl + u_ + (16 * at + li) * 64 + 32 * ks + 8 * fq); } } } while (0)
    GDN_SCAN_LOAD(0);
    for (int c = 0; c < 64; ++c) {
        bf16x8v Ah[4][2], Al[4][2]; f32x4 Bc[4];
#pragma unroll
        for (int at = 0; at < 4; ++at) { Bc[at] = Bn[at];
#pragma unroll
            for (int ks = 0; ks < 2; ++ks) { Ah[at][ks] = Ahn[at][ks]; Al[at][ks] = Aln[at][ks]; } }
        if (c + 1 < 64) GDN_SCAN_LOAD(c + 1);
        const size_t u = (size_t)((b * 64 + c) * 4 + h) * 4096;
#pragma unroll
        for (int at = 0; at < 4; ++at) *(f32x4*)(SC + u + v * 64 + 16 * at + 4 * fq) = S[at];
        bf16x8v sh[2], sl[2];
#pragma unroll
        for (int ks = 0; ks < 2; ++ks) bf_split(S[2 * ks], S[2 * ks + 1], sh[ks], sl[ks]);
#pragma unroll
        for (int at = 0; at < 4; ++at) { f32x4 acc = Bc[at];
#pragma unroll
            for (int ks = 0; ks < 2; ++ks) { acc = MFMA16(Ah[at][ks], sh[ks], acc); acc = MFMA16(Ah[at][ks], sl[ks], acc); acc = MFMA16(Al[at][ks], sh[ks], acc); }
            S[at] = acc; }
    }
#undef GDN_SCAN_LOAD
    float* so = C.out + O_PGDN + ((size_t)(l * NB + b) * 4 + h) * 4096 + v;
#pragma unroll
    for (int at = 0; at < 4; ++at)
#pragma unroll
        for (int r = 0; r < 4; ++r) so[(size_t)(16 * at + 4 * fq + r) * 64] = S[at][r];
}
constexpr int GO_HSZ = 512 + 4 * 64 * LT * 2;
DI void gdn_out_chunk(Ctx& C, int l, int b, int c) {
    const int lane = C.lane, wave = C.wave, hh = wave >> 2, qw = wave & 3, li = lane & 15, fq = lane >> 4;
    const size_t row0 = (size_t)b * SEQ + (size_t)c * 64;
    LASQ unsigned char* HB = C.lds + hh * GO_HSZ; constexpr int TB = 64 * LT * 2;
    LASQ float* GC = (LASQ float*)HB; LASQ float* BE = GC + 64; LASQ unsigned char* KH = HB + 512; LASQ unsigned char* WL = KH + TB; LASQ unsigned char* ST = WL + TB; LASQ unsigned char* UTL = ST + TB;
    const float* gnp = inF(C, 28) + l * 64;
#pragma unroll 1
    for (int pass = 0; pass < 2; ++pass) { const int h = 2 * pass + hh; const int unit = ((b * 64 + c) * 4 + h);
        {
            const int x = (qw << 6) | lane, r = x >> 2, qd = x & 3;
            const bf16* kg = (const bf16*)(C.ws + GDN_K) + (row0 + r) * 256 + h * 64 + 16 * qd; const bf16* wgp = (const bf16*)(C.ws + GDN_W) + (size_t)unit * 4096 + r * 64 + 16 * qd;
            const float* sg = (const float*)(C.ws + GDN_SC) + (size_t)unit * 4096 + r * 64 + 16 * qd;
#pragma unroll
            for (int e = 0; e < 2; ++e) { *(LASQ u32x4*)(KH + r * (LT * 2) + (16 * qd + 8 * e) * 2) = *(const u32x4*)(kg + 8 * e); *(LASQ u32x4*)(WL + r * (LT * 2) + (16 * qd + 8 * e) * 2) = *(const u32x4*)(wgp + 8 * e);
                const f32x4 s0 = *(const f32x4*)(sg + 8 * e), s1 = *(const f32x4*)(sg + 8 * e + 4); *(LASQ bf16x8v*)(ST + r * (LT * 2) + (16 * qd + 8 * e) * 2) = cvt8(s0, s1); }
            if (x < 64) { GC[x] = ((const float*)(C.ws + GDN_GC))[(size_t)unit * 64 + x]; BE[x] = ((const float*)(C.ws + GDN_BE))[(size_t)unit * 64 + x]; }
        }
        __syncthreads();
        {
            bf16x8v af[2];
#pragma unroll
            for (int ks = 0; ks < 2; ++ks) af[ks] = *(const LASQ bf16x8v*)(WL + (16 * qw + li) * (LT * 2) + (32 * ks + 8 * fq) * 2);
            const float* Ug = (const float*)(C.ws + GDN_UT) + (size_t)unit * 4096;
#pragma unroll
            for (int bt = 0; bt < 4; ++bt) { f32x4 acc = {0.f, 0.f, 0.f, 0.f};
#pragma unroll
                for (int ks = 0; ks < 2; ++ks) { const bf16x8v bfr = *(const LASQ bf16x8v*)(ST + (16 * bt + li) * (LT * 2) + (32 * ks + 8 * fq) * 2); acc = MFMA16(af[ks], bfr, acc); }
                const f32x4 uu = *(const f32x4*)(Ug + (16 * bt + li) * 64 + 16 * qw + 4 * fq) - acc;
                u32x2 w; w.x = pg8::cvt_pk_bf16(uu.x, uu.y); w.y = pg8::cvt_pk_bf16(uu.z, uu.w);
                *(LASQ u32x2*)(UTL + (16 * bt + li) * (LT * 2) + (16 * qw + 4 * fq) * 2) = w; }
        }
        __syncthreads();
        {   const int iq = 16 * qw + li; const size_t row = row0 + iq;
            bf16x8v qf[2];
#pragma unroll
            for (int ks = 0; ks < 2; ++ks) qf[ks] = *(const bf16x8v*)((const bf16*)(C.ws + GDN_Q) + row * 256 + h * 64 + 32 * ks + 8 * fq);
            const float gi = GC[iq]; f32x4 s[4];
#pragma unroll
            for (int jt = 0; jt < 4; ++jt) { s[jt] = (f32x4){0.f, 0.f, 0.f, 0.f};
#pragma unroll
                for (int ks = 0; ks < 2; ++ks) { const bf16x8v kf = *(const LASQ bf16x8v*)(KH + (16 * jt + li) * (LT * 2) + (32 * ks + 8 * fq) * 2); s[jt] = MFMA16(kf, qf[ks], s[jt]); }
#pragma unroll
                for (int r = 0; r < 4; ++r) { const int j = 16 * jt + 4 * fq + r; s[jt][r] = (j <= iq) ? s[jt][r] * __expf(gi - GC[j]) * BE[j] : 0.f; } }
            bf16x8v pf[2];
#pragma unroll
            for (int ks = 0; ks < 2; ++ks) pf[ks] = cvt8(s[2 * ks], s[2 * ks + 1]);
            const float eg = __expf(gi); f32x4 o[4]; float ss = 0.f;
#pragma unroll
            for (int vt = 0; vt < 4; ++vt) { f32x4 a1 = {0.f, 0.f, 0.f, 0.f}, a2 = {0.f, 0.f, 0.f, 0.f};
#pragma unroll
                for (int ks = 0; ks < 2; ++ks) { const LASQ unsigned char* ur = UTL + (16 * vt + li) * (LT * 2);
                    const bf16x4v lo = *(const LASQ bf16x4v*)(ur + (32 * ks + 4 * fq) * 2), hi = *(const LASQ bf16x4v*)(ur + (32 * ks + 16 + 4 * fq) * 2);
                    a1 = MFMA16(__builtin_shufflevector(lo, hi, 0, 1, 2, 3, 4, 5, 6, 7), pf[ks], a1);
                    const bf16x8v sf = *(const LASQ bf16x8v*)(ST + (16 * vt + li) * (LT * 2) + (32 * ks + 8 * fq) * 2); a2 = MFMA16(sf, qf[ks], a2); }
                o[vt] = a1 + a2 * eg; ss += (o[vt][0] * o[vt][0] + o[vt][1] * o[vt][1]) + (o[vt][2] * o[vt][2] + o[vt][3] * o[vt][3]); }
            ss += __shfl_xor(ss, 16); ss += __shfl_xor(ss, 32);
            const float rinv = rsq_(ss * (1.f / 64.f) + 1e-6f);
            const float* zr = projp(C) + row * NP + C_DZ + h * 64; bf16* yc = ybuf(C, 2) + row * 256 + h * 64;
#pragma unroll
            for (int vt = 0; vt < 4; ++vt) { const f32x4 g = *(const f32x4*)(zr + 16 * vt + 4 * fq), gn = *(const f32x4*)(gnp + 16 * vt + 4 * fq);
                u32x2 w; w.x = pg8::cvt_pk_bf16(o[vt][0] * rinv * gn.x * silu_(g.x), o[vt][1] * rinv * gn.y * silu_(g.y)); w.y = pg8::cvt_pk_bf16(o[vt][2] * rinv * gn.z * silu_(g.z), o[vt][3] * rinv * gn.w * silu_(g.w));
                *(u32x2*)(yc + 16 * vt + 4 * fq) = w; }
        }
        __syncthreads();
    }
}

constexpr size_t WS_MB = WS_END4;
constexpr size_t MB_Q = WS_MB;
constexpr size_t MB_K = MB_Q + (size_t)MP * 256 * 2;
constexpr size_t MB_VT = MB_K + (size_t)MP * 256 * 2;
constexpr size_t MB_KSUM = MB_VT + (size_t)MP * 256 * 2;
constexpr size_t WS_END5 = MB_KSUM + (size_t)NB * 64 * 256 * 4;
DI void moba_prep_chunk(Ctx& C, int l, int b, int c, const float* ropetab) {
    const int tid = C.tid, lane = C.lane, wave = C.wave; const size_t row0 = (size_t)b * SEQ + (size_t)c * 64;
    LASQ unsigned char* VTL = C.lds; LASQ float* KS = (LASQ float*)(C.lds + 256 * LT * 2);
    const float qnv = inF(C, 29)[l * 64 + lane], knv = inF(C, 30)[l * 64 + lane]; const float qs = 0.125f * 1.4426950408889634f;
    float ks[4] = {0.f, 0.f, 0.f, 0.f};
    float* MQ = tmpbuf(C, T_MQ); bf16* QB = (bf16*)(C.ws + MB_Q); bf16* KB = (bf16*)(C.ws + MB_K); bf16* VB = (bf16*)(C.ws + MB_VT);
#pragma unroll 1
    for (int half = 0; half < 2; ++half) {
        float xq[4][4], xk[4][4], xv[4][4];
#pragma unroll
        for (int i = 0; i < 4; ++i) { const float* pr = projp(C) + (row0 + 8 * wave + 4 * half + i) * NP;
#pragma unroll
            for (int hh = 0; hh < 4; ++hh) { xq[i][hh] = pr[C_MQ + hh * 64 + lane]; xk[i][hh] = pr[C_MK + hh * 64 + lane]; xv[i][hh] = pr[C_MV + hh * 64 + lane]; } }
#pragma unroll
        for (int i = 0; i < 4; ++i) { const int t = 8 * wave + 4 * half + i; const size_t row = row0 + t;
            const float* rt = ropetab + (size_t)(c * 64 + t) * 16; const float cs = rt[lane & 7], sn = rt[8 + (lane & 7)];
            float* MK = C.out + O_PMK + ((size_t)l * MP + row) * 256; float* MV = C.out + O_PMV + ((size_t)l * MP + row) * 256;
#pragma unroll
            for (int hh = 0; hh < 4; ++hh) { float q = xq[i][hh], k = xk[i][hh];
                q = q * rsq_(wsum(q * q) * (1.f / 64.f) + 1e-6f) * qnv; k = k * rsq_(wsum(k * k) * (1.f / 64.f) + 1e-6f) * knv;
                const float pq = __shfl_xor(q, 8), pk = __shfl_xor(k, 8);
                if (lane < 8) { q = q * cs - pq * sn; k = k * cs - pk * sn; } else if (lane < 16) { q = q * cs + pq * sn; k = k * cs + pk * sn; }
                MQ[row * 256 + hh * 64 + lane] = q; QB[row * 256 + hh * 64 + lane] = (bf16)f2bf(q * qs);
                MK[hh * 64 + lane] = k; KB[row * 256 + hh * 64 + lane] = (bf16)f2bf(k); ks[hh] += k;
                MV[hh * 64 + lane] = xv[i][hh]; VB[row * 256 + hh * 64 + lane] = (bf16)f2bf(xv[i][hh]); } }
    }
#pragma unroll
    for (int hh = 0; hh < 4; ++hh) KS[wave * 256 + hh * 64 + lane] = ks[hh];
    __syncthreads();
    if (tid < 256) { float s = 0.f;
#pragma unroll
        for (int w = 0; w < 8; ++w) s += KS[w * 256 + tid];
        ((float*)(C.ws + MB_KSUM))[((size_t)b * 64 + c) * 256 + tid] = s; }
    if (c == 63) { for (int i = tid; i < 3 * 768; i += 512) { const int j = i / 768, ch = i - j * 768; C.out[O_PCONV + (((size_t)l * NB + b) * 3 + j) * 768 + ch] = projp(C)[(row0 + 61 + j) * NP + C_DQ + ch]; } }
    __syncthreads();
}

constexpr size_t WS_KMS2 = WS_END5;
constexpr size_t WS_END6 = WS_KMS2 + (size_t)2 * SB * 32 * 256 * 4;
DI void lds_barrier_() { asm volatile("s_waitcnt lgkmcnt(0)" ::: "memory"); __builtin_amdgcn_s_barrier(); asm volatile("" ::: "memory"); }
DI float skinny_core(const Ctx& C, const bf16* A, const bf16* Bt, int K, int n0, LASQ float* red) {
    const int lane = C.lane, wave = C.wave, li = lane & 15, fq = lane >> 4, kw = K >> 3, k0 = wave * kw + 8 * fq;
    f32x4 acc0 = {0.f, 0.f, 0.f, 0.f}, acc1 = {0.f, 0.f, 0.f, 0.f};
    const bf16* bp = Bt + (size_t)(n0 + li) * K + k0; const bf16* ap0 = A + (size_t)li * K + k0; const bf16* ap1 = A + (size_t)(16 + li) * K + k0;
#pragma unroll 8
    for (int ks = 0; ks < (kw >> 5); ++ks) { const bf16x8v bfr = *(const bf16x8v*)(bp + 32 * ks), a0 = *(const bf16x8v*)(ap0 + 32 * ks), a1 = *(const bf16x8v*)(ap1 + 32 * ks);
        acc0 = MFMA16(bfr, a0, acc0); acc1 = MFMA16(bfr, a1, acc1); }
    *(LASQ f32x4*)(red + wave * 512 + li * 16 + 4 * fq) = acc0; *(LASQ f32x4*)(red + wave * 512 + (16 + li) * 16 + 4 * fq) = acc1;
    __syncthreads();
    float v = 0.f;
#pragma unroll
    for (int w = 0; w < 8; ++w) v += red[w * 512 + C.tid];
    __syncthreads();
    return v;
}
DI void kmean_unit(Ctx& C, int l, int u) {
    const int tid = C.tid, cc = tid & 63, tg = tid >> 6; LASQ float* red = (LASQ float*)C.lds;
    const int r = u, bs = r >> 5, blk = r & 31; const int page = inI(C, 4)[bs * 64 + blk * 2 + (tg >> 2)];
    const float* src = inF(C, 2) + (((size_t)l * NPOOL + page) * 128 + (tg & 3) * 32) * 256; float* dst = (float*)(C.ws + WS_KMS2) + ((size_t)l * SB * 32 + r) * 256;
    f32x4 s = {0.f, 0.f, 0.f, 0.f};
#pragma unroll 8
    for (int j = 0; j < 32; ++j) s += __builtin_nontemporal_load((const f32x4*)(src + (size_t)j * 256 + 4 * cc));
    *(LASQ f32x4*)(red + tg * 256 + 4 * cc) = s;
    __syncthreads();
    if (tid < 256) { float t = 0.f;
#pragma unroll
        for (int g = 0; g < 8; ++g) t += red[g * 256 + tid];
        dst[tid] = t * (1.f / 256.f); }
    __syncthreads();
}
DI void moba_decode_unit(Ctx& C, int l, int bs, int h) {
    const int tid = C.tid, lane = C.lane, wave = C.wave; const size_t m = (size_t)MP + bs;
    LASQ float* QL = (LASQ float*)C.lds; LASQ float* GT = QL + 64; LASQ float* LG = QL + 128; LASQ float* PO = QL + 1024;
    const float q = tmpbuf(C, T_MQ)[m * 256 + h * 64 + lane];
    if (wave == 0) QL[lane] = q;
#pragma unroll
    for (int i = 0; i < 4; ++i) { const int n = 4 * wave + i; const float g = wsum(q * ((const float*)(C.ws + WS_KMS2))[(((size_t)l * SB + bs) * 32 + n) * 256 + h * 64 + lane]); if (lane == 0) GT[n] = g; }
    __syncthreads();
    int sel[3];
    { float myg = (lane < 32) ? GT[lane] : -3.0e38f;
#pragma unroll
      for (int r = 0; r < 3; ++r) { const float mx = wmaxf(myg); const unsigned long long bal = __ballot(myg == mx); const int idx = __ffsll((long long)bal) - 1; sel[r] = __builtin_amdgcn_readfirstlane(idx); if (lane == idx) myg = -3.0e38f; } }
    const int* pt = inI(C, 4) + bs * 64; const float* ck = inF(C, 2) + (size_t)l * NPOOL * 128 * 256 + h * 64; const float* cv = inF(C, 3) + (size_t)l * NPOOL * 128 * 256 + h * 64;
#pragma unroll
    for (int rep = 0; rep < 2; ++rep) { const int key = tid + 512 * rep;
        if (key <= 768) { const float* kr;
            if (key < 768) { const int r = key >> 8, kk = key & 255; const int sb = (r == 0) ? sel[0] : ((r == 1) ? sel[1] : sel[2]); const int kp = sb * 256 + kk; kr = ck + ((size_t)pt[kp >> 7] * 128 + (kp & 127)) * 256; }
            else kr = C.out + O_SMK + ((size_t)l * SB + bs) * 256 + h * 64;
            float dot = 0.f;
#pragma unroll
            for (int d4 = 0; d4 < 16; ++d4) { const f32x4 kv = *(const f32x4*)(kr + 4 * d4); const f32x4 qv = *(const LASQ f32x4*)(QL + 4 * d4); dot += (kv.x * qv.x + kv.y * qv.y) + (kv.z * qv.z + kv.w * qv.w); }
            LG[key] = dot * 0.125f; } }
    __syncthreads();
    float mx = -3.0e38f;
    for (int k = lane; k <= 768; k += 64) mx = fmaxf(mx, LG[k]);
    mx = wmaxf(mx);
    float sum = 0.f;
    for (int k = lane; k <= 768; k += 64) sum += __expf(LG[k] - mx);
    sum = wsum(sum);
    float o = 0.f;
    {   const float* vb[3]; float vv[3][32];
#pragma unroll
        for (int gi = 0; gi < 3; ++gi) { const int gk0 = 32 * (3 * wave + gi), r = gk0 >> 8, kk0 = gk0 & 255; const int sb = (r == 0) ? sel[0] : ((r == 1) ? sel[1] : sel[2]); const int kp0 = sb * 256 + kk0;
            vb[gi] = cv + ((size_t)pt[kp0 >> 7] * 128 + (kp0 & 127)) * 256 + lane; }
#pragma unroll
        for (int gi = 0; gi < 3; ++gi)
#pragma unroll
            for (int j = 0; j < 32; ++j) vv[gi][j] = vb[gi][(size_t)j * 256];
#pragma unroll
        for (int gi = 0; gi < 3; ++gi)
#pragma unroll
            for (int j = 0; j < 32; ++j) o += __expf(LG[32 * (3 * wave + gi) + j] - mx) * vv[gi][j]; }
    if (wave == 0) o += __expf(LG[768] - mx) * C.out[O_SMV + ((size_t)l * SB + bs) * 256 + h * 64 + lane];
    PO[wave * 64 + lane] = o;
    __syncthreads();
    if (wave == 0) { float t = 0.f;
#pragma unroll
        for (int w = 0; w < 8; ++w) t += PO[w * 64 + lane];
        ybuf(C, 3)[m * 256 + h * 64 + lane] = (bf16)f2bf(t / sum); }
    __syncthreads();
}

DI void skinny_merge_item(Ctx& C, int l, int n0, LASQ float* red) {
    const int lane = C.lane, wave = C.wave, li = lane & 15, fq = lane >> 4, br = wave >> 1, kh = wave & 1, k0 = 128 * kh + 8 * fq;
    const bf16* A = ybuf(C, br) + (size_t)MP * BW; const bf16* Bt = wptr(C, l, WO_WBR) + (size_t)br * D * BW;
    f32x4 acc0 = {0.f, 0.f, 0.f, 0.f}, acc1 = {0.f, 0.f, 0.f, 0.f};
    const bf16* bp = Bt + (size_t)(n0 + li) * BW + k0; const bf16* ap0 = A + (size_t)li * BW + k0; const bf16* ap1 = A + (size_t)(16 + li) * BW + k0;
#pragma unroll
    for (int ks = 0; ks < 4; ++ks) { const bf16x8v bfr = *(const bf16x8v*)(bp + 32 * ks), a0 = *(const bf16x8v*)(ap0 + 32 * ks), a1 = *(const bf16x8v*)(ap1 + 32 * ks);
        acc0 = MFMA16(bfr, a0, acc0); acc1 = MFMA16(bfr, a1, acc1); }
    *(LASQ f32x4*)(red + wave * 512 + li * 16 + 4 * fq) = acc0; *(LASQ f32x4*)(red + wave * 512 + (16 + li) * 16 + 4 * fq) = acc1;
    lds_barrier_();
    const int row = C.tid >> 4, col = C.tid & 15; float accm = 0.f;
#pragma unroll
    for (int b4 = 0; b4 < 4; ++b4) accm += (red[(2 * b4) * 512 + C.tid] + red[(2 * b4 + 1) * 512 + C.tid]) * bflo((unsigned)gatep(C)[(size_t)(MP + row) * NGATE + b4 * D + n0 + col]);
    lds_barrier_();
    mrgp(C)[(size_t)(MP + row) * D + n0 + col] = (bf16)f2bf(accm);
}

constexpr int MG_AB = 256 * LT * 2, MG_BB = 128 * LT * 2, MG_STAGE = MG_AB + MG_BB;
DI void merge_unit(Ctx& C, int l, int m0, int n0) {
    const int tid = C.tid, lane = C.lane, wave = C.wave, li = lane & 15, fq = lane >> 4, wr = wave >> 1, wc = wave & 1;
    LASQ unsigned char* L = C.lds;
    f32x4 acc[4][4]; u32x2 tot[4][4];
#pragma unroll
    for (int mt = 0; mt < 4; ++mt)
#pragma unroll
        for (int nt = 0; nt < 4; ++nt) { acc[mt][nt] = (f32x4){0.f, 0.f, 0.f, 0.f}; tot[mt][nt] = (u32x2){0u, 0u}; }
    u32x4 ra[4], ra2[4], rb[2], rb2[2];
    const int srow = tid >> 3, sseg = tid & 7;
    const int psrow = (((srow >> 2) & 3) << 4) | (((srow >> 4) & 3) << 2) | (srow & 3);
#define MG_LOADA(s, dst) do { const int br_ = (s) >> 2, kt_ = (s) & 3; const bf16* yb_ = ybuf(C, br_) + (size_t)m0 * BW + kt_ * 64 + 8 * sseg; \
        _Pragma("unroll") for (int j = 0; j < 4; ++j) dst[j] = *(const u32x4*)(yb_ + (size_t)(srow + 64 * j) * BW); } while (0)
#define MG_LOADB(s, bdst) do { const int br_ = (s) >> 2, kt_ = (s) & 3; const bf16* wb_ = wptr(C, l, WO_WBR) + (size_t)br_ * D * BW + (size_t)n0 * BW + kt_ * 64 + 8 * sseg; \
        _Pragma("unroll") for (int j = 0; j < 2; ++j) bdst[j] = *(const u32x4*)(wb_ + (size_t)(srow + 64 * j) * BW); } while (0)
#define MG_STORE(buf, src, bsrc) do { LASQ unsigned char* sb_ = L + (buf) * MG_STAGE; \
        _Pragma("unroll") for (int j = 0; j < 4; ++j) *(LASQ u32x4*)(sb_ + (srow + 64 * j) * (LT * 2) + sseg * 16) = src[j]; \
        _Pragma("unroll") for (int j = 0; j < 2; ++j) *(LASQ u32x4*)(sb_ + MG_AB + (psrow + 64 * j) * (LT * 2) + sseg * 16) = bsrc[j]; } while (0)
    u32x2 gv[4][4];
#define MG_STEP(s, RCUR, RPRE, BCUR, BPRE) do { const int buf = (s) & 1, br = (s) >> 2, kt = (s) & 3; \
        if (kt == 3) { const bf16* gp = gatep(C) + (size_t)(m0 + 64 * wr + li) * NGATE + br * D + n0 + 64 * wc + 16 * fq; \
            _Pragma("unroll") for (int mt = 0; mt < 4; ++mt) { const u32x4 g0_ = *(const u32x4*)(gp + (size_t)(16 * mt) * NGATE), g1_ = *(const u32x4*)(gp + (size_t)(16 * mt) * NGATE + 8); \
                gv[mt][0] = (u32x2){g0_.x, g0_.y}; gv[mt][1] = (u32x2){g0_.z, g0_.w}; gv[mt][2] = (u32x2){g1_.x, g1_.y}; gv[mt][3] = (u32x2){g1_.z, g1_.w}; } } \
        if ((s) + 2 < 16) MG_LOADB((s) + 2, BPRE); \
        if (kt != 3 && (s) + 2 < 16) MG_LOADA((s) + 2, RPRE); \
        const LASQ unsigned char* AL = L + buf * MG_STAGE; const LASQ unsigned char* BL = AL + MG_AB; \
        _Pragma("unroll 1") for (int ks = 0; ks < 2; ++ks) { bf16x8v af[4], bfr[4]; \
            _Pragma("unroll") for (int mt = 0; mt < 4; ++mt) af[mt] = *(const LASQ bf16x8v*)(AL + (64 * wr + 16 * mt + li) * (LT * 2) + (32 * ks + 8 * fq) * 2); \
            _Pragma("unroll") for (int nt = 0; nt < 4; ++nt) bfr[nt] = *(const LASQ bf16x8v*)(BL + (64 * wc + 16 * nt + li) * (LT * 2) + (32 * ks + 8 * fq) * 2); \
            _Pragma("unroll") for (int mt = 0; mt < 4; ++mt) _Pragma("unroll") for (int nt = 0; nt < 4; ++nt) acc[mt][nt] = MFMA16(bfr[nt], af[mt], acc[mt][nt]); } \
        if (kt == 3) { \
            _Pragma("unroll") for (int mt = 0; mt < 4; ++mt) _Pragma("unroll") for (int nt = 0; nt < 4; ++nt) { const u32x2 g = gv[mt][nt]; const u32x2 t_ = tot[mt][nt]; const f32x4 a = acc[mt][nt]; u32x2 o_; \
                    o_.x = pg8::cvt_pk_bf16(bflo(t_.x) + a[0] * bflo(g.x), bfhi(t_.x) + a[1] * bfhi(g.x)); o_.y = pg8::cvt_pk_bf16(bflo(t_.y) + a[2] * bflo(g.y), bfhi(t_.y) + a[3] * bfhi(g.y)); \
                    tot[mt][nt] = o_; acc[mt][nt] = (f32x4){0.f, 0.f, 0.f, 0.f}; } \
            if ((s) + 2 < 16) MG_LOADA((s) + 2, RPRE); }     \
        if ((s) + 1 < 16) MG_STORE(buf ^ 1, RCUR, BCUR); \
        lds_barrier_(); } while (0)
    MG_LOADB(0, rb); MG_LOADA(0, ra); MG_STORE(0, ra, rb); MG_LOADB(1, rb); MG_LOADA(1, ra); lds_barrier_();
#pragma unroll 1
    for (int s2 = 0; s2 < 16; s2 += 2) { MG_STEP(s2, ra, ra2, rb, rb2); MG_STEP(s2 + 1, ra2, ra, rb2, rb); }
#undef MG_STEP
#undef MG_LOADA
#undef MG_LOADB
#undef MG_STORE
    bf16* op = mrgp(C) + (size_t)(m0 + 64 * wr + li) * D + n0 + 64 * wc + 16 * fq;
#pragma unroll
    for (int mt = 0; mt < 4; ++mt) { *(u32x4*)(op + (size_t)(16 * mt) * D) = (u32x4){tot[mt][0].x, tot[mt][0].y, tot[mt][1].x, tot[mt][1].y}; *(u32x4*)(op + (size_t)(16 * mt) * D + 8) = (u32x4){tot[mt][2].x, tot[mt][2].y, tot[mt][3].x, tot[mt][3].y}; }
}

DI void small_proj_chunk(Ctx& C, int l, int b, int c) {
    const int lane = C.lane, wave = C.wave, li = lane & 15, fq = lane >> 4, mt = wave & 3, kh = wave >> 2; const size_t row0 = (size_t)b * SEQ + (size_t)c * 64;
    LASQ float* red = (LASQ float*)C.lds;
    const bf16* wp = wptr(C, l, WO_WIN) + (size_t)(3072 + li) * D + 512 * kh + 8 * fq; const bf16* hp = Hp(C) + (row0 + 16 * mt + li) * D + 512 * kh + 8 * fq;
    f32x4 acc[2] = {{0.f, 0.f, 0.f, 0.f}, {0.f, 0.f, 0.f, 0.f}};
    const f32x4* sq = (const f32x4*)((const float*)(C.ws + WS_SSQ) + (row0 + 16 * mt + li) * 16); const f32x4 q0 = sq[0], q1 = sq[1], q2 = sq[2], q3 = sq[3];
#pragma unroll 4
    for (int ks = 0; ks < 16; ++ks) { const bf16x8v hb = *(const bf16x8v*)(hp + 32 * ks), w0 = *(const bf16x8v*)(wp + 32 * ks), w1 = *(const bf16x8v*)(wp + (size_t)16 * D + 32 * ks);
        acc[0] = MFMA16(w0, hb, acc[0]); acc[1] = MFMA16(w1, hb, acc[1]); }
    if (kh == 1) { *(LASQ f32x4*)(red + ((mt * 2 + 0) * 64 + lane) * 4) = acc[0]; *(LASQ f32x4*)(red + ((mt * 2 + 1) * 64 + lane) * 4) = acc[1]; }
    __syncthreads();
    if (kh == 0) { float* pr = projp(C) + (row0 + 16 * mt + li) * NP + 3072 + 4 * fq;
        const f32x4 qs = (q0 + q1) + (q2 + q3); const float rs = rsq_(((qs.x + qs.y) + (qs.z + qs.w)) * (1.f / D) + 1e-6f);
#pragma unroll
        for (int nt = 0; nt < 2; ++nt) *(f32x4*)(pr + 16 * nt) = (acc[nt] + *(const LASQ f32x4*)(red + ((mt * 2 + nt) * 64 + lane) * 4)) * rs; }
    __syncthreads();
}

#include <hip/hip_bf16.h>
#include <cmath>
namespace attn_body {
using bf16=__hip_bfloat16;
using bf16x8=__attribute__((ext_vector_type(8)))short;
using s16x4=__attribute__((ext_vector_type(4)))short;
using f32x16=__attribute__((ext_vector_type(16)))float;
using u32x4=__attribute__((ext_vector_type(4)))unsigned;
constexpr int BATCH=4,NHEAD=4,SEQ=4096,D=64,DM=NHEAD*D;
constexpr int NW=8,QBLK=32,QB=QBLK*NW,KVBLK=64,NQB=SEQ/QB;
constexpr int ATTN_PITCH=DM, ATTN_UNIT_ROWS=QB;
__device__ __forceinline__ int crow(int r,int hi){return (r&3)+8*(r>>2)+4*hi;}
#define SBAR() __builtin_amdgcn_sched_barrier(0)
__device__ __forceinline__ void cmask(f32x16&p0,f32x16&p1,int jb,int qrel,int hi){
  const float NEG=-INFINITY; int kb=64*jb+4*hi;
  #pragma unroll
  for(int r=0;r<16;++r){int kv=kb+(r&3)+8*(r>>2); if(kv>qrel)p0[r]=NEG; if(kv+32>qrel)p1[r]=NEG;}
}

constexpr int NSLOT=3, SLOTB=8192;
constexpr int LDS_K=0, LDS_V=NSLOT*SLOTB, LDS_WS=2*NSLOT*SLOTB, LDS_OST=LDS_WS+NW*64*4, LDS_BYTES=LDS_OST+NW*4096;
constexpr float C2=0.125f*1.4426950408889634f;
__device__ __forceinline__ void glds16(const void*gsrc,unsigned lds_dst){unsigned keep;
  asm volatile("s_mov_b32 %0, m0\n\ts_mov_b32 m0, %2\n\ts_nop 0\n\tglobal_load_lds_dwordx4 %1, off\n\ts_mov_b32 m0, %0":"=&s"(keep):"v"(gsrc),"s"(lds_dst):"memory");}
__device__ __forceinline__ float max3f(float a,float b,float c){float r;asm("v_max3_f32 %0, %1, %2, %3":"=v"(r):"v"(a),"v"(b),"v"(c));return r;}
__device__ __forceinline__ float max2f(float a,float b){float r;asm("v_max_f32_e32 %0, %1, %2":"=v"(r):"v"(a),"v"(b));return r;}
__device__ __forceinline__ float fadd_s(float a,float b){float r;asm("v_add_f32_e32 %0, %1, %2":"=v"(r):"v"(a),"v"(b));return r;}
__device__ __forceinline__ float fsub_s(float a,float b){float r;asm("v_sub_f32_e32 %0, %1, %2":"=v"(r):"v"(a),"v"(b));return r;}
typedef float f32x2_t __attribute__((ext_vector_type(2))); typedef __bf16 bf16x2_t __attribute__((ext_vector_type(2)));
__device__ __forceinline__ unsigned cvtpk_s(float lo,float hi){f32x2_t v={lo,hi};bf16x2_t b=__builtin_convertvector(v,bf16x2_t);return __builtin_bit_cast(unsigned,b);}
#define WAIT_BAR(N) asm volatile("s_waitcnt vmcnt(" #N ") lgkmcnt(0)\n\ts_barrier":::"memory")

__device__ __forceinline__ void qkt(f32x16&p0,f32x16&p1,const char*Kslot,const bf16x8*qr,const f32x16&negm,int r32,int hi){
  const char*kb=Kslot+hi*1024+r32*16;
  #pragma unroll
  for(int d0=0;d0<4;++d0){
    const bf16x8 b0=*reinterpret_cast<const bf16x8*>(kb+d0*2048);
    const bf16x8 b1=*reinterpret_cast<const bf16x8*>(kb+d0*2048+512);
    if(d0==0){p0=__builtin_amdgcn_mfma_f32_32x32x16_bf16(b0,qr[0],negm,0,0,0);p1=__builtin_amdgcn_mfma_f32_32x32x16_bf16(b1,qr[0],negm,0,0,0);}
    else{p0=__builtin_amdgcn_mfma_f32_32x32x16_bf16(b0,qr[d0],p0,0,0,0);p1=__builtin_amdgcn_mfma_f32_32x32x16_bf16(b1,qr[d0],p1,0,0,0);}}
}
typedef __attribute__((address_space(3))) const char* lds_cptr;
typedef short v4i16_t __attribute__((ext_vector_type(4)));
__device__ __forceinline__ void kload8(bf16x8*kf,lds_cptr kp){
  kf[0]=*(const __attribute__((address_space(3))) bf16x8*)(kp);      kf[1]=*(const __attribute__((address_space(3))) bf16x8*)(kp+512);
  kf[2]=*(const __attribute__((address_space(3))) bf16x8*)(kp+2048); kf[3]=*(const __attribute__((address_space(3))) bf16x8*)(kp+2560);
  kf[4]=*(const __attribute__((address_space(3))) bf16x8*)(kp+4096); kf[5]=*(const __attribute__((address_space(3))) bf16x8*)(kp+4608);
  kf[6]=*(const __attribute__((address_space(3))) bf16x8*)(kp+6144); kf[7]=*(const __attribute__((address_space(3))) bf16x8*)(kp+6656);
}
__device__ __forceinline__ void kload2(bf16x8*kf,lds_cptr kp,int j){ kf[2*j]=*(const __attribute__((address_space(3))) bf16x8*)(kp+j*2048); kf[2*j+1]=*(const __attribute__((address_space(3))) bf16x8*)(kp+j*2048+512); }
__device__ __forceinline__ s16x4 vtr(lds_cptr p){ return __builtin_bit_cast(s16x4,__builtin_amdgcn_ds_read_tr16_b64_v4i16((__attribute__((address_space(3))) v4i16_t*)p)); }
__device__ __forceinline__ float rowmax(const f32x16&p0,const f32x16&p1){
  float a=max3f(p0[0],p0[1],p1[0]),b=max3f(p0[2],p0[3],p1[1]);a=max3f(a,p1[2],p1[3]);
  #pragma unroll
  for(int r=4;r<16;r+=4){a=max3f(a,p0[r],p0[r+1]);b=max3f(b,p0[r+2],p0[r+3]);a=max3f(a,p1[r],p1[r+1]);b=max3f(b,p1[r+2],p1[r+3]);}
  const float m=max2f(a,b);
  auto rr=__builtin_amdgcn_permlane32_swap(__float_as_uint(m),__float_as_uint(m),false,false);
  return max2f(__uint_as_float(rr[0]),__uint_as_float(rr[1]));
}
__device__ __forceinline__ void pv(f32x16*o,int vb,bf16x8 pa0,bf16x8 pa1,bf16x8 pa2,bf16x8 pa3){
  #pragma unroll
  for(int d0=0;d0<2;++d0){s16x4 lo[4],hi[4];
    #pragma unroll
    for(int ks=0;ks<4;++ks){
      asm volatile("ds_read_b64_tr_b16 %0,%1 offset:%c2":"=&v"(lo[ks]):"v"(vb),"i"(d0*4096+ks*1024):"memory");
      asm volatile("ds_read_b64_tr_b16 %0,%1 offset:%c2":"=&v"(hi[ks]):"v"(vb),"i"(d0*4096+ks*1024+512):"memory");}
    asm volatile("s_waitcnt lgkmcnt(0)":::"memory");SBAR();
    #define PK(k) (bf16x8){lo[k][0],lo[k][1],lo[k][2],lo[k][3],hi[k][0],hi[k][1],hi[k][2],hi[k][3]}
    o[d0]=__builtin_amdgcn_mfma_f32_32x32x16_bf16(pa0,PK(0),o[d0],0,0,0);
    o[d0]=__builtin_amdgcn_mfma_f32_32x32x16_bf16(pa1,PK(1),o[d0],0,0,0);
    o[d0]=__builtin_amdgcn_mfma_f32_32x32x16_bf16(pa2,PK(2),o[d0],0,0,0);
    o[d0]=__builtin_amdgcn_mfma_f32_32x32x16_bf16(pa3,PK(3),o[d0],0,0,0);
    #undef PK
  }
}

#ifndef ATTN_STORE16
#define ATTN_STORE16(p,v) (*(u32x4*)(p)=(v))
#endif
template<int THRL> __device__ __forceinline__ void attn_unit(int b,int h,int qb,const bf16*Q,const bf16*__restrict__ K,const bf16*__restrict__ V,bf16*O,char*shm,unsigned selmask){
  int tid_o=threadIdx.x; asm volatile("":"+v"(tid_o));
  const int tid=tid_o,lane=tid&63,r32=lane&31,hi=lane>>5; const int wid=__builtin_amdgcn_readfirstlane(tid>>6);
  const long rowbase=(long)b*SEQ; const int q0=qb*QB;
  const bf16*Qw=Q+(rowbase+q0+wid*QBLK)*DM+h*D;
  const bf16*Kh=K+rowbase*DM+h*D,*Vh=V+rowbase*DM+h*D;
  const unsigned lds0=(unsigned)(uintptr_t)shm;
  float*wsf=(float*)(shm+LDS_WS)+wid*64;
  const bf16*ksrc=Kh+(long)lane*DM+wid*8;
  const bf16*vsrc=Vh+(long)(16*(wid&3)+(lane>>2))*DM+(wid>>2)*32+(lane&3)*8;
  const unsigned kdst=lds0+LDS_K+wid*1024, vdst=lds0+LDS_V+wid*1024;
  #define DMA_K(t,slot) glds16(ksrc+(long)(t)*KVBLK*DM,(unsigned)__builtin_amdgcn_readfirstlane(kdst+(slot)))
  #define DMA_V(t,slot) glds16(vsrc+(long)(t)*KVBLK*DM,(unsigned)__builtin_amdgcn_readfirstlane(vdst+(slot)))
  const int vb0=(int)(lds0+LDS_V)+((lane>>4)&1)*32+(lane&3)*8+(4*hi+((lane&15)>>2))*64;
  const char*Kbase=shm+LDS_K; bf16x8 kf[8];
  const lds_cptr shm3=(lds_cptr)shm; const lds_cptr kp0=shm3+LDS_K+hi*1024+r32*16; const lds_cptr vp0=shm3+LDS_V+((lane>>4)&1)*32+(lane&3)*8+(4*hi+((lane&15)>>2))*64;
  const int NT=(q0+QB)/KVBLK;
  DMA_K(0,0);DMA_V(0,0);DMA_K(1,SLOTB);
  bf16x8 qr[4];
  #pragma unroll
  for(int d0=0;d0<4;++d0)qr[d0]=*reinterpret_cast<const bf16x8*>(&Qw[(long)r32*DM+d0*16+hi*8]);
  float mhat=0.f,l_reg=0.f;f32x16 o[2];o[0]=f32x16{};o[1]=f32x16{};const f32x16 negm=f32x16{};
  const int qrel=wid*QBLK+r32;
  #define CMASK(P0,P1,t) do{int jb_=(t)-(NT-4); if(jb_>=0)cmask(P0,P1,jb_,qrel,hi); else if(!((selmask>>((t)>>2))&1u)){ _Pragma("unroll") for(int r_=0;r_<16;++r_){P0[r_]=-INFINITY;P1[r_]=-INFINITY;} } }while(0)
  bool resc=false;
  #define START(P0,P1) do{ const float rm=rowmax(P0,P1); resc=false; \
    { const float dl=(rm>-1.0e30f)?rm:0.f; mhat=fadd_s(mhat,dl); \
      _Pragma("unroll") for(int r=0;r<16;++r){P0[r]=fsub_s(P0[r],dl);P1[r]=fsub_s(P1[r],dl);} \
      } \
    _Pragma("unroll") for(int r=0;r<16;++r)P0[r]=__builtin_amdgcn_exp2f(P0[r]); }while(0)
  #define RESC() do{ if(resc){ asm volatile("s_waitcnt lgkmcnt(0)":::"memory"); \
      _Pragma("unroll") for(int d_=0;d_<2;++d_) _Pragma("unroll") for(int r=0;r<16;++r)o[d_][r]*=wsf[crow(r,hi)]; } }while(0)
  f32x16 pA0,pA1,pB0,pB1;
  int sl_prev=0,sl_cur=0,sl_next=SLOTB;
  #define ROT() do{sl_prev=sl_cur;sl_cur=sl_next;sl_next=(sl_next==(NSLOT-1)*SLOTB)?0:sl_next+SLOTB;}while(0)
  DMA_K(2,2*SLOTB);
  WAIT_BAR(3);
  qkt(pA0,pA1,Kbase,qr,negm,r32,hi);asm volatile("s_nop 15\n\ts_nop 7":"+v"(pA0),"+v"(pA1));CMASK(pA0,pA1,0);
  START(pA0,pA1);
  _Pragma("unroll") for(int r=0;r<16;++r)pA1[r]=__builtin_amdgcn_exp2f(pA1[r]);
  WAIT_BAR(0);
  DMA_K(3,0);DMA_V(1,SLOTB);
  ROT();
  kload8(kf,kp0+sl_cur);
  WAIT_BAR(2);
  s16x4 vlo[8],vhi[8]; u32x4 pw0,pw1,pw2,pw3;
  #define PKW(P,B) cvtpk_s(P[B],P[B+1])
  #define PAF(k) __builtin_bit_cast(bf16x8,pw##k)
  #define VFR(i) (bf16x8){vlo[i][0],vlo[i][1],vlo[i][2],vlo[i][3],vhi[i][0],vhi[i][1],vhi[i][2],vhi[i][3]}
  #define PIN(x) asm volatile("":"+v"(x))
  #define MX3(a,b,c) __builtin_fmaxf(__builtin_fmaxf((a),(b)),(c))
  #define GAPA(MF,A0,A1,A2,A3,W0,W1,PW) do{ MF; sacc+=A0; sacc+=A1; sacc+=A2; sacc+=A3; PIN(sacc); W0; W1; PIN(PW); SBAR(); }while(0)
  #define EX(v) __builtin_amdgcn_exp2f(v)
  #define GAPB(MF,X,B) do{ MF; X[B]=EX(X[B]); X[B+1]=EX(X[B+1]); X[B+2]=EX(X[B+2]); X[B+3]=EX(X[B+3]); PIN(X); SBAR(); }while(0)
  #define VRD(i) do{ vlo[i]=vtr(vp_+(((i)>>2)*4096+((i)&3)*1024)); vhi[i]=vtr(vp_+(((i)>>2)*4096+((i)&3)*1024+512)); }while(0)
  #define KRD(G,j) do{ if(G){ kload2(kf,kp0+sl_next,j); SBAR(); } }while(0)
  #define STEP(C0,C1,P0,P1,t,GK,GV,GL) do{ SBAR(); \
    const lds_cptr vp_=vp0+sl_prev; \
    VRD(0); SBAR(); float sacc=(P0[0]+P0[1]); \
    GAPA(C0=__builtin_amdgcn_mfma_f32_32x32x16_bf16(kf[0],qr[0],negm,0,0,0), P0[2],P0[3],P0[4],P0[5],     pw0[0]=PKW(P0,0), pw0[1]=PKW(P0,2), pw0); \
    VRD(4); SBAR(); GAPA(C1=__builtin_amdgcn_mfma_f32_32x32x16_bf16(kf[1],qr[0],negm,0,0,0), P0[6],P0[7],P0[8],P0[9],     pw0[2]=PKW(P0,4), pw0[3]=PKW(P0,6), pw0); \
    VRD(1); SBAR(); GAPA(C0=__builtin_amdgcn_mfma_f32_32x32x16_bf16(kf[2],qr[1],C0,0,0,0),   P0[10],P0[11],P0[12],P0[13], pw1[0]=PKW(P0,8), pw1[1]=PKW(P0,10), pw1); \
    VRD(5); SBAR(); GAPA(C1=__builtin_amdgcn_mfma_f32_32x32x16_bf16(kf[3],qr[1],C1,0,0,0),   P0[14],P0[15],P1[0],P1[1],   pw1[2]=PKW(P0,12),pw1[3]=PKW(P0,14), pw1); \
    VRD(2); SBAR(); GAPA(C0=__builtin_amdgcn_mfma_f32_32x32x16_bf16(kf[4],qr[2],C0,0,0,0),   P1[2],P1[3],P1[4],P1[5],     pw2[0]=PKW(P1,0), pw2[1]=PKW(P1,2), pw2); \
    VRD(6); SBAR(); GAPA(C1=__builtin_amdgcn_mfma_f32_32x32x16_bf16(kf[5],qr[2],C1,0,0,0),   P1[6],P1[7],P1[8],P1[9],     pw2[2]=PKW(P1,4), pw2[3]=PKW(P1,6), pw2); \
    VRD(3); SBAR(); GAPA(C0=__builtin_amdgcn_mfma_f32_32x32x16_bf16(kf[6],qr[3],C0,0,0,0),   P1[10],P1[11],P1[12],P1[13], pw3[0]=PKW(P1,8), pw3[1]=PKW(P1,10), pw3); \
    VRD(7); SBAR(); GAPA(C1=__builtin_amdgcn_mfma_f32_32x32x16_bf16(kf[7],qr[3],C1,0,0,0),   P1[14],P1[15],0.f,0.f,       pw3[2]=PKW(P1,12),pw3[3]=PKW(P1,14), pw3); \
    l_reg+=sacc; \
    if(GK){DMA_K((t)+3,sl_cur);} if(GV){DMA_V((t)+1,sl_next);} \
    _Pragma("unroll") for(int r=0;r<16;++r){C0[r]-=mhat;C1[r]-=mhat;} \
    CMASK(C0,C1,t); \
    { float a=MX3(C0[0],C0[1],C1[0]),b=MX3(C0[2],C0[3],C1[1]); a=MX3(a,C1[2],C1[3]); \
      _Pragma("unroll") for(int r=4;r<16;r+=4){a=MX3(a,C0[r],C0[r+1]);b=MX3(b,C0[r+2],C0[r+3]);a=MX3(a,C1[r],C1[r+1]);b=MX3(b,C1[r+2],C1[r+3]);} \
      float rm=__builtin_fmaxf(a,b); { auto rr=__builtin_amdgcn_permlane32_swap(__float_as_uint(rm),__float_as_uint(rm),false,false); rm=__builtin_fmaxf(__uint_as_float(rr[0]),__uint_as_float(rr[1])); } \
      resc=false; \
      if(__builtin_expect(__any(rm>(float)THRL),0)){ const float dl=__builtin_fmaxf(rm,0.f); mhat+=dl; \
        _Pragma("unroll") for(int r=0;r<16;++r){C0[r]-=dl;C1[r]-=dl;} \
        \
        const float f=__builtin_amdgcn_exp2f(-dl); l_reg*=f; if(hi==0)wsf[r32]=f; resc=true; } } \
    SBAR(); \
    GAPB(o[0]=__builtin_amdgcn_mfma_f32_32x32x16_bf16(PAF(0),VFR(0),o[0],0,0,0), C0,0); \
    GAPB(o[1]=__builtin_amdgcn_mfma_f32_32x32x16_bf16(PAF(0),VFR(4),o[1],0,0,0), C0,4); \
    KRD(GL,0); GAPB(o[0]=__builtin_amdgcn_mfma_f32_32x32x16_bf16(PAF(1),VFR(1),o[0],0,0,0), C0,8); \
    KRD(GL,1); GAPB(o[1]=__builtin_amdgcn_mfma_f32_32x32x16_bf16(PAF(1),VFR(5),o[1],0,0,0), C0,12); \
    KRD(GL,2); GAPB(o[0]=__builtin_amdgcn_mfma_f32_32x32x16_bf16(PAF(2),VFR(2),o[0],0,0,0), C1,0); \
    KRD(GL,3); GAPB(o[1]=__builtin_amdgcn_mfma_f32_32x32x16_bf16(PAF(2),VFR(6),o[1],0,0,0), C1,4); \
    GAPB(o[0]=__builtin_amdgcn_mfma_f32_32x32x16_bf16(PAF(3),VFR(3),o[0],0,0,0), C1,8); \
    GAPB(o[1]=__builtin_amdgcn_mfma_f32_32x32x16_bf16(PAF(3),VFR(7),o[1],0,0,0), C1,12); \
    }while(0)
  int t=1;
  #undef CMASK
  #define CMASK(P0,P1,t) do{ if(!((selmask>>((t)>>2))&1u)){ _Pragma("unroll") for(int r_=0;r_<16;++r_){P0[r_]=-INFINITY;P1[r_]=-INFINITY;} } }while(0)
  for(;t+5<NT;t+=2){
    STEP(pB0,pB1,pA0,pA1,t,true,true,true);     WAIT_BAR(2); RESC(); ROT();
    STEP(pA0,pA1,pB0,pB1,t+1,true,true,true);   WAIT_BAR(2); RESC(); ROT();
  }
  #undef CMASK
  #define CMASK(P0,P1,t) do{int jb_=(t)-(NT-4); if(jb_>=0)cmask(P0,P1,jb_,qrel,hi); else if(!((selmask>>((t)>>2))&1u)){ _Pragma("unroll") for(int r_=0;r_<16;++r_){P0[r_]=-INFINITY;P1[r_]=-INFINITY;} } }while(0)
  #define ENDW(tt) do{ if((tt)+3<NT){WAIT_BAR(2);} else if((tt)+2<NT){WAIT_BAR(1);} else {WAIT_BAR(0);} }while(0)
  for(;t+1<NT;t+=2){
    STEP(pB0,pB1,pA0,pA1,t,(t+3<NT),(t+1<NT),(t+1<NT));       ENDW(t);   RESC(); ROT();
    STEP(pA0,pA1,pB0,pB1,t+1,(t+4<NT),(t+2<NT),(t+2<NT));     ENDW(t+1); RESC(); ROT();
  }
  STEP(pB0,pB1,pA0,pA1,NT-1,false,false,false); RESC();
  { float sacc=pB0[0]+pB0[1]; _Pragma("unroll") for(int r=2;r<16;++r)sacc+=pB0[r]; _Pragma("unroll") for(int r=0;r<16;++r)sacc+=pB1[r]; l_reg+=sacc;
    pw0=(u32x4){PKW(pB0,0),PKW(pB0,2),PKW(pB0,4),PKW(pB0,6)};pw1=(u32x4){PKW(pB0,8),PKW(pB0,10),PKW(pB0,12),PKW(pB0,14)};pw2=(u32x4){PKW(pB1,0),PKW(pB1,2),PKW(pB1,4),PKW(pB1,6)};pw3=(u32x4){PKW(pB1,8),PKW(pB1,10),PKW(pB1,12),PKW(pB1,14)};
    SBAR(); pv(o,vb0+sl_cur,PAF(0),PAF(1),PAF(2),PAF(3)); }
  #undef PKW
  #undef PAF
  #undef VFR
  #undef PIN
  #undef MX3
  #undef GAPA
  #undef GAPB
  #undef EX
  #undef VRD
  #undef KRD
  #undef STEP
  #undef ENDW
  {auto rr=__builtin_amdgcn_permlane32_swap(__float_as_uint(l_reg),__float_as_uint(l_reg),false,false);l_reg=__uint_as_float(rr[0])+__uint_as_float(rr[1]);}
  if(hi==0)wsf[32+r32]=l_reg;asm volatile("s_waitcnt lgkmcnt(0)":::"memory");
  float rli[16];
  #pragma unroll
  for(int r=0;r<16;++r)rli[r]=__builtin_amdgcn_rcpf(wsf[32+crow(r,hi)]);
  bf16*Ow=O+(rowbase+q0+wid*QBLK)*DM+h*D;
  { bf16*stg=(bf16*)(shm+LDS_OST)+wid*2048;
    #pragma unroll
    for(int r=0;r<16;++r){const int orow=crow(r,hi);
      #pragma unroll
      for(int d0=0;d0<2;++d0)stg[orow*64+d0*32+r32]=__float2bfloat16(o[d0][r]*rli[r]);}
    asm volatile("s_waitcnt lgkmcnt(0)":::"memory");
    #pragma unroll
    for(int i=0;i<4;++i){const int row=i*8+(lane>>3),ch=lane&7; const u32x4 v=*(const u32x4*)(stg+row*64+ch*8); ATTN_STORE16(Ow+(long)row*DM+ch*8,v);} }
  asm volatile("s_waitcnt lgkmcnt(0)\n\ts_barrier":::"memory");
  #undef DMA_K
  #undef DMA_V
  #undef CMASK
  #undef START
  #undef RESC
  #undef ROT
}
constexpr int ATTN_LDS_BYTES=LDS_BYTES;
#undef SBAR
#undef WAIT_BAR
}

DI void moba_attn_unit256(Ctx& C, int l, int b, int h, int qb) {
    const int lane = C.lane, wave = C.wave, r32 = lane & 31, hi = lane >> 5;
    unsigned selmask = 0u;
    if (qb > 0) {
        LASQ float* KML = (LASQ float*)(C.lds + 90112);
        const float* ksum = (const float*)(C.ws + MB_KSUM) + (size_t)b * 64 * 256 + h * 64;
        for (int idx = C.tid; idx < qb * 64; idx += 512) { const int n = idx >> 6, d = idx & 63; const float* kp = ksum + (size_t)(4 * n) * 256 + d;
            KML[idx] = (kp[0] + kp[256]) + (kp[512] + kp[768]); }
        const size_t rowq = (size_t)b * SEQ + qb * 256 + wave * 32 + r32;
        const float* mq = tmpbuf(C, T_MQ) + rowq * 256 + h * 64 + 32 * hi;
        f32x4 qg[8];
#pragma unroll
        for (int j = 0; j < 8; ++j) qg[j] = *(const f32x4*)(mq + 4 * j);
        __syncthreads();
        float v1 = -3.0e38f, v2 = -3.0e38f, v3 = -3.0e38f; int i1 = -1, i2 = -1, i3 = -1;
        for (int n = 0; n < qb; ++n) { float g = 0.f;
#pragma unroll
            for (int j = 0; j < 8; ++j) { const f32x4 kv = *(const LASQ f32x4*)(KML + n * 64 + 32 * hi + 4 * j); g += (qg[j].x * kv.x + qg[j].y * kv.y) + (qg[j].z * kv.z + qg[j].w * kv.w); }
            g += __shfl_xor(g, 32);
            if (g > v1) { v3 = v2; i3 = i2; v2 = v1; i2 = i1; v1 = g; i1 = n; } else if (g > v2) { v3 = v2; i3 = i2; v2 = g; i2 = n; } else if (g > v3) { v3 = g; i3 = n; } }
        if (i1 >= 0) selmask |= 1u << i1; if (i2 >= 0) selmask |= 1u << i2; if (i3 >= 0) selmask |= 1u << i3;
        __syncthreads();
    }
    attn_body::attn_unit<8>(b, h, qb, (const attn_body::bf16*)(C.ws + MB_Q), (const attn_body::bf16*)(C.ws + MB_K), (const attn_body::bf16*)(C.ws + MB_VT), (attn_body::bf16*)ybuf(C, 3), (char*)C.lds, selmask);
}

constexpr size_t WS_TOTAL = WS_END6;

constexpr int PH_PER_LAYER = 8, N_PHASES = 1 + 2 * PH_PER_LAYER;
#ifndef MK_ONE_LAUNCH
#define MK_ONE_LAUNCH 1
#endif

__global__ void __launch_bounds__(512, 2) fwd(Args a) {
    extern __shared__ __attribute__((aligned(16))) unsigned char lds_raw[];
    Ctx C;
    C.out = a.out; C.ws = a.ws; C.outb = a.out; C.wsb = a.ws; C.lds = (LASQ unsigned char*)lds_raw;
    C.tid = threadIdx.x; C.lane = C.tid & 63; C.wave = __builtin_amdgcn_readfirstlane(C.tid >> 6);
    C.G = gridDim.x; { const int bx = blockIdx.x; C.vcu = (C.G % 8 == 0) ? (bx % 8) * (C.G / 8) + bx / 8 : bx; }
    C.gw = C.wave * C.G + C.vcu; C.NGW = C.G * 8;
    volatile LASQ unsigned* MISC = (volatile LASQ unsigned*)(C.lds + MISC_OFF);
    if (C.tid < 32) MISC[C.tid] = 0u;
    if (C.tid < 40) *(LASQ unsigned long long*)(C.lds + PTAB_OFF + 8 * C.tid) = (unsigned long long)a.in[C.tid];
    __syncthreads();
    unsigned* ctl = (unsigned*)(a.ws + WS_CTL);
    XcdBarrier bar = xcd_barrier_post(ctl + CW_BAR + a.li * XCD_BAR_WORDS, (volatile LAS unsigned*)(MISC + 8));
    const int lo = a.ph_lo, hi = a.ph_hi; int ph = 0;
    LASQ unsigned char* ring = C.lds;
    const int bid = (int)blockIdx.x;
#ifndef REP_MASK
#define REP_MASK 0
#endif
#define PH_BEGIN(slot) if (ph >= lo && ph < hi) { constexpr int nrep_ = ((REP_MASK >> (slot)) & 1) ? 2 : 1; for (int rep_ = 0; rep_ < nrep_; ++rep_) { refresh(C);
#define PH_END   if (rep_ + 1 < nrep_) xcd_barrier(bar); } if (ph + 1 < hi) xcd_barrier(bar); } ++ph;

    PH_BEGIN(0)
#if !defined(SKIP_PH0)
        if (C.vcu & 1) { for (int u = C.vcu; u < 2 * SB * 32; u += C.G) kmean_unit(C, u / (SB * 32), u % (SB * 32)); }
        prologue(C);
        __syncthreads();
        if (!(C.vcu & 1)) { for (int u = C.vcu; u < 2 * SB * 32; u += C.G) kmean_unit(C, u / (SB * 32), u % (SB * 32)); }
        if (FAST_S5) { LASQ float* scr = (LASQ float*)(C.lds + C.wave * 16384);
            for (int it = C.gw; it < 32 + 64 + (SEQ / 4 + 1); it += C.NGW) { if (it < 32) s5_param_item(C, it);
                else if (it >= 96) rope_item(C, it - 96);
                else { const int r = it - 32, l2 = r >> 5; tr_item<false>(inF(C, 20) + (size_t)l2 * 256 * 256, 256, 256, 256, (bf16*)(C.ws + S5_WGT) + (size_t)l2 * 256 * 256, scr, r & 31, C.lane); } } }
    #endif
    PH_END

    for (int l = 0; l < 2; ++l) {
        PH_BEGIN(1)
#if !defined(SKIP_PH1)
            pg8::StaticOrder S1; S1.init(MP, 3072, C.G, bid); pg8::StaticOrder S2; S2.init(MP, NGATE, C.G, C.G - 1 - bid);
            const int n1 = (MP / 256 * 12 + C.G - 1) / C.G;
            fill_rs(C, S1, 0); fill_rs(C, S2, n1);
            {   LASQ float* red = (LASQ float*)C.lds; const bf16* As = Hp(C) + (size_t)MP * D; const int row = C.tid >> 4, col = C.tid & 15; const float rss = sample_rs(C);
                for (int it = C.vcu; it < NP / 16 + NGATE / 16; it += C.G) {
                    if (it < NP / 16) { const float v = skinny_core(C, As, wptr(C, l, WO_WIN), D, 16 * it, red) * rss; projp(C)[(size_t)(MP + row) * NP + 16 * it + col] = v; }
                    else { const int n0 = 16 * (it - NP / 16); const float v = skinny_core(C, As, wptr(C, l, WO_WG), D, n0, red) * rss; gatep(C)[(size_t)(MP + row) * NGATE + n0 + col] = (bf16)f2bf(sigmoid_(v)); } } }
            { __syncthreads();
              { pg8::Gemm g{Hp(C), wptr(C, l, WO_WIN), MP, 3072, D};     pg8::EpiStoreF32<NP> E{projp(C), (const LASQ float*)(C.lds + RS_OFF), 0};
                pg8::gemm_phase<pg8::EpiStoreF32<NP>, pg8::StaticOrder>(ring, g, S1, E, nullptr); }
              { pg8::Gemm g{Hp(C), wptr(C, l, WO_WG), MP, NGATE, D}; pg8::EpiActBf16<0, NGATE> E{gatep(C), (const LASQ float*)(C.lds + RS_OFF) + n1 * 256, 0};
                pg8::gemm_phase<pg8::EpiActBf16<0, NGATE>, pg8::StaticOrder>(ring, g, S2, E, nullptr); } }
        #endif
    PH_END
        PH_BEGIN(2)
#if !defined(SKIP_PH2)
            for (int m = MP + C.vcu; m < MR; m += C.G) pre_row(C, l, m, (const float*)(C.ws + ROPE_TAB), C.wave);
            __syncthreads();
#ifndef REPS
#define REPS 0
#endif
#define RPT(bit) for (int rr_ = 0; rr_ < (((REPS) >> (bit)) & 1 ? 3 : 1); ++rr_)
            refresh(C);
            for (int u = C.vcu; u < 256; u += C.G) small_proj_chunk(C, l, u >> 6, u & 63);
            refresh(C);
            RPT(1) for (int u = C.vcu; u < 256; u += C.G) moba_prep_chunk(C, l, u >> 6, u & 63, (const float*)(C.ws + ROPE_TAB));
            refresh(C);
            for (int u = C.vcu; u < 256; u += C.G) s5_pass1_chunk(C, l, u >> 6, u & 63);
            refresh(C);
            for (int u = C.vcu; u < 256; u += C.G) gla_prep_chunk(C, l, u >> 6, u & 63);
            refresh(C);
            for (int u = C.vcu; u < 256; u += C.G) gdn_prep_chunk(C, l, u >> 6, u & 63);
            refresh(C);
            refresh(C);

        #endif
    PH_END
        PH_BEGIN(3)
#if !defined(SKIP_PH4)
            {
                constexpr int nD = SB * 16, nShort = SB * 16 + SB * 32 + SB * 32;
                const bool full = (C.G == 256);
                const int qb0 = C.vcu & 15; const bool light = !full || qb0 < 12; const int lidx = full ? (C.vcu >> 4) * 12 + qb0 : C.vcu, nl = full ? 192 : C.G;
                if (light) {
                    if (full) {
                        constexpr int nGen = NB * 256 + NB * 16 + nShort, nWav = 192 * 7 + 128;
                        if (C.wave == 0 && qb0 < 4) gdn_scan_item(C, l, (C.vcu >> 4) * 4 + qb0);
                        else { const int gi = (C.wave >= 1) ? (C.wave - 1) * 192 + lidx : 192 * 7 + (C.vcu >> 4) * 8 + (qb0 - 4);
                            for (int it = gi; it < nGen; it += nWav) { int r = it;
                                if (r < NB * 256) { gla_scan_item(C, l, r); continue; } r -= NB * 256;
                                if (r < NB * 16) { s5_carry_item(C, l, r); continue; } r -= NB * 16;
                                if (r < 512) { gla_naive(C, l, NB + (r >> 5), (r >> 3) & 3, r & 7); continue; } r -= 512;
                                if (r < nD) { s5_naive(C, l, NB + (r >> 4), r & 15, (const float*)(C.ws + S5_P), (bf16*)(C.ws + S5_YSB)); continue; } r -= nD;
                                if (r < 512) { r += 512; gla_naive(C, l, NB + (r >> 5), (r >> 3) & 3, r & 7); continue; } r -= 512;
                                gdn_naive(C, l, NB + (r >> 5), (r >> 3) & 3, r & 7); } }
                    } else {
                        for (int it = C.wave * nl + lidx; it < NB * 16; it += nl * 8) gdn_scan_item(C, l, it);
                        for (int it = lidx * 8 + C.wave; it < NB * 16; it += nl * 8) s5_carry_item(C, l, it);
                        for (int it = lidx * 8 + C.wave; it < NB * 256; it += nl * 8) gla_scan_item(C, l, it);
                        for (int it = C.wave * nl + lidx; it < nShort; it += nl * 8) { int r = it;
                            if (r < 512) { gla_naive(C, l, NB + (r >> 5), (r >> 3) & 3, r & 7); continue; } r -= 512;
                            if (r < nD) { s5_naive(C, l, NB + (r >> 4), r & 15, (const float*)(C.ws + S5_P), (bf16*)(C.ws + S5_YSB)); continue; } r -= nD;
                            if (r < 512) { r += 512; gla_naive(C, l, NB + (r >> 5), (r >> 3) & 3, r & 7); continue; } r -= 512;
                            gdn_naive(C, l, NB + (r >> 5), (r >> 3) & 3, r & 7); }
                    }
                }
                __syncthreads(); refresh(C);
                for (int p = C.vcu; p < 256; p += C.G) { const int qb = p & 15;
                    const int dslot = (qb == 0) ? 0 : (qb == 1) ? 1 : (qb >= 4 && qb <= 8) ? qb - 2 : (qb == 12) ? 7 : -1;
                    if (dslot >= 0) { const int u = (p >> 4) * 8 + dslot; moba_decode_unit(C, l, u >> 2, u & 3); refresh(C); }
                    moba_attn_unit256(C, l, p >> 6, (p >> 4) & 3, qb); }
            }
#endif
    PH_END
        PH_BEGIN(4)
#if !defined(SKIP_PH5)
            for (int m = MP + C.vcu; m < MR; m += C.G) post_row(C, l, m, C.wave);
            {   LASQ float* red = (LASQ float*)C.lds; const int row = C.tid >> 4, col = C.tid & 15;
                for (int it = C.vcu; it < BW / 16; it += C.G) { const float v = skinny_core(C, (const bf16*)(C.ws + S5_YSB), (const bf16*)(C.ws + S5_WGT) + (size_t)l * 256 * 256, BW, 16 * it, red);
                    const int n = 16 * it + col; ybuf(C, 0)[(size_t)(MP + row) * 256 + n] = (bf16)f2bf(tmpbuf(C, T_YPRE)[(size_t)(MP + row) * 256 + n] * sigmoid_(v + inF(C, 21)[l * 256 + n])); } }
            refresh(C);
            if (FAST_S5) { for (int u = C.vcu; u < 256; u += C.G) s5_out_chunk(C, l, u >> 6, u & 63); }
            refresh(C);
            if (FAST_GLA) { for (int u = C.vcu; u < 256; u += C.G) gla_out_chunk(C, l, u >> 6, u & 63); }
            refresh(C);
            if (FAST_GDN) { for (int u = C.vcu; u < 256; u += C.G) gdn_out_chunk(C, l, u >> 6, u & 63); }
        #endif
    PH_END
        PH_BEGIN(5)
#if !defined(SKIP_PH6)
            {   LASQ float* red = (LASQ float*)C.lds; const int row = C.tid >> 4, col = C.tid & 15;
                for (int it = C.vcu; it < D / 16; it += C.G) skinny_merge_item(C, l, 16 * it, red); (void)row; (void)col; }
            refresh(C);
            for (int u = C.vcu; u < (MP / 256) * (D / 128); u += C.G) merge_unit(C, l, (u >> 3) * 256, (u & 7) * 128);
#endif
    PH_END
        PH_BEGIN(6)
#if !defined(SKIP_PH7)
            { const float* xin_p = (l == 0) ? inF(C, 0) : X2p(C); const float* xin_s = (l == 0) ? inF(C, 1) : X2p(C) + (size_t)MP * D;
              {   LASQ float* red = (LASQ float*)C.lds; const int row = C.tid >> 4, col = C.tid & 15;
                  for (int it = C.vcu; it < D / 16; it += C.G) { const float v = xin_s[(size_t)row * D + 16 * it + col] + skinny_core(C, mrgp(C) + (size_t)MP * D, wptr(C, l, WO_WOUT), D, 16 * it, red);
                      X1p(C)[(size_t)(MP + row) * D + 16 * it + col] = v; Hp(C)[(size_t)(MP + row) * D + 16 * it + col] = (bf16)f2bf(v);
                      float s = v * v; s += __shfl_xor(s, 1); s += __shfl_xor(s, 2); s += __shfl_xor(s, 4); s += __shfl_xor(s, 8); if (col == 0) ((float*)(C.ws + WS_SSQS))[row * 64 + it] = s; } }
              pg8::Gemm g{mrgp(C), wptr(C, l, WO_WOUT), MP, D, D}; pg8::StaticOrder S; S.init(MP, D, C.G, bid); pg8::EpiRes E{xin_p, X1p(C), (pg8::bf16_t*)Hp(C), (float*)(C.ws + WS_SSQ)};
              pg8::gemm_phase<pg8::EpiRes, pg8::StaticOrder>(ring, g, S, E, nullptr); }
        #endif
    PH_END
        PH_BEGIN(7)
#if !defined(SKIP_PH9)
            pg8::StaticOrder SH; SH.init(MP, DFF, C.G, bid); fill_rs(C, SH, 0);
            {   LASQ float* red = (LASQ float*)C.lds; const int row = C.tid >> 4, col = C.tid & 15; const float rss = sample_rs(C);
                for (int it = C.vcu; it < DFF / 16; it += C.G) { const float v = fmaxf(skinny_core(C, Hp(C) + (size_t)MP * D, wptr(C, l, WO_FF1), D, 16 * it, red) * rss, 0.f);
                    Zp(C)[(size_t)(MP + row) * DFF + 16 * it + col] = (bf16)f2bf(v * v); } }
            { pg8::Gemm g{Hp(C), wptr(C, l, WO_FF1), MP, DFF, D}; const pg8::StaticOrder& S = SH; __syncthreads();
              pg8::EpiActBf16<1, DFF> E{Zp(C), (const LASQ float*)(C.lds + RS_OFF), 0};
              pg8::gemm_phase<pg8::EpiActBf16<1, DFF>, pg8::StaticOrder>(ring, g, S, E, nullptr); }
        #endif
    PH_END
        PH_BEGIN(8)
#if !defined(SKIP_PH10)
            { float* xout_p = (l == 0) ? X2p(C) : C.out + O_YP; float* xout_s = (l == 0) ? X2p(C) + (size_t)MP * D : C.out + O_YS;
              {   LASQ float* red = (LASQ float*)C.lds; const int row = C.tid >> 4, col = C.tid & 15;
                  for (int it = C.vcu; it < D / 16; it += C.G) { const float v = X1p(C)[(size_t)(MP + row) * D + 16 * it + col] + skinny_core(C, Zp(C) + (size_t)MP * DFF, wptr(C, l, WO_FF2), DFF, 16 * it, red);
                      xout_s[(size_t)row * D + 16 * it + col] = v;
                      if (l == 0) { Hp(C)[(size_t)(MP + row) * D + 16 * it + col] = (bf16)f2bf(v);
                          float s = v * v; s += __shfl_xor(s, 1); s += __shfl_xor(s, 2); s += __shfl_xor(s, 4); s += __shfl_xor(s, 8); if (col == 0) ((float*)(C.ws + WS_SSQS))[row * 64 + it] = s; } } }
              pg8::Gemm g{Zp(C), wptr(C, l, WO_FF2), MP, D, DFF}; pg8::StaticOrder S; S.init(MP, D, C.G, bid); pg8::EpiRes E{X1p(C), xout_p, (l == 0) ? (pg8::bf16_t*)Hp(C) : (pg8::bf16_t*)nullptr, (float*)(C.ws + WS_SSQ)};
              pg8::gemm_phase<pg8::EpiRes, pg8::StaticOrder>(ring, g, S, E, nullptr); }
        #endif
    PH_END
    }
#undef PH_BEGIN
#undef PH_END
}

extern "C" void kernel_launch(void* const* d_in, const int* in_sizes, int n_in, void* d_out, int out_size, void* d_ws, size_t ws_size, hipStream_t stream) {
    static int grid = 0;
    if (grid == 0) {
        if (n_in != 40 || out_size != (int)O_END || ws_size < WS_TOTAL) { fprintf(stderr, "kernel_launch: unexpected shapes: n_in %d out %d ws %zu (need %zu)\n", n_in, out_size, ws_size, (size_t)WS_TOTAL); grid = -1; return; }
        int dev = 0, cus = 0, per_cu = 0;
        if (hipGetDevice(&dev) != hipSuccess || hipDeviceGetAttribute(&cus, hipDeviceAttributeMultiprocessorCount, dev) != hipSuccess) { grid = -1; return; }
        if (hipFuncSetAttribute((const void*)fwd, hipFuncAttributeMaxDynamicSharedMemorySize, LDS_BYTES) != hipSuccess) { fprintf(stderr, "kernel_launch: hipFuncSetAttribute failed\n"); grid = -1; return; }
        if (hipOccupancyMaxActiveBlocksPerMultiprocessor(&per_cu, (const void*)fwd, 512, LDS_BYTES) != hipSuccess || per_cu < 1) fprintf(stderr, "kernel_launch: occupancy query reports %d\n", per_cu);
        (void)hipGetLastError();
        grid = cus;
    }
    if (grid < 0) return;
    if (hipMemsetAsync((char*)d_ws + WS_CTL, 0, MK_ONE_LAUNCH ? (size_t)32768 : CTL_BYTES, stream) != hipSuccess) return;
    Args a{};
    for (int i = 0; i < 40; ++i) a.in[i] = d_in[i];
    a.out = (float*)d_out; a.ws = (unsigned char*)d_ws; a.pad = 0;
#if MK_ONE_LAUNCH
    a.ph_lo = 0; a.ph_hi = N_PHASES; a.li = 0;
    hipLaunchKernelGGL(fwd, dim3(grid), dim3(512), LDS_BYTES, stream, a);
#else
    for (int p = 0; p < N_PHASES; ++p) { a.ph_lo = p; a.ph_hi = p + 1; a.li = p; hipLaunchKernelGGL(fwd, dim3(grid), dim3(512), LDS_BYTES, stream, a); }
#endif
}
```

```cpp
#include <hip/hip_runtime.h>
#include <cstdio>
#include <cstdint>
namespace pg8 {
#define PG8_LAS __attribute__((address_space(3)))
typedef unsigned short bf16_t;
typedef short bf16x8 __attribute__((ext_vector_type(8)));
typedef float f32x4 __attribute__((ext_vector_type(4)));
typedef unsigned u32x4 __attribute__((ext_vector_type(4)));
constexpr int BM = 256, BK = 64, HALF = 128, HTB = HALF * BK * 2  , STAGE_BYTES = 8 * HTB, NXCD = 8, WGM = 8;

__host__ __device__ __forceinline__ int lds_byte(int r, int c) { const int st = (r >> 4) * 2 + (c >> 5), rr = r & 15, cc = c & 31, ob = rr * 64 + cc * 2; return st * 1024 + (ob ^ (((ob >> 9) & 1) << 5)); }
__host__ __device__ __forceinline__ void stage_rc(int b, int& R, int& C) { const int st = b / 1024, sb = b % 1024, swz = sb ^ (((sb >> 9) & 1) << 5); R = (st >> 1) * 16 + swz / 64; C = (st & 1) * 32 + (swz % 64) / 2; }
__host__ __device__ __forceinline__ int perm32(int rho) { const int n = rho >> 4, i = rho & 15; return 8 * (i >> 2) + 4 * n + (i & 3); }

struct Unit { int pm, pn; };
struct Gemm { const bf16_t* A; const bf16_t* Bt; int M, N, K; };

struct StaticOrder {
    int nM, nN, nwg, G, c;
    __host__ __device__ void init(int M, int N, int G_, int c_) { nM = M / BM; nN = N / BM; nwg = nM * nN; G = G_; c = c_; }
    __host__ __device__ bool next(int i, Unit& u) const {
        const long L = (long)i * G + c; if (L >= nwg) return false;
        int wgid = (int)L; { const int q = nwg / NXCD, r = nwg % NXCD, xcd = wgid % NXCD, off = wgid / NXCD; wgid = (xcd < r ? xcd * (q + 1) : r * (q + 1) + (xcd - r) * q) + off; }
        const int nig = WGM * nN, gid = wgid / nig, fm = gid * WGM, gsz = (nM - fm) < WGM ? (nM - fm) : WGM;
        u.pm = fm + ((wgid % nig) % gsz); u.pn = (wgid % nig) / gsz; return true;
    }
    __device__ __forceinline__ void a_ready(const Unit&) const {}
    __device__ __forceinline__ void done(const Unit&) const {}
};
struct CountedOrder : StaticOrder {
    const unsigned* ready; unsigned need; unsigned* tmo;
    __device__ __forceinline__ void a_ready(const Unit& u) const {
        if (threadIdx.x < 64) {
            const unsigned long long t0 = __builtin_amdgcn_s_memrealtime(); unsigned polls = 0;
            while ((unsigned)__builtin_amdgcn_readfirstlane(__hip_atomic_load(ready + 64 * u.pm, __ATOMIC_RELAXED, __HIP_MEMORY_SCOPE_AGENT)) < need) {
                if ((++polls & 255u) == 0u && __builtin_amdgcn_readfirstlane(__hip_atomic_load(tmo, __ATOMIC_RELAXED, __HIP_MEMORY_SCOPE_AGENT)) != 0u) break;
                if (__builtin_amdgcn_s_memrealtime() - t0 > 2000000ull) {
                    if (threadIdx.x == 0) { unsigned expect = 0u; __hip_atomic_compare_exchange_strong(tmo + 1, &expect, 0x600u | (unsigned)(u.pm & 0xff), __ATOMIC_RELAXED, __ATOMIC_RELAXED, __HIP_MEMORY_SCOPE_AGENT); __hip_atomic_store(tmo, 1u, __ATOMIC_RELAXED, __HIP_MEMORY_SCOPE_AGENT); }
                    break; }
                __builtin_amdgcn_s_sleep(2); }
            __builtin_amdgcn_fence(__ATOMIC_ACQUIRE, "agent");
            asm volatile("s_waitcnt vmcnt(0)" ::: "memory");
        }
#if !defined(BROKEN_HOOK_NO_BARRIER)
        asm volatile("" ::: "memory"); __builtin_amdgcn_s_barrier(); asm volatile("" ::: "memory");
#endif
    }
};

__device__ __forceinline__ unsigned cvt_pk_bf16(float lo, float hi) { unsigned r; asm volatile("v_cvt_pk_bf16_f32 %0, %1, %2" : "=v"(r) : "v"(lo), "v"(hi)); return r; }
typedef float f32x2 __attribute__((ext_vector_type(2)));
__device__ __forceinline__ f32x2 gelu_pk(f32x2 v) {
    const f32x2 av = __builtin_elementwise_abs(v), d = av * 0.2316418882f + 1.0f;
    f32x2 t; t.x = __builtin_amdgcn_rcpf(d.x); t.y = __builtin_amdgcn_rcpf(d.y);
    f32x2 q = t * 0.5307027145f + (-0.7265760135f); q = q * t + 0.7107068705f; q = q * t + (-0.142248368f); q = q * t + 0.127414796f; q = q * t;
    const f32x2 s = (v * v) * (-0.72134752044f);
    f32x2 e; e.x = __builtin_amdgcn_exp2f(s.x); e.y = __builtin_amdgcn_exp2f(s.y);
    const f32x2 m = v * (q * e), r = v - m;
    f32x2 o; o.x = v.x < 0.f ? m.x : r.x; o.y = v.y < 0.f ? m.y : r.y; return o;
}

struct EpiF32 {
    static constexpr bool PERM = false, AFTER_DRAIN = false;
    float* C; int ldc; const float* bias;
    __device__ __forceinline__ void operator()(const f32x4 (&acc)[2][2][4][2], const Unit& u, int wr, int wc, int fr, int fq) const {
        const int row0 = u.pm * BM + wr * 64 + fr, col0 = u.pn * BM + wc * 32 + 4 * fq;
        f32x4 bv[2][2];
#pragma unroll
        for (int bj = 0; bj < 2; ++bj)
#pragma unroll
            for (int n = 0; n < 2; ++n) bv[bj][n] = bias ? *(const f32x4*)(bias + col0 + bj * HALF + n * 16) : (f32x4){0.f, 0.f, 0.f, 0.f};
#pragma unroll
        for (int ai = 0; ai < 2; ++ai)
#pragma unroll
            for (int m = 0; m < 4; ++m) { float* rowp = C + (size_t)(row0 + ai * HALF + m * 16) * ldc + col0;
#pragma unroll
                for (int bj = 0; bj < 2; ++bj)
#pragma unroll
                    for (int n = 0; n < 2; ++n) *(f32x4*)(rowp + bj * HALF + n * 16) = acc[ai][bj][m][n] + bv[bj][n]; }
    }
};
template <int ACT  > struct EpiBf16 {
    static constexpr bool PERM = true, AFTER_DRAIN = false;
    bf16_t* O; int ldc; const float* bias; int split_cols; size_t split_stride;
    __device__ __forceinline__ void operator()(const f32x4 (&acc)[2][2][4][2], const Unit& u, int wr, int wc, int fr, int fq) const {
        const int row0 = u.pm * BM + wr * 64 + fr; int colt = u.pn * BM; bf16_t* base = O;
        if (split_cols) { const int t = colt / split_cols; base += (size_t)t * split_stride; colt -= t * split_cols; }
        const int col0 = colt + wc * 32 + 8 * fq, bcol0 = u.pn * BM + wc * 32 + 8 * fq;
        f32x4 bv[2][2];
#pragma unroll
        for (int bj = 0; bj < 2; ++bj)
#pragma unroll
            for (int n = 0; n < 2; ++n) bv[bj][n] = bias ? *(const f32x4*)(bias + bcol0 + bj * HALF + 4 * n) : (f32x4){0.f, 0.f, 0.f, 0.f};
#pragma unroll
        for (int ai = 0; ai < 2; ++ai)
#pragma unroll
            for (int m = 0; m < 4; ++m) { bf16_t* rowp = base + (size_t)(row0 + ai * HALF + m * 16) * ldc + col0;
#pragma unroll
                for (int bj = 0; bj < 2; ++bj) { f32x4 v0 = acc[ai][bj][m][0] + bv[bj][0], v1 = acc[ai][bj][m][1] + bv[bj][1];
                    if (ACT == 1) { f32x2 a = gelu_pk((f32x2){v0[0], v0[1]}), b = gelu_pk((f32x2){v0[2], v0[3]}), c = gelu_pk((f32x2){v1[0], v1[1]}), d = gelu_pk((f32x2){v1[2], v1[3]});
                        v0 = (f32x4){a.x, a.y, b.x, b.y}; v1 = (f32x4){c.x, c.y, d.x, d.y}; }
                    if (ACT == 2) {
#pragma unroll
                        for (int j = 0; j < 4; ++j) { v0[j] = 0.5f * v0[j] * (1.0f + erff(v0[j] * 0.70710678f)); v1[j] = 0.5f * v1[j] * (1.0f + erff(v1[j] * 0.70710678f)); } }
                    u32x4 w; w.x = cvt_pk_bf16(v0[0], v0[1]); w.y = cvt_pk_bf16(v0[2], v0[3]); w.z = cvt_pk_bf16(v1[0], v1[1]); w.w = cvt_pk_bf16(v1[2], v1[3]);
                    *(u32x4*)(rowp + bj * HALF) = w; } }
    }
};

struct PanelStats {
    unsigned* xbuf;
    unsigned* cnt;
    unsigned* tmo;
    int ntn; float eps;
    unsigned code;
    __device__ __forceinline__ bool run(const f32x4 (&v)[2][2][4][2], const Unit& u, int wr, int wc, int fr, int fq, PG8_LAS unsigned char* lds, int wid, int lane) const {
        typedef float f32x2v __attribute__((ext_vector_type(2)));
        PG8_LAS f32x2v* P = (PG8_LAS f32x2v*)lds;
        PG8_LAS f32x2v* S = (PG8_LAS f32x2v*)(lds + 8192);
        PG8_LAS unsigned* flag = (PG8_LAS unsigned*)(lds + 8192 + 2048);
#pragma unroll
        for (int ai = 0; ai < 2; ++ai)
#pragma unroll
            for (int m = 0; m < 4; ++m) {
                float s = 0.f;
#pragma unroll
                for (int bj = 0; bj < 2; ++bj)
#pragma unroll
                    for (int n = 0; n < 2; ++n) { const f32x4 x = v[ai][bj][m][n]; s += (x[0] + x[1]) + (x[2] + x[3]); }
                s += __shfl_xor(s, 16); s += __shfl_xor(s, 32);
                const float mw = s * (1.0f / 64.0f); float q = 0.f;
#pragma unroll
                for (int bj = 0; bj < 2; ++bj)
#pragma unroll
                    for (int n = 0; n < 2; ++n) { const f32x4 d = v[ai][bj][m][n] - mw; q += (d[0] * d[0] + d[1] * d[1]) + (d[2] * d[2] + d[3] * d[3]); }
                q += __shfl_xor(q, 16); q += __shfl_xor(q, 32);
                if (fq == 0) P[(ai * HALF + wr * 64 + m * 16 + fr) * 4 + wc] = (f32x2v){mw, q};
            }
        asm volatile("s_waitcnt lgkmcnt(0)" ::: "memory"); __builtin_amdgcn_s_barrier(); asm volatile("" ::: "memory");
#if defined(BROKEN_NO_WAIT)
        if (blockIdx.x >= 64) { const long long t0 = clock64(); while (clock64() - t0 < 60000) __builtin_amdgcn_s_sleep(8); }
#endif
        const int row = wid * 32 + (lane & 31);
        if (lane < 32) {
            const f32x2v a = P[row * 4 + 0], b = P[row * 4 + 1], c = P[row * 4 + 2], d = P[row * 4 + 3];
            const float mt = (a.x + b.x + c.x + d.x) * 0.25f;
            const float da = a.x - mt, db = b.x - mt, dc = c.x - mt, dd = d.x - mt;
            const float m2 = (a.y + b.y) + (c.y + d.y) + 64.0f * ((da * da + db * db) + (dc * dc + dd * dd));
            unsigned long long* slot = (unsigned long long*)xbuf + ((size_t)(u.pm * BM + row) * 4 + u.pn);
            __hip_atomic_store(slot, ((unsigned long long)__float_as_uint(m2) << 32) | __float_as_uint(mt), __ATOMIC_RELAXED, __HIP_MEMORY_SCOPE_AGENT);
        }
        asm volatile("s_waitcnt vmcnt(0)" ::: "memory");
        if (lane == 0) __hip_atomic_fetch_add(cnt + 64 * u.pm, 1u, __ATOMIC_RELAXED, __HIP_MEMORY_SCOPE_AGENT);
        if (wid == 0) {
            bool dead = false; const unsigned long long t0 = __builtin_amdgcn_s_memrealtime(); const unsigned want = 8u * (unsigned)ntn;
            for (;;) {
#if defined(BROKEN_NO_WAIT)
                break;
#endif
                if ((unsigned)__builtin_amdgcn_readfirstlane(__hip_atomic_load(cnt + 64 * u.pm, __ATOMIC_RELAXED, __HIP_MEMORY_SCOPE_AGENT)) >= want) break;
                if (__builtin_amdgcn_s_memrealtime() - t0 > 2000000ull) {
                    if (lane == 0) { unsigned expect = 0u; __hip_atomic_compare_exchange_strong(tmo + 1, &expect, code | (unsigned)(u.pm & 0xff), __ATOMIC_RELAXED, __ATOMIC_RELAXED, __HIP_MEMORY_SCOPE_AGENT);
                                     __hip_atomic_store(tmo, 1u, __ATOMIC_RELAXED, __HIP_MEMORY_SCOPE_AGENT); }
                    dead = true; break; }
                __builtin_amdgcn_s_sleep(2);
            }
            __builtin_amdgcn_fence(__ATOMIC_ACQUIRE, "agent");
            if (lane == 0) flag[0] = dead ? 1u : 0u;
        }
        asm volatile("s_waitcnt vmcnt(0) lgkmcnt(0)" ::: "memory"); __builtin_amdgcn_s_barrier(); asm volatile("" ::: "memory");
        const bool bad = flag[0] != 0u;
        if (lane < 32) {
            const unsigned long long* slot = (const unsigned long long*)xbuf + (size_t)(u.pm * BM + row) * 4; float mt[4], m2[4]; float ms = 0.f;
#pragma unroll
            for (int t = 0; t < 4; ++t) { if (t < ntn) { const unsigned long long w = __hip_atomic_load(slot + t, __ATOMIC_RELAXED, __HIP_MEMORY_SCOPE_AGENT); mt[t] = __uint_as_float((unsigned)w); m2[t] = __uint_as_float((unsigned)(w >> 32)); } else { mt[t] = 0.f; m2[t] = 0.f; } ms += mt[t]; }
            const float mean = ms / (float)ntn; float q = 0.f;
#pragma unroll
            for (int t = 0; t < 4; ++t) if (t < ntn) { const float dm = mt[t] - mean; q += m2[t] + 256.0f * dm * dm; }
            S[row] = (f32x2v){mean, 1.0f / sqrtf(q / (256.0f * (float)ntn) + eps)};
        }
        asm volatile("s_waitcnt lgkmcnt(0)" ::: "memory"); __builtin_amdgcn_s_barrier(); asm volatile("" ::: "memory");
        return bad;
    }
};
struct EpiLnRes {
    static constexpr bool PERM = false, AFTER_DRAIN = true;
    const float* base; float* out; int ldc; const float* bias; PanelStats st; unsigned poison;
    __device__ __forceinline__ void refuse(size_t i0, size_t stride, int M, int N) const { const float q = __builtin_nanf(""); for (size_t i = i0; i < (size_t)M * N; i += stride) out[(i / N) * ldc + i % N] = q;
        if (i0 == 0) { unsigned expect = 0u; __hip_atomic_compare_exchange_strong(st.tmo + 1, &expect, 0x7f0u, __ATOMIC_RELAXED, __ATOMIC_RELAXED, __HIP_MEMORY_SCOPE_AGENT); __hip_atomic_store(st.tmo, 1u, __ATOMIC_RELAXED, __HIP_MEMORY_SCOPE_AGENT); } }
    __device__ __forceinline__ void fused(f32x4 (&acc)[2][2][4][2], const Unit& u, int wr, int wc, int fr, int fq, PG8_LAS unsigned char* lds, int wid, int lane) const {
        typedef float f32x2v __attribute__((ext_vector_type(2)));
        const PG8_LAS f32x2v* S = (const PG8_LAS f32x2v*)(lds + 8192);
        const int col0 = u.pn * BM + wc * 32 + 4 * fq;
#pragma unroll
        for (int bj = 0; bj < 2; ++bj)
#pragma unroll
            for (int n = 0; n < 2; ++n) { const f32x4 bv = bias ? *(const f32x4*)(bias + col0 + bj * HALF + n * 16) : (f32x4){0.f, 0.f, 0.f, 0.f};
#pragma unroll
                for (int ai = 0; ai < 2; ++ai)
#pragma unroll
                    for (int m = 0; m < 4; ++m) acc[ai][bj][m][n] += bv; }
        const bool bad = st.run(acc, u, wr, wc, fr, fq, lds, wid, lane) || poison != 0u;
        const float qnan = __builtin_nanf("");
#pragma unroll
        for (int ai = 0; ai < 2; ++ai)
#pragma unroll
            for (int m = 0; m < 4; ++m) { const int r = ai * HALF + wr * 64 + m * 16 + fr; const f32x2v sr = S[r]; const size_t off = (size_t)(u.pm * BM + r) * ldc + col0;
#pragma unroll
                for (int bj = 0; bj < 2; ++bj)
#pragma unroll
                    for (int n = 0; n < 2; ++n) { const f32x4 bs = *(const f32x4*)(base + off + bj * HALF + n * 16); f32x4 o = bs + (acc[ai][bj][m][n] - sr.x) * sr.y;
                        if (bad) o = (f32x4){qnan, qnan, qnan, qnan}; *(f32x4*)(out + off + bj * HALF + n * 16) = o; }
                asm volatile("" ::: "memory"); }
    }
};
struct EpiLnResLn {
    static constexpr bool PERM = false, AFTER_DRAIN = true;
    const float* base; float* out; bf16_t* xn; int ldc; const float* bias; PanelStats st1, st2; unsigned poison;
    __device__ __forceinline__ void refuse(size_t i0, size_t stride, int M, int N) const { const float q = __builtin_nanf(""); for (size_t i = i0; i < (size_t)M * N; i += stride) { const size_t o = (i / N) * ldc + i % N; out[o] = q; xn[o] = (bf16_t)0x7fc0u; }
        if (i0 == 0) { unsigned expect = 0u; __hip_atomic_compare_exchange_strong(st1.tmo + 1, &expect, 0x7f0u, __ATOMIC_RELAXED, __ATOMIC_RELAXED, __HIP_MEMORY_SCOPE_AGENT); __hip_atomic_store(st1.tmo, 1u, __ATOMIC_RELAXED, __HIP_MEMORY_SCOPE_AGENT); } }
    __device__ __forceinline__ void fused(f32x4 (&acc)[2][2][4][2], const Unit& u, int wr, int wc, int fr, int fq, PG8_LAS unsigned char* lds, int wid, int lane) const {
        typedef float f32x2v __attribute__((ext_vector_type(2))); typedef unsigned u32x2v __attribute__((ext_vector_type(2)));
        const PG8_LAS f32x2v* S = (const PG8_LAS f32x2v*)(lds + 8192);
        const int col0 = u.pn * BM + wc * 32 + 4 * fq;
#pragma unroll
        for (int bj = 0; bj < 2; ++bj)
#pragma unroll
            for (int n = 0; n < 2; ++n) { const f32x4 bv = bias ? *(const f32x4*)(bias + col0 + bj * HALF + n * 16) : (f32x4){0.f, 0.f, 0.f, 0.f};
#pragma unroll
                for (int ai = 0; ai < 2; ++ai)
#pragma unroll
                    for (int m = 0; m < 4; ++m) acc[ai][bj][m][n] += bv; }
        bool bad = st1.run(acc, u, wr, wc, fr, fq, lds, wid, lane) || poison != 0u;
        const float qnan = __builtin_nanf("");
#pragma unroll
        for (int ai = 0; ai < 2; ++ai)
#pragma unroll
            for (int m = 0; m < 4; ++m) { const int r = ai * HALF + wr * 64 + m * 16 + fr; const f32x2v sr = S[r]; const size_t off = (size_t)(u.pm * BM + r) * ldc + col0;
#pragma unroll
                for (int bj = 0; bj < 2; ++bj)
#pragma unroll
                    for (int n = 0; n < 2; ++n) { const f32x4 bs = *(const f32x4*)(base + off + bj * HALF + n * 16); acc[ai][bj][m][n] = bs + (acc[ai][bj][m][n] - sr.x) * sr.y; }
                asm volatile("" : "+v"(acc[ai][0][m][0]), "+v"(acc[ai][0][m][1]), "+v"(acc[ai][1][m][0]), "+v"(acc[ai][1][m][1]));
                if (m & 1) asm volatile("" ::: "memory"); }
        const bool bad1 = bad;
        bad = st2.run(acc, u, wr, wc, fr, fq, lds, wid, lane) || bad;
#pragma unroll
        for (int ai = 0; ai < 2; ++ai)
#pragma unroll
            for (int m = 0; m < 4; ++m) { const int r = ai * HALF + wr * 64 + m * 16 + fr; const f32x2v sr = S[r]; const size_t off = (size_t)(u.pm * BM + r) * ldc + col0;
#pragma unroll
                for (int bj = 0; bj < 2; ++bj)
#pragma unroll
                    for (int n = 0; n < 2; ++n) { const f32x4 x1 = acc[ai][bj][m][n]; *(f32x4*)(out + off + bj * HALF + n * 16) = bad1 ? (f32x4){qnan, qnan, qnan, qnan} : x1;
                        const f32x4 o = (x1 - sr.x) * sr.y; u32x2v w; w.x = cvt_pk_bf16(o[0], o[1]); w.y = cvt_pk_bf16(o[2], o[3]);
                        if (bad) { w.x = 0x7fc07fc0u; w.y = 0x7fc07fc0u; } *(u32x2v*)(xn + off + bj * HALF + n * 16) = w; }
                asm volatile("" ::: "memory"); }
    }
};

template <class Epi, class Sched, bool STAMP = false>
__device__ __forceinline__ void gemm_phase(PG8_LAS unsigned char* lds, const Gemm g, const Sched& S, const Epi& E, unsigned long long* stamps) {
    int tid_o = threadIdx.x; asm volatile("" : "+v"(tid_o));
    const int tid = tid_o, wid = __builtin_amdgcn_readfirstlane(tid >> 6), lane = tid & 63, wr = wid >> 2, wc = wid & 3, fr = lane & 15, fq = lane >> 4;
    const int K = g.K, nt = K / BK;
    int ts_lo = 0, ts_hi = 0, nts = 0; const unsigned long long rt_entry = STAMP ? (unsigned long long)wall_clock64() : 0ull;
#define PG8_STAMP() do { if (STAMP && wid == 0 && nts < 64) { const unsigned long long _c = (unsigned long long)clock64(); \
        ts_lo = (lane == nts) ? (int)(unsigned)_c : ts_lo; ts_hi = (lane == nts) ? (int)(unsigned)(_c >> 32) : ts_hi; ++nts; } } while (0)
    PG8_STAMP();
    unsigned voffA[2], voffB[2];
#pragma unroll
    for (int i = 0; i < 2; ++i) { int R, C; stage_rc(tid * 16 + i * 8192, R, C); const int Rb = Epi::PERM ? ((R & ~31) + perm32(R & 31)) : R;
        voffA[i] = (unsigned)(R * K + C) * 2u; voffB[i] = (unsigned)(Rb * K + C) * 2u; }
    const size_t kstep = (size_t)(BK * 2);
    const size_t hstep = (size_t)HALF * K * 2;
    const size_t tstep = 2 * hstep;
    const unsigned ldsw = (unsigned)wid * 1024u;
    const int aoff = lds_byte(wr * 64 + fr, fq * 8), boff = lds_byte(wc * 32 + fr, fq * 8);
#define PG8_SA(b, h) (((b) * 2 + (h)) * HTB)
#define PG8_SB(b, h) ((4 + (b) * 2 + (h)) * HTB)
#define PG8_STAGE(bufoff, gbase, voff) do { _Pragma("unroll") for (int _i = 0; _i < 2; ++_i) \
        __builtin_amdgcn_global_load_lds((const unsigned*)((const char*)(gbase) + (voff)[_i]), (PG8_LAS unsigned*)(lds + (bufoff) + ldsw + _i * 8192), 16, 0, 0); } while (0)
#define PG8_LDA(dst, b, h) do { _Pragma("unroll") for (int m = 0; m < 4; ++m) _Pragma("unroll") for (int k = 0; k < 2; ++k) dst[m][k] = *(const PG8_LAS bf16x8*)(lds + PG8_SA(b, h) + aoff + m * 2048 + k * 1024); } while (0)
#define PG8_LDB(dst, b, h) do { _Pragma("unroll") for (int n = 0; n < 2; ++n) _Pragma("unroll") for (int k = 0; k < 2; ++k) dst[n][k] = *(const PG8_LAS bf16x8*)(lds + PG8_SB(b, h) + boff + n * 2048 + k * 1024); } while (0)
#define PG8_MMA(ai, bj, At, Bt) do { __builtin_amdgcn_s_setprio(1); _Pragma("unroll") for (int m = 0; m < 4; ++m) _Pragma("unroll") for (int n = 0; n < 2; ++n) _Pragma("unroll") for (int k = 0; k < 2; ++k) \
        acc[ai][bj][m][n] = __builtin_amdgcn_mfma_f32_16x16x32_bf16(Bt[n][k], At[m][k], acc[ai][bj][m][n], 0, 0, 0); __builtin_amdgcn_s_setprio(0); } while (0)
#define PG8_WAIT_V(n) asm volatile("s_waitcnt vmcnt(" #n ")" ::: "memory")
#define PG8_WAIT_L(n) asm volatile("s_waitcnt lgkmcnt(" #n ")" ::: "memory")
#define PG8_BAR __builtin_amdgcn_s_barrier()
#define PG8_SCHED __builtin_amdgcn_sched_barrier(0)
    Unit cur, nxt; int ui = 0;
    if (!S.next(0, cur)) return;
    f32x4 acc[2][2][4][2];
#pragma unroll
    for (int a = 0; a < 2; ++a)
#pragma unroll
        for (int b = 0; b < 2; ++b)
#pragma unroll
            for (int m = 0; m < 4; ++m)
#pragma unroll
                for (int n = 0; n < 2; ++n) acc[a][b][m][n] = (f32x4){0.f, 0.f, 0.f, 0.f};
    bf16x8 At[4][2], B0[2][2], B1[2][2];
    const char* cA = (const char*)g.A + (size_t)cur.pm * tstep; const char* cB = (const char*)g.Bt + (size_t)cur.pn * tstep;
    S.a_ready(cur);
    PG8_STAGE(PG8_SB(0, 0), cB, voffB); PG8_STAGE(PG8_SA(0, 0), cA, voffA); PG8_STAGE(PG8_SB(0, 1), cB + hstep, voffB); PG8_STAGE(PG8_SA(0, 1), cA + hstep, voffA);
    if (wr == 1) PG8_BAR;
    PG8_WAIT_V(4); PG8_BAR;
    PG8_STAGE(PG8_SB(1, 0), cB + kstep, voffB); PG8_STAGE(PG8_SA(1, 0), cA + kstep, voffA); PG8_STAGE(PG8_SB(1, 1), cB + hstep + kstep, voffB);
    PG8_WAIT_V(6); PG8_BAR;
    PG8_STAMP();
    for (;;) {
        const bool has_next = S.next(ui + 1, nxt);
        const char* nA = has_next ? (const char*)g.A + (size_t)nxt.pm * tstep : cA; const char* nB = has_next ? (const char*)g.Bt + (size_t)nxt.pn * tstep : cB;
        for (int t = 0; t < nt; t += 2) {
            const bool last = (t == nt - 2);
            const char* a1 = cA + (size_t)(t + 1) * kstep;
            const char* a2 = last ? nA : cA + (size_t)(t + 2) * kstep; const char* b2 = last ? nB : cB + (size_t)(t + 2) * kstep;
            const char* a3 = a2 + kstep; const char* b3 = b2 + kstep;
            if (last && has_next) S.a_ready(nxt);
            PG8_LDB(B0, 0, 0); PG8_SCHED; PG8_LDA(At, 0, 0); PG8_STAGE(PG8_SA(1, 1), a1 + hstep, voffA);
            PG8_WAIT_L(8); PG8_BAR; PG8_WAIT_L(0); PG8_MMA(0, 0, At, B0); PG8_BAR; PG8_SCHED;
            PG8_LDB(B1, 0, 1); PG8_STAGE(PG8_SB(0, 0), b2, voffB);
            PG8_BAR; PG8_WAIT_L(0); PG8_MMA(0, 1, At, B1); PG8_BAR;
            PG8_LDA(At, 0, 1); PG8_STAGE(PG8_SA(0, 0), a2, voffA);
            PG8_BAR; PG8_WAIT_L(0); PG8_MMA(1, 0, At, B0); PG8_BAR; PG8_SCHED;
            PG8_STAGE(PG8_SB(0, 1), b2 + hstep, voffB);
            PG8_WAIT_V(6); PG8_BAR; PG8_MMA(1, 1, At, B1); PG8_BAR;
            PG8_LDB(B0, 1, 0); PG8_SCHED; PG8_LDA(At, 1, 0); PG8_STAGE(PG8_SA(0, 1), a2 + hstep, voffA);
            PG8_WAIT_L(8); PG8_BAR; PG8_WAIT_L(0); PG8_MMA(0, 0, At, B0); PG8_BAR; PG8_SCHED;
            PG8_LDB(B1, 1, 1); PG8_STAGE(PG8_SB(1, 0), b3, voffB);
            PG8_BAR; PG8_WAIT_L(0); PG8_MMA(0, 1, At, B1); PG8_BAR;
            PG8_LDA(At, 1, 1); PG8_STAGE(PG8_SA(1, 0), a3, voffA);
            PG8_BAR; PG8_WAIT_L(0); PG8_MMA(1, 0, At, B0); PG8_BAR; PG8_SCHED;
            PG8_STAGE(PG8_SB(1, 1), b3 + hstep, voffB);
            PG8_WAIT_V(6); PG8_BAR; PG8_MMA(1, 1, At, B1); PG8_BAR;
        }
        PG8_STAMP();
        if constexpr (!Epi::AFTER_DRAIN) { E(acc, cur, wr, wc, fr, fq); S.done(cur); }
        PG8_STAMP();
        if (!has_next) break;
#pragma unroll
        for (int a = 0; a < 2; ++a)
#pragma unroll
            for (int b = 0; b < 2; ++b)
#pragma unroll
                for (int m = 0; m < 4; ++m)
#pragma unroll
                    for (int n = 0; n < 2; ++n) acc[a][b][m][n] = (f32x4){0.f, 0.f, 0.f, 0.f};
        cur = nxt; cA = nA; cB = nB; ++ui;
    }
    PG8_WAIT_V(0);
    if (wr == 0) PG8_BAR;
    PG8_BAR;
    if constexpr (Epi::AFTER_DRAIN) { E.fused(acc, cur, wr, wc, fr, fq, lds, wid, lane); S.done(cur); }
    PG8_STAMP();
    if (STAMP && wid == 0) { stamps[lane] = lane < nts ? (((unsigned long long)(unsigned)ts_hi << 32) | (unsigned)ts_lo) : 0ull;
        if (lane == 62) stamps[62] = rt_entry; if (lane == 63) stamps[63] = (unsigned long long)wall_clock64(); }
#undef PG8_STAMP
#undef PG8_SA
#undef PG8_SB
#undef PG8_STAGE
#undef PG8_LDA
#undef PG8_LDB
#undef PG8_MMA
#undef PG8_WAIT_V
#undef PG8_WAIT_L
#undef PG8_BAR
#undef PG8_SCHED
}
}
#define XB_TMO      128
#define XB_XCNT(j)  (256  + 64 * (j))
#define XB_XSUB(j)  (1280 + 64 * (j))
#define XB_XGEN(j)  (2304 + 64 * (j))
#define XB_TOP      3328
#define XB_TOPGEN   3392
#define XCD_BAR_WORDS 3456
#define XB_SPIN_CAP (1u << 22)
#define LAS __attribute__((address_space(3)))

__device__ __forceinline__ unsigned xb_ld(unsigned* p)              { return __hip_atomic_load(p, __ATOMIC_RELAXED, __HIP_MEMORY_SCOPE_AGENT); }
__device__ __forceinline__ unsigned xb_add(unsigned* p, unsigned v) { return __hip_atomic_fetch_add(p, v, __ATOMIC_RELAXED, __HIP_MEMORY_SCOPE_AGENT); }
__device__ __forceinline__ unsigned xb_xcc_id() { return (unsigned)__builtin_amdgcn_s_getreg((3 << 11) | 20) & 0xFu; }
#define XB_SPIN(cond, bar) do { unsigned _sp = 0; while (cond) { __builtin_amdgcn_s_sleep(1); \
    if ((++_sp & 255u) == 0u) { if (xb_ld(&(bar)[XB_TMO])) break; if (_sp > XB_SPIN_CAP) { atomicAdd(&(bar)[XB_TMO], 1u); break; } } } } while (0)

struct XcdBarrier {
    unsigned* bar; unsigned x;
    volatile LAS unsigned* st;
};

__device__ __forceinline__ XcdBarrier xcd_barrier_post(unsigned* bar, volatile LAS unsigned* st) {
    XcdBarrier b; b.bar = bar; b.x = xb_xcc_id(); b.st = st;
    if (threadIdx.x == 0) (void)xb_add(&bar[XB_XCNT(b.x)], 1u);
    return b;
}
__device__ __forceinline__ void xcd_barrier_complete(unsigned* bar, unsigned x, unsigned& nloc, unsigned& nx) {
    const unsigned G = gridDim.x * gridDim.y * gridDim.z;
    unsigned sum, cnt, mine, sp = 0u;
    for (;;) {
        sum = 0u; cnt = 0u; mine = 0u;
#pragma unroll
        for (unsigned j = 0; j < 16; ++j) { const unsigned c = xb_ld(&bar[XB_XCNT(j)]); sum += c; cnt += (c > 0u) ? 1u : 0u; mine = (j == x) ? c : mine; }
        if (sum == G) break;
        __builtin_amdgcn_s_sleep(1);
        if ((++sp & 255u) == 0u) { if (xb_ld(&bar[XB_TMO])) break; if (sp > XB_SPIN_CAP) { atomicAdd(&bar[XB_TMO], 1u); break; } }
    }
    nloc = mine > 0u ? mine : 1u; nx = cnt > 0u ? cnt : 1u;
}

__device__ __forceinline__ void xcd_barrier(const XcdBarrier& b) {
    asm volatile("s_waitcnt vmcnt(0)" ::: "memory");
    __syncthreads();
    if (threadIdx.x == 0) {
        unsigned* bar = b.bar;
        __builtin_amdgcn_s_waitcnt(0);
        unsigned nloc = b.st[0], nx = b.st[1];
        if (nloc == 0u) { xcd_barrier_complete(bar, b.x, nloc, nx); b.st[0] = nloc; b.st[1] = nx; }
        const unsigned old = xb_add(&bar[XB_XSUB(b.x)], 1u);
        const unsigned gen = old / nloc;
        if (old + 1u == (gen + 1u) * nloc) {
            __builtin_amdgcn_fence(__ATOMIC_RELEASE, "agent");
            asm volatile("s_waitcnt vmcnt(0)" ::: "memory");
            const unsigned og = xb_add(&bar[XB_TOP], 1u);
            const unsigned tg = og / nx;
            if (og + 1u == (tg + 1u) * nx) xb_add(&bar[XB_TOPGEN], 1u);
            else XB_SPIN(xb_ld(&bar[XB_TOPGEN]) == tg, bar);
            __builtin_amdgcn_fence(__ATOMIC_ACQUIRE, "agent");
            xb_add(&bar[XB_XGEN(b.x)], 1u);
            asm volatile("s_waitcnt vmcnt(0)" ::: "memory");
        } else {
            XB_SPIN(xb_ld(&bar[XB_XGEN(b.x)]) == gen, bar);
            __builtin_amdgcn_fence(__ATOMIC_ACQUIRE, "agent");
            asm volatile("s_waitcnt vmcnt(0)" ::: "memory");
        }
    }
    __syncthreads();
}

#define DI __device__ __forceinline__
typedef unsigned short bf16;
typedef float f32x4 __attribute__((ext_vector_type(4)));
typedef unsigned u32x4 __attribute__((ext_vector_type(4)));
typedef unsigned u32x2 __attribute__((ext_vector_type(2)));

constexpr int D = 1024, NB = 4, SEQ = 4096, MP = NB * SEQ, SB = 32, MR = MP + SB, MPAD = MP + 256;
constexpr int PAST = 8192, NPOOL = 2560;
constexpr int NP = 3328, DFF = 4096, NGATE = 4096, BW = 256;
constexpr int C_S5U = 0, C_AQ = 256, C_AK = 512, C_AV = 768, C_AR = 1024, C_DQ = 1280, C_DK = 1536, C_DV = 1792, C_DZ = 2048, C_MQ = 2304, C_MK = 2560, C_MV = 2816, C_LR = 3072, C_DB = 3088, C_DA = 3092;
constexpr size_t O_YP = 0, O_YS = O_YP + (size_t)MP * D, O_PMK = O_YS + (size_t)SB * D, O_PMV = O_PMK + (size_t)2 * MP * 256, O_PS5R = O_PMV + (size_t)2 * MP * 256,
                 O_PS5I = O_PS5R + 2 * NB * 1024, O_PGLA = O_PS5I + 2 * NB * 1024, O_PGDN = O_PGLA + 2 * NB * 16384, O_PCONV = O_PGDN + 2 * NB * 16384,
                 O_SMK = O_PCONV + 2 * NB * 3 * 768, O_SMV = O_SMK + 2 * SB * 256, O_SS5R = O_SMV + 2 * SB * 256, O_SS5I = O_SS5R + 2 * SB * 1024,
                 O_SGLA = O_SS5I + 2 * SB * 1024, O_SGDN = O_SGLA + (size_t)2 * SB * 16384, O_SCONV = O_SGDN + (size_t)2 * SB * 16384, O_END = O_SCONV + 2 * SB * 3 * 768;
static_assert(O_END == 36292608, "output size");
constexpr size_t al256(size_t x) { return (x + 255) & ~(size_t)255; }
constexpr size_t WS_CTL = 0, CTL_BYTES = 1u << 20;
constexpr size_t WSZ_WIN = (size_t)NP * D * 2, WSZ_WG = (size_t)NGATE * D * 2, WSZ_WBR = (size_t)4 * D * BW * 2, WSZ_WOUT = (size_t)D * D * 2, WSZ_FF1 = (size_t)DFF * D * 2, WSZ_FF2 = (size_t)D * DFF * 2;
constexpr size_t WO_WIN = 0, WO_WG = WO_WIN + WSZ_WIN, WO_WBR = WO_WG + WSZ_WG, WO_WOUT = WO_WBR + WSZ_WBR, WO_FF1 = WO_WOUT + WSZ_WOUT, WO_FF2 = WO_FF1 + WSZ_FF1, W_LAYER = al256(WO_FF2 + WSZ_FF2);
constexpr size_t WS_W = CTL_BYTES;
constexpr size_t WS_H = WS_W + 2 * W_LAYER;
constexpr size_t WS_PROJ = WS_H + (size_t)MPAD * D * 2;
constexpr size_t WS_GATE = WS_PROJ + (size_t)MPAD * NP * 4;
constexpr size_t WS_Y = WS_GATE + (size_t)MPAD * NGATE * 2;
constexpr size_t YSTRIDE = (size_t)MPAD * BW * 2;
constexpr size_t WS_M32 = WS_Y + 4 * YSTRIDE;
constexpr size_t WS_MRG = WS_M32 + (size_t)MPAD * D * 4;
constexpr size_t WS_SSQ = WS_M32;
constexpr size_t WS_SSQS = WS_SSQ + (size_t)MP * 16 * 4;
constexpr size_t WS_X1 = WS_MRG + (size_t)MPAD * D * 2;
constexpr size_t WS_X2 = WS_X1 + (size_t)MPAD * D * 4;
constexpr size_t WS_Z = WS_X2 + (size_t)MPAD * D * 4;
constexpr size_t WS_TMP = WS_Z + (size_t)MPAD * DFF * 2;
constexpr size_t TSTRIDE = (size_t)MPAD * BW * 4;
constexpr int T_LA = 0, T_GQ = 1, T_GK = 2, T_GV = 3, T_MQ = 4, T_YPRE = 5, T_OGLA = 6, T_OGDN = 7, T_N = 8;
constexpr size_t WS_GB = WS_TMP + T_N * TSTRIDE;
constexpr size_t WS_KM = WS_GB + 2 * (size_t)MPAD * 4 * 4;
constexpr size_t WS_KMS = WS_KM + 4 * 16 * 256 * 4;
constexpr size_t WS_END = WS_KMS + 32 * 32 * 256 * 4;
constexpr int CW_BAR = 1024;
constexpr int RING_BYTES = 131072, MISC_OFF = RING_BYTES + 320, LDS_BYTES = 147456;
constexpr int RS_OFF = RING_BYTES + 1024;
#define LASQ __attribute__((address_space(3)))

DI float wsum(float v) {
#pragma unroll
    for (int o = 32; o >= 1; o >>= 1) v += __shfl_xor(v, o);
    return v;
}
DI float wmaxf(float v) {
#pragma unroll
    for (int o = 32; o >= 1; o >>= 1) v = fmaxf(v, __shfl_xor(v, o));
    return v;
}
DI unsigned f2bf(float f) { unsigned u = __builtin_bit_cast(unsigned, f); return (u + 0x7fffu + ((u >> 16) & 1u)) >> 16; }
DI unsigned pk2(float lo, float hi) { return f2bf(lo) | (f2bf(hi) << 16); }
DI float bflo(unsigned w) { return __builtin_bit_cast(float, w << 16); }
DI float bfhi(unsigned w) { return __builtin_bit_cast(float, w & 0xffff0000u); }
DI float rcp_(float x) { return __builtin_amdgcn_rcpf(x); }
DI float rsq_(float x) { return __builtin_amdgcn_rsqf(x); }
DI float sigmoid_(float x) { return rcp_(1.f + __expf(-x)); }
DI float silu_(float x) { return x * sigmoid_(x); }
DI float softplus_(float x) { return x > 20.f ? x : __logf(1.f + __expf(x)); }
DI float logsigmoid_(float x) { return -softplus_(-x); }
DI float gelu_tanh_(float x) { const float u = 0.7978845608028654f * (x + 0.044715f * x * x * x); return x * rcp_(1.f + __expf(-2.f * u)); }

namespace pg8 {
#define EPI_OPAQUE_LANE() int fr = fr_, fq = fq_; asm volatile("" : "+v"(fr), "+v"(fq))
template <unsigned LDC> struct EpiStoreF32 {
    static constexpr bool PERM = false, AFTER_DRAIN = false;
    float* C; const LASQ float* rs; mutable int k;
    __device__ __forceinline__ void operator()(const f32x4 (&acc)[2][2][4][2], const Unit& u, int wr, int wc, int fr_, int fq_) const {
        EPI_OPAQUE_LANE();
        const unsigned row0 = (unsigned)(u.pm * BM + wr * 64 + fr), col0 = (unsigned)(u.pn * BM + wc * 32 + 4 * fq);
        const unsigned o0 = (row0 * LDC + col0) * 4u; char* cb = (char*)C;
        const LASQ float* rp = rs + k * 256 + wr * 64 + fr; ++k;
#pragma unroll
        for (int ai = 0; ai < 2; ++ai)
#pragma unroll
            for (int m = 0; m < 4; ++m) { const float sc = rp[ai * HALF + m * 16];
#pragma unroll
                for (int bj = 0; bj < 2; ++bj)
#pragma unroll
                    for (int n = 0; n < 2; ++n) *(f32x4*)(cb + (o0 + ((unsigned)(ai * HALF + m * 16) * LDC + (unsigned)(bj * HALF + n * 16)) * 4u)) = acc[ai][bj][m][n] * sc; }
    }
};
template <int ACT, unsigned LDC> struct EpiActBf16 {
    static constexpr bool PERM = true, AFTER_DRAIN = false;
    bf16_t* O; const LASQ float* rs; mutable int k;
    __device__ __forceinline__ void operator()(const f32x4 (&acc)[2][2][4][2], const Unit& u, int wr, int wc, int fr_, int fq_) const {
        EPI_OPAQUE_LANE();
        const unsigned row0 = (unsigned)(u.pm * BM + wr * 64 + fr), col0 = (unsigned)(u.pn * BM + wc * 32 + 8 * fq);
        const unsigned o0 = (row0 * LDC + col0) * 2u; char* ob = (char*)O;
        const LASQ float* rp = rs + k * 256 + wr * 64 + fr; ++k;
#pragma unroll
        for (int ai = 0; ai < 2; ++ai)
#pragma unroll
            for (int m = 0; m < 4; ++m) { const float sc = rp[ai * HALF + m * 16];
#pragma unroll
                for (int bj = 0; bj < 2; ++bj) { f32x4 v0 = acc[ai][bj][m][0] * sc, v1 = acc[ai][bj][m][1] * sc;
#pragma unroll
                    for (int j = 0; j < 4; ++j) {
                        if (ACT == 0) { v0[j] = __builtin_amdgcn_rcpf(1.f + __expf(-v0[j])); v1[j] = __builtin_amdgcn_rcpf(1.f + __expf(-v1[j])); }
                        else { const float a = fmaxf(v0[j], 0.f), b = fmaxf(v1[j], 0.f); v0[j] = a * a; v1[j] = b * b; } }
                    u32x4 w; w.x = cvt_pk_bf16(v0[0], v0[1]); w.y = cvt_pk_bf16(v0[2], v0[3]); w.z = cvt_pk_bf16(v1[0], v1[1]); w.w = cvt_pk_bf16(v1[2], v1[3]);
                    *(u32x4*)(ob + (o0 + ((unsigned)(ai * HALF + m * 16) * LDC + (unsigned)(bj * HALF)) * 2u)) = w; } }
    }
};
template <int MODE> struct EpiGate {
    static constexpr bool PERM = true, AFTER_DRAIN = false;
    static constexpr unsigned LDG = 4096, LD = 1024;
    const bf16_t* gate; float* m32; bf16_t* mrg;
    __device__ __forceinline__ void operator()(const f32x4 (&acc)[2][2][4][2], const Unit& u, int wr, int wc, int fr_, int fq_) const {
        EPI_OPAQUE_LANE();
        const unsigned row0 = (unsigned)(u.pm * BM + wr * 64 + fr), col0 = (unsigned)(u.pn * BM + wc * 32 + 8 * fq);
        const unsigned g0 = (row0 * LDG + col0) * 2u, m0 = (row0 * LD + col0) * 4u, b0 = (row0 * LD + col0) * 2u;
        const char* gb = (const char*)gate; char* mb = (char*)m32; char* bb = (char*)mrg;
#pragma unroll
        for (int ai = 0; ai < 2; ++ai)
#pragma unroll
            for (int m = 0; m < 4; ++m) { const unsigned dr = (unsigned)(ai * HALF + m * 16);
#pragma unroll
                for (int bj = 0; bj < 2; ++bj) { const unsigned dc = (unsigned)(bj * HALF);
                    const u32x4 gw = *(const u32x4*)(gb + (g0 + (dr * LDG + dc) * 2u));
                    f32x4 v0 = acc[ai][bj][m][0], v1 = acc[ai][bj][m][1];
                    v0[0] *= __builtin_bit_cast(float, gw.x << 16); v0[1] *= __builtin_bit_cast(float, gw.x & 0xffff0000u);
                    v0[2] *= __builtin_bit_cast(float, gw.y << 16); v0[3] *= __builtin_bit_cast(float, gw.y & 0xffff0000u);
                    v1[0] *= __builtin_bit_cast(float, gw.z << 16); v1[1] *= __builtin_bit_cast(float, gw.z & 0xffff0000u);
                    v1[2] *= __builtin_bit_cast(float, gw.w << 16); v1[3] *= __builtin_bit_cast(float, gw.w & 0xffff0000u);
                    const unsigned mo = m0 + (dr * LD + dc) * 4u;
                    if (MODE != 0) { v0 += *(const f32x4*)(mb + mo); v1 += *(const f32x4*)(mb + mo + 16u); }
                    if (MODE != 2) { *(f32x4*)(mb + mo) = v0; *(f32x4*)(mb + mo + 16u) = v1; }
                    else { u32x4 w; w.x = cvt_pk_bf16(v0[0], v0[1]); w.y = cvt_pk_bf16(v0[2], v0[3]); w.z = cvt_pk_bf16(v1[0], v1[1]); w.w = cvt_pk_bf16(v1[2], v1[3]);
                           *(u32x4*)(bb + (b0 + (dr * LD + dc) * 2u)) = w; }
                    asm volatile("" ::: "memory"); } }
    }
};
struct EpiRes {
    static constexpr bool PERM = true, AFTER_DRAIN = false;
    static constexpr unsigned LD = 1024;
    const float* base_p; float* out_p; bf16_t* hb; float* ssq;
    __device__ __forceinline__ void operator()(const f32x4 (&acc)[2][2][4][2], const Unit& u, int wr, int wc, int fr_, int fq_) const {
        EPI_OPAQUE_LANE();
        const char* bb = (const char*)base_p; char* ob = (char*)out_p; char* hbb = (char*)hb;
        const int rl0 = u.pm * BM + wr * 64 + fr; const unsigned col0 = (unsigned)(u.pn * BM + wc * 32 + 8 * fq);
#pragma unroll
        for (int ai = 0; ai < 2; ++ai) {
            f32x4 b[4][2][2];
#pragma unroll
            for (int m = 0; m < 4; ++m) { const unsigned off = ((unsigned)(rl0 + ai * HALF + m * 16) * LD + col0) * 4u;
#pragma unroll
                for (int bj = 0; bj < 2; ++bj)
#pragma unroll
                    for (int n = 0; n < 2; ++n) b[m][bj][n] = *(const f32x4*)(bb + off + (unsigned)(bj * HALF) * 4u + (unsigned)n * 16u); }
#pragma unroll
            for (int m = 0; m < 4; ++m) { const int row = rl0 + ai * HALF + m * 16;
                const unsigned off = ((unsigned)row * LD + col0) * 4u; float s = 0.f;
#pragma unroll
                for (int bj = 0; bj < 2; ++bj) { const unsigned o = off + (unsigned)(bj * HALF) * 4u;
                    const f32x4 v0 = b[m][bj][0] + acc[ai][bj][m][0], v1 = b[m][bj][1] + acc[ai][bj][m][1]; *(f32x4*)(ob + o) = v0; *(f32x4*)(ob + o + 16) = v1;
                    if (hb) { s += ((v0.x * v0.x + v0.y * v0.y) + (v0.z * v0.z + v0.w * v0.w)) + ((v1.x * v1.x + v1.y * v1.y) + (v1.z * v1.z + v1.w * v1.w));
                        u32x4 w; w.x = cvt_pk_bf16(v0.x, v0.y); w.y = cvt_pk_bf16(v0.z, v0.w); w.z = cvt_pk_bf16(v1.x, v1.y); w.w = cvt_pk_bf16(v1.z, v1.w); *(u32x4*)(hbb + (o >> 1)) = w; } }
                if (hb) { s += __shfl_xor(s, 16); s += __shfl_xor(s, 32); if (fq == 0) ssq[(unsigned)row * 16u + (unsigned)(u.pn * 4 + wc)] = s; } }
            asm volatile("" ::: "memory"); }
    }
};
}

#ifndef FAST_GLA
#define FAST_GLA 1
#endif
#ifndef FAST_S5
#define FAST_S5 1
#endif
#ifndef FAST_GDN
#define FAST_GDN 1
#endif
struct Args { const void* in[40]; float* out; unsigned char* ws; int ph_lo, ph_hi, li, pad; };
struct Ctx {
    float* out; unsigned char* ws;
    float* outb; unsigned char* wsb;
    LASQ unsigned char* lds;
    int tid, lane, wave, vcu, G, gw, NGW;
};
constexpr int PTAB_OFF = RING_BYTES;
DI unsigned long long inU(const Ctx& C, int i) { const u32x2 v = *(const LASQ u32x2*)(C.lds + PTAB_OFF + 8 * i);
    return ((unsigned long long)(unsigned)__builtin_amdgcn_readfirstlane((int)v.y) << 32) | (unsigned)__builtin_amdgcn_readfirstlane((int)v.x); }
#define GASQ __attribute__((address_space(1)))
DI const float* inF(const Ctx& C, int i) { return (const float*)(const GASQ float*)inU(C, i); }
DI const int* inI(const Ctx& C, int i) { return (const int*)(const GASQ int*)inU(C, i); }
DI float* tmpbuf(const Ctx& C, int i) { return (float*)(C.ws + WS_TMP + (size_t)i * TSTRIDE); }
DI bf16* ybuf(const Ctx& C, int i) { return (bf16*)(C.ws + WS_Y + (size_t)i * YSTRIDE); }
DI float* projp(const Ctx& C) { return (float*)(C.ws + WS_PROJ); }
DI bf16* Hp(const Ctx& C) { return (bf16*)(C.ws + WS_H); }
DI bf16* gatep(const Ctx& C) { return (bf16*)(C.ws + WS_GATE); }
DI float* m32p(const Ctx& C) { return (float*)(C.ws + WS_M32); }
DI bf16* mrgp(const Ctx& C) { return (bf16*)(C.ws + WS_MRG); }
DI float* X1p(const Ctx& C) { return (float*)(C.ws + WS_X1); }
DI float* X2p(const Ctx& C) { return (float*)(C.ws + WS_X2); }
DI bf16* Zp(const Ctx& C) { return (bf16*)(C.ws + WS_Z); }
DI float* GBp(const Ctx& C) { return (float*)(C.ws + WS_GB); }
DI float* GGp(const Ctx& C) { return (float*)(C.ws + WS_GB) + (size_t)MPAD * 4; }
DI float* KMp(const Ctx& C) { return (float*)(C.ws + WS_KM); }
DI float* KMSp(const Ctx& C) { return (float*)(C.ws + WS_KMS); }
DI bf16* wptr(const Ctx& C, int l, size_t off) { return (bf16*)(C.ws + WS_W + (size_t)l * W_LAYER + off); }

DI void refresh(Ctx& C) { int t_ = threadIdx.x; asm volatile("" : "+v"(t_)); C.tid = t_; C.lane = t_ & 63; int v_ = C.vcu, w_ = C.wave; size_t z_ = 0; asm volatile("" : "+s"(v_), "+s"(w_), "+s"(z_)); C.vcu = v_; C.wave = w_; C.ws = C.wsb + z_; C.out = C.outb + z_; C.gw = w_ * C.G + v_; }
DI int winmap(int c) {
    if (c < 1024) return c;
    if (c < 1280) return 1040 + (c - 1024);
    if (c < 2048) return 1296 + (c - 1280);
    if (c < 2304) return 2072 + (c - 2048);
    if (c < 3072) return 2328 + (c - 2304);
    if (c < 3088) return 1024 + (c - 3072);
    if (c < 3096) return 2064 + (c - 3088);
    return -1;
}
template <bool MAP, bool GAIN = false> DI void tr_item(const float* W, int K, int Nsrc, int Ndst, bf16* WT, LASQ float* scr, int item, int lane, const float* gn = nullptr) {
    const int nblk = Ndst / 32, kb = item / nblk, nb = item % nblk, k0 = 64 * kb, n0 = 32 * nb;
    const int nd = n0 + (lane & 31); const int ns = MAP ? winmap(nd) : nd;
    const int c = lane & 7;
    f32x4 ga = {1.f, 1.f, 1.f, 1.f}, gb = ga; if (GAIN) { ga = *(const f32x4*)(gn + k0 + 8 * c); gb = *(const f32x4*)(gn + k0 + 8 * c + 4); }
#pragma unroll
    for (int i = 0; i < 32; ++i) { const int kk = 2 * i + (lane >> 5); scr[kk * 33 + (lane & 31)] = (ns >= 0) ? __builtin_nontemporal_load(W + (size_t)(k0 + kk) * Nsrc + ns) : 0.f; }
    asm volatile("s_waitcnt lgkmcnt(0)" ::: "memory");
#pragma unroll
    for (int j = 0; j < 4; ++j) { const int n = (lane >> 3) + 8 * j; const LASQ float* s = scr + (8 * c) * 33 + n;
        u32x4 o; if (GAIN) { o.x = pk2(s[0 * 33] * ga.x, s[1 * 33] * ga.y); o.y = pk2(s[2 * 33] * ga.z, s[3 * 33] * ga.w); o.z = pk2(s[4 * 33] * gb.x, s[5 * 33] * gb.y); o.w = pk2(s[6 * 33] * gb.z, s[7 * 33] * gb.w); }
        else { o.x = pk2(s[0 * 33], s[1 * 33]); o.y = pk2(s[2 * 33], s[3 * 33]); o.z = pk2(s[4 * 33], s[5 * 33]); o.w = pk2(s[6 * 33], s[7 * 33]); }
        *(u32x4*)(WT + (size_t)(n0 + n) * K + k0 + 8 * c) = o; }
    asm volatile("s_waitcnt lgkmcnt(0)" ::: "memory");
}
DI void rms_row(const float* xrow, const float* g, bf16* orow, int lane) {
    const f32x4* xr = (const f32x4*)xrow + lane; const f32x4* gr = (const f32x4*)g + lane;
    f32x4 v[4]; float s = 0.f;
#pragma unroll
    for (int j = 0; j < 4; ++j) { v[j] = xr[64 * j]; s += (v[j].x * v[j].x + v[j].y * v[j].y) + (v[j].z * v[j].z + v[j].w * v[j].w); }
    const float r = 1.f / sqrtf(wsum(s) * (1.f / D) + 1e-6f);
    unsigned long long* o8 = (unsigned long long*)orow + lane;
#pragma unroll
    for (int j = 0; j < 4; ++j) { const f32x4 gg = gr[64 * j];
        o8[64 * j] = (unsigned long long)pk2(v[j].x * r * gg.x, v[j].y * r * gg.y) | ((unsigned long long)pk2(v[j].z * r * gg.z, v[j].w * r * gg.w) << 32); }
}
DI void cast_rows(Ctx& C, const float* xp, const float* xs) {
    const int lane = C.lane;
    for (int m0 = 4 * C.gw; m0 < MR; m0 += 4 * C.NGW) {
        const float* x0 = (m0 < MP) ? xp + (size_t)m0 * D : xs + (size_t)(m0 - MP) * D;
        f32x4 v[4][4];
#pragma unroll
        for (int i = 0; i < 4; ++i)
#pragma unroll
            for (int j = 0; j < 4; ++j) v[i][j] = __builtin_nontemporal_load((const f32x4*)(x0 + (size_t)i * D) + lane + 64 * j);
#pragma unroll
        for (int i = 0; i < 4; ++i) { float s = 0.f;
#pragma unroll
            for (int j = 0; j < 4; ++j) s += (v[i][j].x * v[i][j].x + v[i][j].y * v[i][j].y) + (v[i][j].z * v[i][j].z + v[i][j].w * v[i][j].w);
            s = wsum(s);
            if (m0 < MP) { if (lane < 16) ((float*)(C.ws + WS_SSQ))[(size_t)(m0 + i) * 16 + lane] = (lane == 0) ? s : 0.f; }
            else ((float*)(C.ws + WS_SSQS))[(size_t)(m0 + i - MP) * 64 + lane] = (lane == 0) ? s : 0.f;
            unsigned long long* o8 = (unsigned long long*)(Hp(C) + (size_t)(m0 + i) * D) + lane;
#pragma unroll
            for (int j = 0; j < 4; ++j) o8[64 * j] = (unsigned long long)pk2(v[i][j].x, v[i][j].y) | ((unsigned long long)pk2(v[i][j].z, v[i][j].w) << 32); }
    }
}
template <class Order> DI void fill_rs(Ctx& C, const Order& S, int slot0) {
    LASQ float* rsl = (LASQ float*)(C.lds + RS_OFF) + slot0 * 256; const float* sq = (const float*)(C.ws + WS_SSQ) + (size_t)(C.tid >> 1) * 16 + (C.tid & 1) * 8;
    constexpr int NU = 4; f32x4 a[NU], b[NU]; bool ok[NU];
#pragma unroll
    for (int i = 0; i < NU; ++i) { pg8::Unit u; ok[i] = S.next(i, u); const float* p = sq + (size_t)(ok[i] ? u.pm : 0) * 256 * 16; a[i] = ((const f32x4*)p)[0]; b[i] = ((const f32x4*)p)[1]; }
#pragma unroll
    for (int i = 0; i < NU; ++i) { float s = ((a[i].x + a[i].y) + (a[i].z + a[i].w)) + ((b[i].x + b[i].y) + (b[i].z + b[i].w)); s += __shfl_xor(s, 1);
        if (ok[i] && !(C.tid & 1)) rsl[i * 256 + (C.tid >> 1)] = rsq_(s * (1.f / D) + 1e-6f); }
    pg8::Unit u;
    for (int i = NU; S.next(i, u); ++i) { const float* p = sq + (size_t)u.pm * 256 * 16;
        const f32x4 a2 = ((const f32x4*)p)[0], b2 = ((const f32x4*)p)[1]; float s = ((a2.x + a2.y) + (a2.z + a2.w)) + ((b2.x + b2.y) + (b2.z + b2.w)); s += __shfl_xor(s, 1);
        if (!(C.tid & 1)) rsl[i * 256 + (C.tid >> 1)] = rsq_(s * (1.f / D) + 1e-6f); }
}
DI float sample_rs(Ctx& C) { const f32x4 a = *((const f32x4*)(C.ws + WS_SSQS) + C.tid); float s = (a.x + a.y) + (a.z + a.w);
#pragma unroll
    for (int o = 1; o < 16; o <<= 1) s += __shfl_xor(s, o);
    return rsq_(s * (1.f / D) + 1e-6f); }
DI void prologue(Ctx& C) {
    LASQ float* scr = (LASQ float*)(C.lds + C.wave * 16384);
    constexpr int I_IN = (D / 64) * (NP / 32), I_G = (D / 64) * (NGATE / 32), I_BR = (BW / 64) * (D / 32), I_O = (D / 64) * (D / 32), I_1 = (D / 64) * (DFF / 32), I_2 = (DFF / 64) * (D / 32);
    constexpr int PER_L = I_IN + I_G + 4 * I_BR + I_O + I_1 + I_2;
    for (int it = C.gw; it < 2 * PER_L; it += C.NGW) {
        const int l = it / PER_L; int r = it % PER_L;
        if (r < I_IN) { tr_item<true, true>(inF(C, 11) + (size_t)l * D * 3096, D, 3096, NP, wptr(C, l, WO_WIN), scr, r, C.lane, inF(C, 10) + l * D); continue; } r -= I_IN;
        if (r < I_G) { tr_item<false, true>(inF(C, 31) + (size_t)l * D * NGATE, D, NGATE, NGATE, wptr(C, l, WO_WG), scr, r, C.lane, inF(C, 10) + l * D); continue; } r -= I_G;
        if (r < 4 * I_BR) { const int br = r / I_BR; tr_item<false>(inF(C, 32 + br) + (size_t)l * BW * D, BW, D, D, wptr(C, l, WO_WBR) + (size_t)br * D * BW, scr, r % I_BR, C.lane); continue; } r -= 4 * I_BR;
        if (r < I_O) { tr_item<false>(inF(C, 36) + (size_t)l * D * D, D, D, D, wptr(C, l, WO_WOUT), scr, r, C.lane); continue; } r -= I_O;
        if (r < I_1) { tr_item<false, true>(inF(C, 38) + (size_t)l * D * DFF, D, DFF, DFF, wptr(C, l, WO_FF1), scr, r, C.lane, inF(C, 37) + l * D); continue; } r -= I_1;
        tr_item<false>(inF(C, 39) + (size_t)l * DFF * D, DFF, D, D, wptr(C, l, WO_FF2), scr, r, C.lane);
    }
    cast_rows(C, inF(C, 0), inF(C, 1));
}

DI void pre_row(Ctx& C, int l, int m, const float* ropetab, int piece) {
    const int lane = C.lane; const bool smp = m >= MP; const int bs = m - MP, t = smp ? 0 : (m & (SEQ - 1)), pos = smp ? PAST : t;
    const float* pr = projp(C) + (size_t)m * NP;
    if ((!FAST_GLA || smp) && piece == 0) {
        const float* Wg = inF(C, 22) + (size_t)l * 16 * 256; const float* bg = inF(C, 23) + l * 256; float* LA = tmpbuf(C, T_LA) + (size_t)m * 256;
        float lr[16];
#pragma unroll
        for (int r = 0; r < 16; ++r) lr[r] = pr[C_LR + r];
#pragma unroll
        for (int i = 0; i < 4; ++i) { const int c = lane + 64 * i; float x = bg[c];
#pragma unroll
            for (int r = 0; r < 16; ++r) x += lr[r] * Wg[r * 256 + c];
            LA[c] = logsigmoid_(x) * (1.f / 16.f); }
    }
    if (piece >= 1 && piece <= 3) {
        const float* cw = inF(C, 25) + (size_t)l * 4 * 768; const float* cst = inF(C, 9) + ((size_t)l * SB + (smp ? bs : 0)) * 3 * 768;
        if (!FAST_GDN || smp) {
        { const int grp = piece - 1;
            float vals[4];
#pragma unroll
            for (int i = 0; i < 4; ++i) { const int c = grp * 256 + lane + 64 * i; float acc = 0.f;
#pragma unroll
                for (int j = 0; j < 4; ++j) { const int tt = t - 3 + j; float xin;
                    if (tt >= 0) xin = projp(C)[(size_t)(m - 3 + j) * NP + C_DQ + c]; else xin = smp ? cst[(tt + 3) * 768 + c] : 0.f;
                    acc += cw[j * 768 + c] * xin; }
                vals[i] = silu_(acc); }
            if (grp < 2) {
#pragma unroll
                for (int i = 0; i < 4; ++i) { const float ss = wsum(vals[i] * vals[i]); vals[i] *= (1.f / sqrtf(ss + 1e-6f)) * (grp == 0 ? 0.125f : 1.f); } }
            float* GO = tmpbuf(C, T_GQ + grp) + (size_t)m * 256;
#pragma unroll
            for (int i = 0; i < 4; ++i) GO[i * 64 + lane] = vals[i];
            asm volatile("" ::: "memory");
        }
        if (lane < 4 && piece == 1) { GBp(C)[(size_t)m * 4 + lane] = sigmoid_(pr[C_DB + lane]);
                        GGp(C)[(size_t)m * 4 + lane] = -expf(inF(C, 26)[l * 4 + lane]) * softplus_(pr[C_DA + lane] + inF(C, 27)[l * 4 + lane]); }
        }
        if (!smp && t >= SEQ - 3 && piece == 3) { float* o = C.out + O_PCONV + (((size_t)l * NB + (m >> 12)) * 3 + (t - (SEQ - 3))) * 768;
#pragma unroll
            for (int i = 0; i < 12; ++i) o[lane + 64 * i] = pr[C_DQ + lane + 64 * i]; }
        if (smp && piece == 3) { float* o = C.out + O_SCONV + ((size_t)l * SB + bs) * 3 * 768;
#pragma unroll
            for (int i = 0; i < 12; ++i) { const int c = lane + 64 * i; o[c] = cst[768 + c]; o[768 + c] = cst[2 * 768 + c]; o[2 * 768 + c] = pr[C_DQ + c]; } }
    }
    if (piece >= 4) {
        const float* qn = inF(C, 29) + l * 64; const float* kn = inF(C, 30) + l * 64;
        const float* rt = ropetab + (size_t)(smp ? SEQ : t) * 16; const float cs = rt[lane & 7], sn = rt[8 + (lane & 7)];
        float* MQ = tmpbuf(C, T_MQ) + (size_t)m * 256;
        float* MK = smp ? C.out + O_SMK + ((size_t)l * SB + bs) * 256 : C.out + O_PMK + ((size_t)l * MP + m) * 256;
        float* MV = smp ? C.out + O_SMV + ((size_t)l * SB + bs) * 256 : C.out + O_PMV + ((size_t)l * MP + m) * 256;
        { const int i = piece - 4;
            float xq = pr[C_MQ + i * 64 + lane], xk = pr[C_MK + i * 64 + lane];
            xq = xq * (1.f / sqrtf(wsum(xq * xq) * (1.f / 64.f) + 1e-6f)) * qn[lane];
            xk = xk * (1.f / sqrtf(wsum(xk * xk) * (1.f / 64.f) + 1e-6f)) * kn[lane];
            const float pq = __shfl_xor(xq, 8), pk = __shfl_xor(xk, 8);
            if (lane < 8) { xq = xq * cs - pq * sn; xk = xk * cs - pk * sn; } else if (lane < 16) { xq = xq * cs + pq * sn; xk = xk * cs + pk * sn; }
            MQ[i * 64 + lane] = xq; MK[i * 64 + lane] = xk; MV[i * 64 + lane] = pr[C_MV + i * 64 + lane]; }
    }
}
DI void kmean_item(Ctx& C, int l, int it) {
    const int lane = C.lane; float s[4] = {0.f, 0.f, 0.f, 0.f};
    if (it < NB * 16) { const int b = it >> 4, blk = it & 15; const float* k = C.out + O_PMK + ((size_t)l * MP + (size_t)b * SEQ + blk * 256) * 256;
        for (int j = 0; j < 256; ++j) {
#pragma unroll
            for (int i = 0; i < 4; ++i) s[i] += k[(size_t)j * 256 + lane + 64 * i]; }
#pragma unroll
        for (int i = 0; i < 4; ++i) KMp(C)[(size_t)it * 256 + lane + 64 * i] = s[i] * (1.f / 256.f);
    } else { const int r = it - NB * 16, bs = r >> 5, blk = r & 31; const int* pt = inI(C, 4) + bs * 64 + blk * 2; const float* ck = inF(C, 2) + (size_t)l * NPOOL * 128 * 256;
        for (int pg = 0; pg < 2; ++pg) { const float* k = ck + (size_t)pt[pg] * 128 * 256;
            for (int j = 0; j < 128; ++j) {
#pragma unroll
                for (int i = 0; i < 4; ++i) s[i] += k[(size_t)j * 256 + lane + 64 * i]; } }
#pragma unroll
        for (int i = 0; i < 4; ++i) KMSp(C)[(size_t)r * 256 + lane + 64 * i] = s[i] * (1.f / 256.f);
    }
}
DI void s5_naive(Ctx& C, int l, int s, int g, const float* s5p, bf16* ysb) {
    const int lane = C.lane;
    const float* P = s5p + (size_t)(l * 16 + g) * 36 * 64 + lane; const float are = P[0], aim = P[64];
    float bre[16], bim[16], cre[16], cim[16];
#pragma unroll
    for (int c = 0; c < 16; ++c) { bre[c] = P[(4 + c) * 64]; bim[c] = P[(20 + c) * 64];
        cre[c] = inF(C, 17)[((size_t)(l * 16 + g) * 16 + c) * 64 + lane]; cim[c] = inF(C, 18)[((size_t)(l * 16 + g) * 16 + c) * 64 + lane]; }
    const float dd = inF(C, 19)[l * 256 + g * 16 + (lane & 15)];
    int L, row0; float hr = 0.f, hi = 0.f;
    if (s < NB) { L = SEQ; row0 = s * SEQ; } else { L = 1; row0 = MP + (s - NB); hr = inF(C, 5)[((size_t)(l * SB + s - NB) * 16 + g) * 64 + lane]; hi = inF(C, 6)[((size_t)(l * SB + s - NB) * 16 + g) * 64 + lane]; }
    float* YPRE = tmpbuf(C, T_YPRE);
    for (int t = 0; t < L; ++t) {
        const float* up = projp(C) + (size_t)(row0 + t) * NP + C_S5U + g * 16;
        float xr = 0.f, xi = 0.f;
#pragma unroll
        for (int c = 0; c < 16; ++c) { const float u = up[c]; xr += bre[c] * u; xi += bim[c] * u; }
        const float nhr = are * hr - aim * hi + xr, nhi = are * hi + aim * hr + xi; hr = nhr; hi = nhi;
        float myy = 0.f;
#pragma unroll
        for (int c = 0; c < 16; ++c) { const float yc = wsum(hr * cre[c] - hi * cim[c]); if (lane == c) myy = yc; }
        if (lane < 16) { const float yv = gelu_tanh_(myy + dd * up[lane]); YPRE[(size_t)(row0 + t) * 256 + g * 16 + lane] = yv; if (s >= NB) ysb[(size_t)(s - NB) * 256 + g * 16 + lane] = (bf16)f2bf(yv); }
    }
    const size_t so = (s < NB) ? ((size_t)(l * NB + s) * 16 + g) * 64 + lane : ((size_t)(l * SB + s - NB) * 16 + g) * 64 + lane;
    if (s < NB) { C.out[O_PS5R + so] = hr; C.out[O_PS5I + so] = hi; } else { C.out[O_SS5R + so] = hr; C.out[O_SS5I + so] = hi; }
}
DI void gla_naive(Ctx& C, int l, int s, int h, int j) {
    const int lane = C.lane; float S[8]; int L, row0; size_t sto;
    if (s < NB) { L = SEQ; row0 = s * SEQ; sto = O_PGLA + (((size_t)(l * NB + s) * 4 + h) * 64 + lane) * 64 + 8 * j;
#pragma unroll
        for (int i = 0; i < 8; ++i) S[i] = 0.f; }
    else { L = 1; row0 = MP + s - NB; sto = O_SGLA + (((size_t)(l * SB + s - NB) * 4 + h) * 64 + lane) * 64 + 8 * j; const float* st = inF(C, 7) + (((size_t)(l * SB + s - NB) * 4 + h) * 64 + lane) * 64 + 8 * j;
#pragma unroll
        for (int i = 0; i < 8; ++i) S[i] = st[i]; }
    const float* LA = tmpbuf(C, T_LA); float* OG = tmpbuf(C, T_OGLA);
    for (int t = 0; t < L; ++t) { const size_t m = row0 + t; const float* pr = projp(C) + m * NP;
        const float q = pr[C_AQ + h * 64 + lane] * 0.125f, k = pr[C_AK + h * 64 + lane], a = __expf(LA[m * 256 + h * 64 + lane]);
        float myo = 0.f;
#pragma unroll
        for (int i = 0; i < 8; ++i) { S[i] = a * S[i] + k * pr[C_AV + h * 64 + 8 * j + i]; const float o = wsum(q * S[i]); if (lane == i) myo = o; }
        if (lane < 8) OG[m * 256 + h * 64 + 8 * j + lane] = myo; }
#pragma unroll
    for (int i = 0; i < 8; ++i) C.out[sto + i] = S[i];
}
DI void gdn_naive(Ctx& C, int l, int s, int h, int j) {
    const int lane = C.lane; float S[8]; int L, row0; size_t sto;
    if (s < NB) { L = SEQ; row0 = s * SEQ; sto = O_PGDN + (((size_t)(l * NB + s) * 4 + h) * 64 + lane) * 64 + 8 * j;
#pragma unroll
        for (int i = 0; i < 8; ++i) S[i] = 0.f; }
    else { L = 1; row0 = MP + s - NB; sto = O_SGDN + (((size_t)(l * SB + s - NB) * 4 + h) * 64 + lane) * 64 + 8 * j; const float* st = inF(C, 8) + (((size_t)(l * SB + s - NB) * 4 + h) * 64 + lane) * 64 + 8 * j;
#pragma unroll
        for (int i = 0; i < 8; ++i) S[i] = st[i]; }
    const float* GQ = tmpbuf(C, T_GQ); const float* GK = tmpbuf(C, T_GK); const float* GV = tmpbuf(C, T_GV); float* OG = tmpbuf(C, T_OGDN);
    for (int t = 0; t < L; ++t) { const size_t m = row0 + t;
        const float q = GQ[m * 256 + h * 64 + lane], k = GK[m * 256 + h * 64 + lane], beta = GBp(C)[m * 4 + h], a = __expf(GGp(C)[m * 4 + h]);
        float myo = 0.f;
#pragma unroll
        for (int i = 0; i < 8; ++i) { S[i] *= a; const float ks = wsum(k * S[i]); S[i] += beta * k * (GV[m * 256 + h * 64 + 8 * j + i] - ks); const float o = wsum(q * S[i]); if (lane == i) myo = o; }
        if (lane < 8) OG[m * 256 + h * 64 + 8 * j + lane] = myo; }
#pragma unroll
    for (int i = 0; i < 8; ++i) C.out[sto + i] = S[i];
}
DI const float* moba_kv_row(const Ctx& C, int l, bool smp, int b, int kp, int h, bool isv) {
    if (!smp) return C.out + (isv ? O_PMV : O_PMK) + ((size_t)l * MP + (size_t)b * SEQ + kp) * 256 + h * 64;
    if (kp >= PAST) return C.out + (isv ? O_SMV : O_SMK) + ((size_t)l * SB + b) * 256 + h * 64;
    const int page = (inI(C, 4))[b * 64 + (kp >> 7)];
    return inF(C, isv ? 3 : 2) + (((size_t)l * NPOOL + page) * 128 + (kp & 127)) * 256 + h * 64;
}
DI void moba_naive(Ctx& C, int l, int m, int h, LASQ float* wl) {
    const int lane = C.lane; const bool smp = m >= MP; const int b = smp ? m - MP : (m >> 12), t = smp ? 0 : (m & (SEQ - 1)), pos = smp ? PAST : t, own = pos >> 8;
    const float q = tmpbuf(C, T_MQ)[(size_t)m * 256 + h * 64 + lane];
    wl[lane] = q;
    const float* km = smp ? KMSp(C) + (size_t)b * 32 * 256 + h * 64 : KMp(C) + (size_t)b * 16 * 256 + h * 64;
    float myg = -3.0e38f;
    for (int n = 0; n < own; ++n) { const float gs = wsum(q * km[(size_t)n * 256 + lane]); if (lane == n) myg = gs; }
    int sel[4];
#pragma unroll
    for (int r = 0; r < 3; ++r) { if (r < own) { const float mx = wmaxf(myg); const unsigned long long bal = __ballot(myg == mx); const int idx = __ffsll((long long)bal) - 1; sel[r] = idx; if (lane == idx) myg = -3.0e38f; } else sel[r] = -1; }
    sel[3] = own;
    asm volatile("s_waitcnt lgkmcnt(0)" ::: "memory");
    float lg[4][4]; float mx = -3.0e38f;
#pragma unroll
    for (int r = 0; r < 4; ++r) {
#pragma unroll
        for (int i = 0; i < 4; ++i) { lg[r][i] = -3.0e38f;
            const int kp = sel[r] * 256 + lane + 64 * i;
            if (sel[r] >= 0 && kp <= pos) { const f32x4* kr = (const f32x4*)moba_kv_row(C, l, smp, b, kp, h, false); float dot = 0.f;
#pragma unroll
                for (int d4 = 0; d4 < 16; ++d4) { const f32x4 kv = kr[d4]; const f32x4 qv = *(const LASQ f32x4*)(wl + 4 * d4); dot += (kv.x * qv.x + kv.y * qv.y) + (kv.z * qv.z + kv.w * qv.w); }
                lg[r][i] = dot * 0.125f; mx = fmaxf(mx, lg[r][i]); } } }
    mx = wmaxf(mx); float sum = 0.f;
#pragma unroll
    for (int r = 0; r < 4; ++r)
#pragma unroll
        for (int i = 0; i < 4; ++i) { const float p = (lg[r][i] > -1.0e38f) ? __expf(lg[r][i] - mx) : 0.f; sum += p; wl[64 + r * 256 + lane + 64 * i] = p; }
    sum = wsum(sum);
    asm volatile("s_waitcnt lgkmcnt(0)" ::: "memory");
    float o = 0.f;
#pragma unroll
    for (int r = 0; r < 4; ++r) { if (sel[r] < 0) continue; const int nk = (r == 3) ? (pos - own * 256 + 1) : 256;
        for (int key = 0; key < nk; ++key) { const float* vr = moba_kv_row(C, l, smp, b, sel[r] * 256 + key, h, true); o += wl[64 + r * 256 + key] * vr[lane]; } }
    ybuf(C, 3)[(size_t)m * 256 + h * 64 + lane] = (bf16)f2bf(o / sum);
    asm volatile("s_waitcnt lgkmcnt(0)" ::: "memory");
}
DI void post_row(Ctx& C, int l, int m, int piece) {
    const int lane = C.lane; const float* pr = projp(C) + (size_t)m * NP;
    if (piece < 4) {   const float* og = tmpbuf(C, T_OGLA) + (size_t)m * 256; const float gn = inF(C, 24)[l * 64 + lane];
        { const int i = piece; const float o = og[i * 64 + lane]; const float r = 1.f / sqrtf(wsum(o * o) * (1.f / 64.f) + 1e-6f);
            ybuf(C, 1)[(size_t)m * 256 + i * 64 + lane] = (bf16)f2bf(o * r * gn * silu_(pr[C_AR + i * 64 + lane])); } }
    if (piece >= 4) {   const float* og = tmpbuf(C, T_OGDN) + (size_t)m * 256; const float gn = inF(C, 28)[l * 64 + lane];
        { const int i = piece - 4; const float o = og[i * 64 + lane]; const float r = 1.f / sqrtf(wsum(o * o) * (1.f / 64.f) + 1e-6f);
            ybuf(C, 2)[(size_t)m * 256 + i * 64 + lane] = (bf16)f2bf(o * r * gn * silu_(pr[C_DZ + i * 64 + lane])); } }
}

typedef short bf16x8v __attribute__((ext_vector_type(8)));
typedef short bf16x4v __attribute__((ext_vector_type(4)));
DI bf16x8v cvt8(f32x4 a, f32x4 b) { u32x4 w; w.x = pg8::cvt_pk_bf16(a.x, a.y); w.y = pg8::cvt_pk_bf16(a.z, a.w); w.z = pg8::cvt_pk_bf16(b.x, b.y); w.w = pg8::cvt_pk_bf16(b.z, b.w); return __builtin_bit_cast(bf16x8v, w); }
#define MFMA16(a, b, c) __builtin_amdgcn_mfma_f32_16x16x32_bf16((a), (b), (c), 0, 0, 0)
constexpr int AT_KS = 144, AT_VS = 144, AT_KB = 64 * AT_KS, AT_VB = 64 * AT_VS;
DI void moba_attn_qtile(Ctx& C, int l, int b, int h, int qt, const bf16* QB, const bf16* KBp, const bf16* VTp, const float* KSUM) {
    const int tid = C.tid, lane = C.lane, wave = C.wave, li = lane & 15, fq = lane >> 4;
    const int qb = qt >> 1, qpos = qt * 128 + wave * 16 + li;
    const size_t rowq = (size_t)b * SEQ + qpos;
    const float* mq = tmpbuf(C, T_MQ) + rowq * 256 + h * 64;
    const bf16* Kg = KBp + (size_t)b * SEQ * 256 + h * 64;
    const bf16* Vg = VTp + (size_t)(b * 4 + h) * 64 * SEQ;
    bf16x8v qf[2];
#pragma unroll
    for (int ks = 0; ks < 2; ++ks) qf[ks] = *(const bf16x8v*)(QB + rowq * 256 + h * 64 + 32 * ks + 8 * fq);
    unsigned selmask = 0u;
    if (qb > 0) {
        f32x4 qg[4];
#pragma unroll
        for (int j = 0; j < 4; ++j) qg[j] = *(const f32x4*)(mq + 16 * fq + 4 * j);
        float v1 = -3.0e38f, v2 = -3.0e38f, v3 = -3.0e38f; int i1 = -1, i2 = -1, i3 = -1;
        const float* km = KSUM + (size_t)b * 64 * 256 + h * 64 + 16 * fq;
        for (int n = 0; n < qb; ++n) { float g = 0.f;
#pragma unroll
            for (int c4 = 0; c4 < 4; ++c4)
#pragma unroll
            for (int j = 0; j < 4; ++j) { const f32x4 kv = *(const f32x4*)(km + (size_t)(4 * n + c4) * 256 + 4 * j); g += (qg[j].x * kv.x + qg[j].y * kv.y) + (qg[j].z * kv.z + qg[j].w * kv.w); }
            g += __shfl_xor(g, 16); g += __shfl_xor(g, 32);
            if (g > v1) { v3 = v2; i3 = i2; v2 = v1; i2 = i1; v1 = g; i1 = n; } else if (g > v2) { v3 = v2; i3 = i2; v2 = g; i2 = n; } else if (g > v3) { v3 = g; i3 = n; } }
        if (i1 >= 0) selmask |= 1u << i1; if (i2 >= 0) selmask |= 1u << i2; if (i3 >= 0) selmask |= 1u << i3;
    }
    const int ntile = qt * 2 + 2;
    f32x4 O[4]; float m = -1.0e30f, lsum = 0.f;
#pragma unroll
    for (int dt = 0; dt < 4; ++dt) O[dt] = (f32x4){0.f, 0.f, 0.f, 0.f};
    const int kkey = tid >> 3, kseg = tid & 7;
    LASQ unsigned char* L = C.lds;
    constexpr int AT_TB = AT_KB + AT_VB;
    u32x4 ka, va;
#define AT_LOAD(t) do { const int tl_ = ((t) < ntile) ? (t) : ntile - 1; ka = *(const GASQ u32x4*)(Kg + (size_t)(tl_ * 64 + kkey) * 256 + 8 * kseg); va = *(const GASQ u32x4*)(Vg + (size_t)kkey * SEQ + tl_ * 64 + 8 * kseg); } while (0)
#define AT_STORE(bo) do { *(LASQ u32x4*)(L + (bo) + kkey * AT_KS + kseg * 16) = ka; *(LASQ u32x4*)(L + (bo) + AT_KB + kkey * AT_VS + kseg * 16) = va; } while (0)
#define AT_QK(dst, bo) do { _Pragma("unroll") for (int nt = 0; nt < 4; ++nt) { dst[nt] = (f32x4){0.f, 0.f, 0.f, 0.f}; \
            _Pragma("unroll") for (int ks = 0; ks < 2; ++ks) { const bf16x8v kf = *(const LASQ bf16x8v*)(L + (bo) + (16 * nt + li) * AT_KS + (32 * ks + 8 * fq) * 2); dst[nt] = MFMA16(kf, qf[ks], dst[nt]); } } } while (0)
#define AT_BAR() do { asm volatile("s_waitcnt lgkmcnt(0)" ::: "memory"); __builtin_amdgcn_s_barrier(); asm volatile("" ::: "memory"); } while (0)
#define AT_STEP(OWN, t) do { \
        f32x4 sn[4]; \
        AT_QK(sn, b1); \
        const int key0 = (t) * 64; const float ninf = -__builtin_inff(); bool ok = true; \
        if (OWN) { _Pragma("unroll") for (int nt = 0; nt < 4; ++nt) _Pragma("unroll") for (int r = 0; r < 4; ++r) s[nt][r] = (key0 + 16 * nt + 4 * fq + r <= qpos) ? s[nt][r] : ninf; } \
        else ok = (selmask >> (key0 >> 8)) & 1u; \
        float mx = fmaxf(fmaxf(fmaxf(s[0][0], s[0][1]), fmaxf(s[0][2], s[0][3])), fmaxf(fmaxf(s[1][0], s[1][1]), fmaxf(s[1][2], s[1][3]))); \
        mx = fmaxf(mx, fmaxf(fmaxf(fmaxf(s[2][0], s[2][1]), fmaxf(s[2][2], s[2][3])), fmaxf(fmaxf(s[3][0], s[3][1]), fmaxf(s[3][2], s[3][3])))); \
        if (!OWN) mx = ok ? mx : ninf; \
        mx = fmaxf(mx, __shfl_xor(mx, 16)); mx = fmaxf(mx, __shfl_xor(mx, 32)); \
        const float mn = fmaxf(m, mx), alpha = __builtin_amdgcn_exp2f(m - mn); \
        const float mnb = (OWN || ok) ? mn : __builtin_inff(); \
        float ps = 0.f; f32x4 p[4]; \
        _Pragma("unroll") for (int nt = 0; nt < 4; ++nt) _Pragma("unroll") for (int r = 0; r < 4; ++r) { const float e_ = __builtin_amdgcn_exp2f(s[nt][r] - mnb); p[nt][r] = e_; ps += e_; } \
        lsum = lsum * alpha + ps; m = mn; \
        _Pragma("unroll") for (int dt = 0; dt < 4; ++dt) O[dt] *= alpha; \
        bf16x8v pf[2]; \
        _Pragma("unroll") for (int ks = 0; ks < 2; ++ks) pf[ks] = cvt8(p[2 * ks], p[2 * ks + 1]); \
        const LASQ unsigned char* VL = L + b0 + AT_KB; \
        _Pragma("unroll") for (int dt = 0; dt < 4; ++dt) _Pragma("unroll") for (int ks = 0; ks < 2; ++ks) { \
            const bf16x4v lo = *(const LASQ bf16x4v*)(VL + (16 * dt + li) * AT_VS + (32 * ks + 4 * fq) * 2), hi = *(const LASQ bf16x4v*)(VL + (16 * dt + li) * AT_VS + (32 * ks + 16 + 4 * fq) * 2); \
            O[dt] = MFMA16(__builtin_shufflevector(lo, hi, 0, 1, 2, 3, 4, 5, 6, 7), pf[ks], O[dt]); } \
        AT_STORE(b2);              \
        AT_LOAD((t) + 3); \
        AT_BAR(); \
        _Pragma("unroll") for (int nt = 0; nt < 4; ++nt) s[nt] = sn[nt]; \
        { const int bt_ = b0; b0 = b1; b1 = b2; b2 = bt_; } } while (0)
    int b0 = 0, b1 = AT_TB, b2 = 2 * AT_TB;
    AT_LOAD(0); AT_STORE(b0); AT_LOAD(1); AT_STORE(b1); AT_LOAD(2); __syncthreads();
    f32x4 s[4]; AT_QK(s, b0);
    const int npast = qb * 4;
    for (int t = 0; t < npast; ++t) AT_STEP(false, t);
    for (int t = npast; t < ntile; ++t) AT_STEP(true, t);
    __syncthreads();
#undef AT_STEP
#undef AT_QK
#undef AT_BAR
#undef AT_LOAD
#undef AT_STORE
    lsum += __shfl_xor(lsum, 16); lsum += __shfl_xor(lsum, 32);
    const float inv = 1.f / lsum;
    bf16* yd = ybuf(C, 3) + rowq * 256 + h * 64;
#pragma unroll
    for (int dt = 0; dt < 4; ++dt) { u32x2 w; w.x = pg8::cvt_pk_bf16(O[dt][0] * inv, O[dt][1] * inv); w.y = pg8::cvt_pk_bf16(O[dt][2] * inv, O[dt][3] * inv); *(u32x2*)(yd + 16 * dt + 4 * fq) = w; }
}

constexpr size_t WS_GLA = WS_END;
constexpr size_t GLA_VT = WS_GLA, GLA_DST = GLA_VT + (size_t)1024 * 4096 * 2, GLA_SC = GLA_DST + (size_t)1024 * 4096 * 4, GLA_DEC = GLA_SC + (size_t)1024 * 4096 * 4,
                 GLA_Q = GLA_DEC + (size_t)1024 * 64 * 4, GLA_K = GLA_Q + (size_t)MPAD * 256 * 2, WS_END2 = GLA_K + (size_t)MPAD * 256 * 2;
DI bf16* glaQ(const Ctx& C) { return (bf16*)(C.ws + GLA_Q); }
DI bf16* glaK(const Ctx& C) { return (bf16*)(C.ws + GLA_K); }
constexpr int LT = 72;

DI void gla_prep_chunk(Ctx& C, int l, int b, int c) {
    const int tid = C.tid, lane = C.lane, wave = C.wave, h = wave >> 1, rh = wave & 1, li = lane & 15, fq = lane >> 4;
    const size_t row0 = (size_t)b * SEQ + (size_t)c * 64; const int unit = ((b * 64 + c) * 4 + h);
    LASQ unsigned char* L = C.lds;
    LASQ float* LR = (LASQ float*)L; LASQ float* TOT = (LASQ float*)(L + 4096) + h * 64; LASQ float* BL = (LASQ float*)(L + 5120) + h * 64;
    LASQ unsigned char* KT = L + 8192 + h * (2 * 64 * LT * 2); LASQ unsigned char* VT = KT + 64 * LT * 2;
    if (tid < 256) { const int t = tid >> 2, r4 = tid & 3; *(LASQ f32x4*)(LR + t * 16 + 4 * r4) = *(const f32x4*)(projp(C) + (row0 + t) * NP + C_LR + 4 * r4); }
    float wg[16];
#pragma unroll
    for (int r = 0; r < 16; ++r) wg[r] = inF(C, 22)[(size_t)l * 16 * 256 + r * 256 + h * 64 + lane];
    const float bgv = inF(C, 23)[l * 256 + h * 64 + lane];
    __syncthreads();
    float qv[32], kv[32], vv[32];
#pragma unroll
    for (int i = 0; i < 32; ++i) { const float* pr = projp(C) + (row0 + 32 * rh + i) * NP + h * 64 + lane; qv[i] = pr[C_AQ]; kv[i] = pr[C_AK]; vv[i] = pr[C_AV]; }
    float bc[32]; float run = 0.f;
#pragma unroll
    for (int i = 0; i < 32; ++i) { const int t = 32 * rh + i; float x = bgv;
#pragma unroll
        for (int r4 = 0; r4 < 4; ++r4) { const f32x4 lr = *(const LASQ f32x4*)(LR + t * 16 + 4 * r4); x += lr.x * wg[4 * r4] + lr.y * wg[4 * r4 + 1] + lr.z * wg[4 * r4 + 2] + lr.w * wg[4 * r4 + 3]; }
        run += logsigmoid_(x) * (1.f / 16.f); bc[i] = run; }
    if (rh == 0) TOT[lane] = run;
    __syncthreads();
    if (rh == 1) { const float off = TOT[lane];
#pragma unroll
        for (int i = 0; i < 32; ++i) bc[i] += off;
        BL[lane] = bc[31]; }
    __syncthreads();
    float* BCg = tmpbuf(C, T_LA); bf16* Qg = glaQ(C); bf16* Kg = glaK(C);
    bf16* VTg = (bf16*)(C.ws + GLA_VT) + (size_t)unit * 4096;
#pragma unroll
    for (int g8 = 0; g8 < 4; ++g8) {
        float kt[8];
#pragma unroll
        for (int e = 0; e < 8; ++e) { const int i = 8 * g8 + e; const size_t row = row0 + 32 * rh + i;
            BCg[row * 256 + h * 64 + lane] = bc[i];
            const float ep = __expf(bc[i]), en = __expf(-bc[i]); kt[e] = kv[i] * en;
            Qg[row * 256 + h * 64 + lane] = (bf16)f2bf(qv[i] * 0.125f * ep); Kg[row * 256 + h * 64 + lane] = (bf16)f2bf(kt[e]); }
        u32x4 kw, vw; kw.x = pk2(kt[0], kt[1]); kw.y = pk2(kt[2], kt[3]); kw.z = pk2(kt[4], kt[5]); kw.w = pk2(kt[6], kt[7]);
        vw.x = pk2(vv[8 * g8], vv[8 * g8 + 1]); vw.y = pk2(vv[8 * g8 + 2], vv[8 * g8 + 3]); vw.z = pk2(vv[8 * g8 + 4], vv[8 * g8 + 5]); vw.w = pk2(vv[8 * g8 + 6], vv[8 * g8 + 7]);
        *(LASQ u32x4*)(KT + lane * (LT * 2) + (32 * rh + 8 * g8) * 2) = kw; *(LASQ u32x4*)(VT + lane * (LT * 2) + (32 * rh + 8 * g8) * 2) = vw;
        *(u32x4*)(VTg + lane * 64 + 32 * rh + 8 * g8) = vw; }
    __syncthreads();
    float* DSTg = (float*)(C.ws + GLA_DST) + (size_t)unit * 4096;
#pragma unroll
    for (int at = 0; at < 2; ++at) { const int d0 = 16 * (2 * rh + at);
        bf16x8v af[2];
#pragma unroll
        for (int ks = 0; ks < 2; ++ks) af[ks] = *(const LASQ bf16x8v*)(KT + (d0 + li) * (LT * 2) + (32 * ks + 8 * fq) * 2);
        const f32x4 eb = {__expf(BL[d0 + 4 * fq]), __expf(BL[d0 + 4 * fq + 1]), __expf(BL[d0 + 4 * fq + 2]), __expf(BL[d0 + 4 * fq + 3])};
#pragma unroll
        for (int bt = 0; bt < 4; ++bt) { f32x4 acc = {0.f, 0.f, 0.f, 0.f};
#pragma unroll
            for (int ks = 0; ks < 2; ++ks) { const bf16x8v bf = *(const LASQ bf16x8v*)(VT + (16 * bt + li) * (LT * 2) + (32 * ks + 8 * fq) * 2); acc = MFMA16(af[ks], bf, acc); }
            *(f32x4*)(DSTg + (16 * bt + li) * 64 + d0 + 4 * fq) = acc * eb; } }
    if (rh == 0) ((float*)(C.ws + GLA_DEC))[(size_t)unit * 64 + lane] = __expf(BL[lane]);
    __syncthreads();
}
DI void gla_scan_item(Ctx& C, int l, int it) {
    const int lane = C.lane, b = it >> 8, h = (it >> 6) & 3, v = it & 63;
    const float* DST = (const float*)(C.ws + GLA_DST); float* SC = (float*)(C.ws + GLA_SC); const float* DEC = (const float*)(C.ws + GLA_DEC);
    float S = 0.f;
    for (int c0 = 0; c0 < 64; c0 += 8) { float ds[8], de[8];
#pragma unroll
        for (int e = 0; e < 8; ++e) { const size_t u = (size_t)((b * 64 + c0 + e) * 4 + h); ds[e] = DST[u * 4096 + v * 64 + lane]; de[e] = DEC[u * 64 + lane]; }
#pragma unroll
        for (int e = 0; e < 8; ++e) { const size_t u = (size_t)((b * 64 + c0 + e) * 4 + h); SC[u * 4096 + v * 64 + lane] = S; S = de[e] * S + ds[e]; } }
    C.out[O_PGLA + (((size_t)(l * NB + b) * 4 + h) * 64 + lane) * 64 + v] = S;
}
DI void gla_out_chunk(Ctx& C, int l, int b, int c) {
    const int tid = C.tid, lane = C.lane, wave = C.wave, h = wave >> 1, rh = wave & 1, li = lane & 15, fq = lane >> 4;
    const size_t row0 = (size_t)b * SEQ + (size_t)c * 64; const int unit = ((b * 64 + c) * 4 + h);
    LASQ unsigned char* L = C.lds; constexpr int TB = 64 * LT * 2;
    LASQ unsigned char* KL = L + h * (3 * TB); LASQ unsigned char* VT = KL + TB; LASQ unsigned char* ST = VT + TB;
    {
        const int x = (rh << 6) | lane, r = x >> 1, hf = x & 1;
        const bf16* kg = glaK(C) + (row0 + r) * 256 + h * 64 + 32 * hf; const bf16* vg = (const bf16*)(C.ws + GLA_VT) + (size_t)unit * 4096 + r * 64 + 32 * hf;
        const float* sg = (const float*)(C.ws + GLA_SC) + (size_t)unit * 4096 + r * 64 + 32 * hf;
#pragma unroll
        for (int e = 0; e < 4; ++e) { *(LASQ u32x4*)(KL + r * (LT * 2) + (32 * hf + 8 * e) * 2) = *(const u32x4*)(kg + 8 * e); *(LASQ u32x4*)(VT + r * (LT * 2) + (32 * hf + 8 * e) * 2) = *(const u32x4*)(vg + 8 * e);
            const f32x4 s0 = *(const f32x4*)(sg + 8 * e), s1 = *(const f32x4*)(sg + 8 * e + 4); *(LASQ bf16x8v*)(ST + r * (LT * 2) + (32 * hf + 8 * e) * 2) = cvt8(s0, s1); }
    }
    __syncthreads();
    const float* gnp = inF(C, 24) + l * 64;
#pragma unroll 1
    for (int bt = 0; bt < 2; ++bt) { const int iq = 32 * rh + 16 * bt + li; const size_t row = row0 + iq;
        bf16x8v qf[2];
#pragma unroll
        for (int ks = 0; ks < 2; ++ks) qf[ks] = *(const bf16x8v*)(glaQ(C) + row * 256 + h * 64 + 32 * ks + 8 * fq);
        f32x4 s[4];
#pragma unroll
        for (int jt = 0; jt < 4; ++jt) { s[jt] = (f32x4){0.f, 0.f, 0.f, 0.f};
#pragma unroll
            for (int ks = 0; ks < 2; ++ks) { const bf16x8v kf = *(const LASQ bf16x8v*)(KL + (16 * jt + li) * (LT * 2) + (32 * ks + 8 * fq) * 2); s[jt] = MFMA16(kf, qf[ks], s[jt]); }
#pragma unroll
            for (int r = 0; r < 4; ++r) s[jt][r] = (16 * jt + 4 * fq + r <= iq) ? s[jt][r] : 0.f; }
        bf16x8v pf[2];
#pragma unroll
        for (int ks = 0; ks < 2; ++ks) pf[ks] = cvt8(s[2 * ks], s[2 * ks + 1]);
        f32x4 o[4]; float ss = 0.f;
#pragma unroll
        for (int vt = 0; vt < 4; ++vt) { o[vt] = (f32x4){0.f, 0.f, 0.f, 0.f};
#pragma unroll
            for (int ks = 0; ks < 2; ++ks) { const LASQ unsigned char* vr = VT + (16 * vt + li) * (LT * 2);
                const bf16x4v lo = *(const LASQ bf16x4v*)(vr + (32 * ks + 4 * fq) * 2), hi = *(const LASQ bf16x4v*)(vr + (32 * ks + 16 + 4 * fq) * 2);
                o[vt] = MFMA16(__builtin_shufflevector(lo, hi, 0, 1, 2, 3, 4, 5, 6, 7), pf[ks], o[vt]);
                const bf16x8v sf = *(const LASQ bf16x8v*)(ST + (16 * vt + li) * (LT * 2) + (32 * ks + 8 * fq) * 2); o[vt] = MFMA16(sf, qf[ks], o[vt]); }
            ss += (o[vt][0] * o[vt][0] + o[vt][1] * o[vt][1]) + (o[vt][2] * o[vt][2] + o[vt][3] * o[vt][3]); }
        ss += __shfl_xor(ss, 16); ss += __shfl_xor(ss, 32);
        const float rinv = rsq_(ss * (1.f / 64.f) + 1e-6f);
        const float* ar = projp(C) + row * NP + C_AR + h * 64; bf16* yb = ybuf(C, 1) + row * 256 + h * 64;
#pragma unroll
        for (int vt = 0; vt < 4; ++vt) { const f32x4 g = *(const f32x4*)(ar + 16 * vt + 4 * fq), gn = *(const f32x4*)(gnp + 16 * vt + 4 * fq);
            u32x2 w; w.x = pg8::cvt_pk_bf16(o[vt][0] * rinv * gn.x * silu_(g.x), o[vt][1] * rinv * gn.y * silu_(g.y)); w.y = pg8::cvt_pk_bf16(o[vt][2] * rinv * gn.z * silu_(g.z), o[vt][3] * rinv * gn.w * silu_(g.w));
            *(u32x2*)(yb + 16 * vt + 4 * fq) = w; } }
    __syncthreads();
}

typedef float f32x2 __attribute__((ext_vector_type(2)));
constexpr size_t WS_S5 = WS_END2;
constexpr size_t S5_P = WS_S5;
constexpr size_t S5_CC = S5_P + (size_t)2 * 16 * 36 * 64 * 4;
constexpr size_t S5_WGT = S5_CC + (size_t)2 * 16 * 16 * 128 * 2;
constexpr size_t S5_E = S5_WGT + (size_t)2 * 256 * 256 * 2;
constexpr size_t S5_HIN = S5_E + (size_t)256 * 16 * 128 * 4;
constexpr size_t S5_YSB = S5_HIN + (size_t)256 * 16 * 128 * 4;
constexpr size_t ROPE_TAB = S5_YSB + 32 * 256 * 2;
constexpr size_t WS_END3 = ROPE_TAB + (size_t)(SEQ + 1) * 16 * 4;
DI void rope_item(Ctx& C, int it) {
    const int lane = C.lane, idx = 4 * it + (lane >> 4), j = lane & 15; if (idx > SEQ) return;
    const float pos = (idx == SEQ) ? (float)PAST : (float)idx; const float ang = pos * powf(500000.f, -(float)(j & 7) * 0.125f);
    ((float*)(C.ws + ROPE_TAB))[(size_t)idx * 16 + j] = (j < 8) ? cosf(ang) : sinf(ang);
}
DI void s5_param_item(Ctx& C, int it) {
    const int lane = C.lane, l = it >> 4, g = it & 15, pg = (l * 16 + g) * 64 + lane;
    const float dt = expf(inF(C, 14)[l * 16 + g]); const float ar = inF(C, 12)[pg], ai = inF(C, 13)[pg];
    const float mag = expf(ar * dt), ang = ai * dt, are = mag * cosf(ang), aim = mag * sinf(ang);
    const float den = ar * ar + ai * ai, nr = are - 1.f, fre = (nr * ar + aim * ai) / den, fim = (aim * ar - nr * ai) / den;
    float* P = (float*)(C.ws + S5_P) + (size_t)(l * 16 + g) * 36 * 64 + lane;
    float pr = are, pi = aim;
#pragma unroll
    for (int k = 0; k < 6; ++k) { const float nr2 = pr * pr - pi * pi, ni2 = 2.f * pr * pi; pr = nr2; pi = ni2; }
    P[0] = are; P[64] = aim; P[128] = pr; P[192] = pi;
#pragma unroll
    for (int c = 0; c < 16; ++c) { const float br = inF(C, 15)[(size_t)pg * 16 + c], bi = inF(C, 16)[(size_t)pg * 16 + c]; P[(4 + c) * 64] = fre * br - fim * bi; P[(20 + c) * 64] = fre * bi + fim * br; }
    unsigned* CC = (unsigned*)(C.ws + S5_CC) + (size_t)(l * 16 + g) * 16 * 64;
#pragma unroll
    for (int c = 0; c < 16; ++c) CC[c * 64 + lane] = pk2(inF(C, 17)[((size_t)(l * 16 + g) * 16 + c) * 64 + lane], -inF(C, 18)[((size_t)(l * 16 + g) * 16 + c) * 64 + lane]);
}
DI void s5_pass1_chunk(Ctx& C, int l, int b, int c) {
    const int lane = C.lane, wave = C.wave; const size_t row0 = (size_t)b * SEQ + (size_t)c * 64;
    LASQ float* US = (LASQ float*)(C.lds + wave * 4096);
#pragma unroll 1
    for (int gi = 0; gi < 2; ++gi) { const int g = 2 * wave + gi;
        { const float* up = projp(C) + (row0 + lane) * NP + C_S5U + g * 16;
#pragma unroll
          for (int j = 0; j < 4; ++j) *(LASQ f32x4*)(US + lane * 16 + 4 * j) = *(const f32x4*)(up + 4 * j); }
        const float* P = (const float*)(C.ws + S5_P) + (size_t)(l * 16 + g) * 36 * 64 + lane;
        const float are = P[0], aim = P[64]; f32x2 bb[16];
#pragma unroll
        for (int k = 0; k < 16; ++k) { bb[k].x = P[(4 + k) * 64]; bb[k].y = P[(20 + k) * 64]; }
        asm volatile("s_waitcnt lgkmcnt(0)" ::: "memory");
        float hr = 0.f, hi = 0.f;
#pragma unroll 4
        for (int t = 0; t < 64; ++t) { f32x2 xa = {0.f, 0.f}, xb = {0.f, 0.f};
#pragma unroll
            for (int j = 0; j < 4; ++j) { const f32x4 u = *(const LASQ f32x4*)(US + t * 16 + 4 * j);
                xa += bb[4 * j] * u.x + bb[4 * j + 1] * u.y; xb += bb[4 * j + 2] * u.z + bb[4 * j + 3] * u.w; }
            const float xr = xa.x + xb.x, xi = xa.y + xb.y;
            const float nhr = are * hr - aim * hi + xr, nhi = are * hi + aim * hr + xi; hr = nhr; hi = nhi; }
        float* E = (float*)(C.ws + S5_E) + ((size_t)((b * 64 + c) * 16 + g)) * 128; E[lane] = hr; E[64 + lane] = hi;
        asm volatile("s_waitcnt lgkmcnt(0)" ::: "memory");
    }
    __syncthreads();
}
DI void s5_carry_item(Ctx& C, int l, int it) {
    const int lane = C.lane, b = it >> 4, g = it & 15;
    const float* P = (const float*)(C.ws + S5_P) + (size_t)(l * 16 + g) * 36 * 64 + lane; const float a6r = P[128], a6i = P[192];
    const float* E = (const float*)(C.ws + S5_E); float* HIN = (float*)(C.ws + S5_HIN);
    float hr = 0.f, hi = 0.f;
    for (int c0 = 0; c0 < 64; c0 += 8) { float er[8], ei[8];
#pragma unroll
        for (int e = 0; e < 8; ++e) { const size_t o = ((size_t)((b * 64 + c0 + e) * 16 + g)) * 128; er[e] = E[o + lane]; ei[e] = E[o + 64 + lane]; }
#pragma unroll
        for (int e = 0; e < 8; ++e) { const size_t o = ((size_t)((b * 64 + c0 + e) * 16 + g)) * 128; HIN[o + lane] = hr; HIN[o + 64 + lane] = hi;
            const float nr = a6r * hr - a6i * hi + er[e], ni = a6r * hi + a6i * hr + ei[e]; hr = nr; hi = ni; } }
    const size_t so = ((size_t)(l * NB + b) * 16 + g) * 64 + lane; C.out[O_PS5R + so] = hr; C.out[O_PS5I + so] = hi;
}
constexpr int S5_HP = 136, S5_YP = 264;
DI void s5_out_chunk(Ctx& C, int l, int b, int c) {
    const int lane = C.lane, wave = C.wave, li = lane & 15, fq = lane >> 4; const size_t row0 = (size_t)b * SEQ + (size_t)c * 64;
    LASQ float* US = (LASQ float*)(C.lds + wave * 8448); LASQ unsigned char* HS = C.lds + wave * 8448 + 4096; LASQ unsigned char* Y = C.lds + 8 * 8448;
#pragma unroll 1
    for (int gi = 0; gi < 2; ++gi) { const int g = 2 * wave + gi;
        { const float* up = projp(C) + (row0 + lane) * NP + C_S5U + g * 16;
#pragma unroll
          for (int j = 0; j < 4; ++j) *(LASQ f32x4*)(US + lane * 16 + 4 * j) = *(const f32x4*)(up + 4 * j); }
        const float* P = (const float*)(C.ws + S5_P) + (size_t)(l * 16 + g) * 36 * 64 + lane;
        const float are = P[0], aim = P[64]; f32x2 bb[16];
#pragma unroll
        for (int k = 0; k < 16; ++k) { bb[k].x = P[(4 + k) * 64]; bb[k].y = P[(20 + k) * 64]; }
        bf16x8v cf[4];
        { const bf16* cc = (const bf16*)(C.ws + S5_CC) + ((size_t)(l * 16 + g) * 16 + li) * 128;
#pragma unroll
          for (int ks = 0; ks < 4; ++ks) cf[ks] = *(const bf16x8v*)(cc + 32 * ks + 8 * fq); }
        const f32x4 dd = *(const f32x4*)(inF(C, 19) + l * 256 + g * 16 + 4 * fq);
        const float* HIN = (const float*)(C.ws + S5_HIN) + ((size_t)((b * 64 + c) * 16 + g)) * 128; float hr = HIN[lane], hi = HIN[64 + lane];
        asm volatile("s_waitcnt lgkmcnt(0)" ::: "memory");
#pragma unroll 1
        for (int tb = 0; tb < 4; ++tb) {
#pragma unroll 4
            for (int i = 0; i < 16; ++i) { const int t = 16 * tb + i; f32x2 xa = {0.f, 0.f}, xb = {0.f, 0.f};
#pragma unroll
                for (int j = 0; j < 4; ++j) { const f32x4 u = *(const LASQ f32x4*)(US + t * 16 + 4 * j);
                    xa += bb[4 * j] * u.x + bb[4 * j + 1] * u.y; xb += bb[4 * j + 2] * u.z + bb[4 * j + 3] * u.w; }
                const float xr = xa.x + xb.x, xi = xa.y + xb.y;
                const float nhr = are * hr - aim * hi + xr, nhi = are * hi + aim * hr + xi; hr = nhr; hi = nhi;
                *(LASQ unsigned*)(HS + i * (S5_HP * 2) + 4 * lane) = pk2(hr, hi); }
            asm volatile("s_waitcnt lgkmcnt(0)" ::: "memory");
            f32x4 acc = {0.f, 0.f, 0.f, 0.f};
#pragma unroll
            for (int ks = 0; ks < 4; ++ks) { const bf16x8v hf = *(const LASQ bf16x8v*)(HS + li * (S5_HP * 2) + (32 * ks + 8 * fq) * 2); acc = MFMA16(cf[ks], hf, acc); }
            const f32x4 u = *(const LASQ f32x4*)(US + (16 * tb + li) * 16 + 4 * fq);
            u32x2 w; w.x = pg8::cvt_pk_bf16(gelu_tanh_(acc[0] + dd.x * u.x), gelu_tanh_(acc[1] + dd.y * u.y)); w.y = pg8::cvt_pk_bf16(gelu_tanh_(acc[2] + dd.z * u.z), gelu_tanh_(acc[3] + dd.w * u.w));
            *(LASQ u32x2*)(Y + (16 * tb + li) * (S5_YP * 2) + (g * 16 + 4 * fq) * 2) = w;
            asm volatile("s_waitcnt lgkmcnt(0)" ::: "memory");
        }
    }
    __syncthreads();
    f32x4 z[2][4];
#pragma unroll
    for (int at = 0; at < 2; ++at)
#pragma unroll
        for (int bt = 0; bt < 4; ++bt) z[at][bt] = (f32x4){0.f, 0.f, 0.f, 0.f};
    const bf16* wg = (const bf16*)(C.ws + S5_WGT) + (size_t)l * 256 * 256;
#pragma unroll 2
    for (int ks = 0; ks < 8; ++ks) { bf16x8v af[2], bfr[4];
#pragma unroll
        for (int at = 0; at < 2; ++at) af[at] = *(const bf16x8v*)(wg + (size_t)(32 * wave + 16 * at + li) * 256 + 32 * ks + 8 * fq);
#pragma unroll
        for (int bt = 0; bt < 4; ++bt) bfr[bt] = *(const LASQ bf16x8v*)(Y + (16 * bt + li) * (S5_YP * 2) + (32 * ks + 8 * fq) * 2);
#pragma unroll
        for (int at = 0; at < 2; ++at)
#pragma unroll
            for (int bt = 0; bt < 4; ++bt) z[at][bt] = MFMA16(af[at], bfr[bt], z[at][bt]); }
#pragma unroll
    for (int at = 0; at < 2; ++at) { const int n0 = 32 * wave + 16 * at + 4 * fq; const f32x4 bg = *(const f32x4*)(inF(C, 21) + l * 256 + n0);
#pragma unroll
        for (int bt = 0; bt < 4; ++bt) { const int t = 16 * bt + li; const u32x2 yw = *(const LASQ u32x2*)(Y + t * (S5_YP * 2) + n0 * 2);
            u32x2 w; w.x = pg8::cvt_pk_bf16(bflo(yw.x) * sigmoid_(z[at][bt][0] + bg.x), bfhi(yw.x) * sigmoid_(z[at][bt][1] + bg.y)); w.y = pg8::cvt_pk_bf16(bflo(yw.y) * sigmoid_(z[at][bt][2] + bg.z), bfhi(yw.y) * sigmoid_(z[at][bt][3] + bg.w));
            *(u32x2*)(ybuf(C, 0) + (row0 + t) * 256 + n0) = w; } }
    __syncthreads();
}
#ifndef GDN_CUT
#define GDN_CUT 4
#endif

constexpr size_t WS_GDN = WS_END3;
constexpr size_t GDN_Q = WS_GDN, GDN_K = GDN_Q + (size_t)MPAD * 256 * 2;
constexpr size_t GDN_GC = GDN_K + (size_t)MPAD * 256 * 2, GDN_BE = GDN_GC + 1024 * 64 * 4;
constexpr size_t GDN_W = GDN_BE + 1024 * 64 * 4;
constexpr size_t GDN_UT = GDN_W + (size_t)1024 * 4096 * 2;
constexpr size_t GDN_AC = GDN_UT + (size_t)1024 * 4096 * 4;
constexpr size_t GDN_BCT = GDN_AC + (size_t)1024 * 4096 * 4;
constexpr size_t GDN_SC = GDN_BCT + (size_t)1024 * 4096 * 4;
constexpr size_t WS_END4 = GDN_SC + (size_t)1024 * 4096 * 4;
constexpr int GD_MP = 72;
constexpr int GD_HSZ = 512 + 64 * LT * 2 + 64 * GD_MP * 4;
DI float wave_incl_scan(float x, int lane) {
#pragma unroll
    for (int o = 1; o < 64; o <<= 1) { const float y = __shfl_up(x, o); if (lane >= o) x += y; }
    return x;
}
#define GDN_CONV64(out, chan_off, cwp)  do { const float w0 = (cwp)[0], w1 = (cwp)[768], w2 = (cwp)[2 * 768], w3 = (cwp)[3 * 768]; \
        const float* p0 = projp(C) + row0 * NP + (chan_off); float x0 = 0.f, x1 = 0.f, x2 = 0.f; \
        if (c > 0) { x0 = *(p0 - 3 * (size_t)NP); x1 = *(p0 - 2 * (size_t)NP); x2 = *(p0 - (size_t)NP); } \
        _Pragma("unroll") for (int t = 0; t < 64; ++t) { const float x3 = p0[(size_t)t * NP]; out[t] = silu_(w0 * x0 + w1 * x1 + w2 * x2 + w3 * x3); x0 = x1; x1 = x2; x2 = x3; } } while (0)
DI void gdn_prep_chunk(Ctx& C, int l, int b, int c) {
    const int lane = C.lane, wave = C.wave, h = wave >> 1, role = wave & 1, li = lane & 15, fq = lane >> 4;
    const size_t row0 = (size_t)b * SEQ + (size_t)c * 64; const int unit = ((b * 64 + c) * 4 + h);
    LASQ unsigned char* HB = C.lds + h * GD_HSZ;
    LASQ float* GC = (LASQ float*)HB; LASQ float* BE = GC + 64; LASQ unsigned char* KH = HB + 512; LASQ float* M = (LASQ float*)(HB + 512 + 64 * LT * 2);
    const float* cw = inF(C, 25) + (size_t)l * 4 * 768;
    float X[64];
    if (role == 0) {
        {
            const float* pr = projp(C) + (row0 + lane) * NP; const float beta = sigmoid_(pr[C_DB + h]);
            const float g = -expf(inF(C, 26)[l * 4 + h]) * softplus_(pr[C_DA + h] + inF(C, 27)[l * 4 + h]);
            const float gc = wave_incl_scan(g, lane); GC[lane] = gc; BE[lane] = beta;
            ((float*)(C.ws + GDN_GC))[(size_t)unit * 64 + lane] = gc; ((float*)(C.ws + GDN_BE))[(size_t)unit * 64 + lane] = beta; }
        GDN_CONV64(X, C_DK + h * 64 + lane, cw + 256 + h * 64 + lane);
        bf16* Kg = (bf16*)(C.ws + GDN_K) + row0 * 256 + h * 64 + lane;
#pragma unroll
        for (int t = 0; t < 64; ++t) { X[t] *= rsq_(wsum(X[t] * X[t]) + 1e-6f); const unsigned short kb = (unsigned short)f2bf(X[t]);
            *(LASQ unsigned short*)(KH + t * (LT * 2) + lane * 2) = kb; Kg[(size_t)t * 256] = kb; }
    } else {
        {
            float Qv[64];
            GDN_CONV64(Qv, C_DQ + h * 64 + lane, cw + h * 64 + lane);
            bf16* Qg = (bf16*)(C.ws + GDN_Q) + row0 * 256 + h * 64 + lane;
#pragma unroll
            for (int t = 0; t < 64; ++t) Qg[(size_t)t * 256] = (bf16)f2bf(Qv[t] * (0.125f * rsq_(wsum(Qv[t] * Qv[t]) + 1e-6f)));
        }
        asm volatile("" ::: "memory");
        GDN_CONV64(X, C_DV + h * 64 + lane, cw + 512 + h * 64 + lane);
    }
    __syncthreads();
#if GDN_CUT >= 1
    {
        float zf; asm volatile("v_mov_b32 %0, 0" : "=v"(zf));
#pragma unroll
        for (int it = 0; it < 2; ++it) { const int i0 = 16 * (2 * role + it); bf16x8v bfr[2];
#pragma unroll
            for (int ks = 0; ks < 2; ++ks) bfr[ks] = *(const LASQ bf16x8v*)(KH + (i0 + li) * (LT * 2) + (32 * ks + 8 * fq) * 2);
            const float gi = GC[i0 + li];
#pragma unroll
            for (int jt = 0; jt < 4; ++jt) { f32x4 acc = {0.f, 0.f, 0.f, 0.f};
#pragma unroll
                for (int ks = 0; ks < 2; ++ks) { const bf16x8v af = *(const LASQ bf16x8v*)(KH + (16 * jt + li) * (LT * 2) + (32 * ks + 8 * fq) * 2); acc = MFMA16(af, bfr[ks], acc); }
                f32x4 mv;
#pragma unroll
                for (int r = 0; r < 4; ++r) { const int j = 16 * jt + 4 * fq + r; mv[r] = (i0 + li > j) ? __expf(gi - GC[j]) * BE[j] * acc[r] : zf; }
                *(LASQ f32x4*)(M + (i0 + li) * GD_MP + 16 * jt + 4 * fq) = mv; } }
    }
#endif
    __syncthreads();
    const float glast = GC[63];
#if GDN_CUT >= 2
    if (role == 0) {
#pragma unroll
        for (int j8 = 0; j8 < 8; ++j8) { float kw[8];
#pragma unroll
            for (int e = 0; e < 8; ++e) { const int j = 8 * j8 + e; kw[e] = X[j] * __expf(glast - GC[j]) * BE[j]; }
            u32x4 w; w.x = pk2(kw[0], kw[1]); w.y = pk2(kw[2], kw[3]); w.z = pk2(kw[4], kw[5]); w.w = pk2(kw[6], kw[7]);
            *(LASQ u32x4*)(KH + lane * (LT * 2) + j8 * 16) = w; }
#pragma unroll
        for (int i = 0; i < 64; ++i) X[i] *= __expf(GC[i]);
    }
#endif
#if GDN_CUT >= 3
#pragma unroll
    for (int i = 1; i < 64; ++i) { float s = 0.f;
#pragma unroll
        for (int j4 = 0; j4 < (i + 3) / 4; ++j4) { const f32x4 mr = *(const LASQ f32x4*)(M + i * GD_MP + 4 * j4);
            s += mr.x * X[4 * j4];
            if (4 * j4 + 1 < i) s += mr.y * X[4 * j4 + 1];
            if (4 * j4 + 2 < i) s += mr.z * X[4 * j4 + 2];
            if (4 * j4 + 3 < i) s += mr.w * X[4 * j4 + 3]; }
        X[i] -= s; asm volatile("" : "+v"(X[i]) :: "memory"); }
#endif
    __syncthreads();
    LASQ unsigned char* WT = (LASQ unsigned char*)M; LASQ unsigned char* UT = WT + 64 * LT * 2;
    {   LASQ unsigned char* dst = (role == 0 ? WT : UT) + lane * (LT * 2);
#pragma unroll
        for (int j8 = 0; j8 < 8; ++j8) { u32x4 w; w.x = pk2(X[8 * j8], X[8 * j8 + 1]); w.y = pk2(X[8 * j8 + 2], X[8 * j8 + 3]); w.z = pk2(X[8 * j8 + 4], X[8 * j8 + 5]); w.w = pk2(X[8 * j8 + 6], X[8 * j8 + 7]);
            *(LASQ u32x4*)(dst + j8 * 16) = w; }
        if (role == 0) { bf16* Wg = (bf16*)(C.ws + GDN_W) + (size_t)unit * 4096 + lane;
#pragma unroll
            for (int i = 0; i < 64; ++i) Wg[i * 64] = (bf16)f2bf(X[i]); }
        else { float* Ug = (float*)(C.ws + GDN_UT) + (size_t)unit * 4096 + lane * 64;
#pragma unroll
            for (int i4 = 0; i4 < 16; ++i4) *(f32x4*)(Ug + 4 * i4) = (f32x4){X[4 * i4], X[4 * i4 + 1], X[4 * i4 + 2], X[4 * i4 + 3]}; }
    }
    __syncthreads();
#if GDN_CUT >= 4
    if (role == 0) {
        bf16* ACh = (bf16*)(C.ws + GDN_AC) + (size_t)unit * 4096; bf16* ACl = ACh + (size_t)1024 * 4096; const float eg = __expf(glast);
#pragma unroll 1
        for (int bt = 0; bt < 4; ++bt) { bf16x8v bfr[2];
#pragma unroll
            for (int ks = 0; ks < 2; ++ks) bfr[ks] = *(const LASQ bf16x8v*)(KH + (16 * bt + li) * (LT * 2) + (32 * ks + 8 * fq) * 2);
#pragma unroll
            for (int at = 0; at < 4; ++at) { f32x4 acc = {0.f, 0.f, 0.f, 0.f};
#pragma unroll
                for (int ks = 0; ks < 2; ++ks) { const bf16x8v af = *(const LASQ bf16x8v*)(WT + (16 * at + li) * (LT * 2) + (32 * ks + 8 * fq) * 2); acc = MFMA16(af, bfr[ks], acc); }
                f32x4 o;
#pragma unroll
                for (int r = 0; r < 4; ++r) o[r] = ((16 * at + 4 * fq + r) == (16 * bt + li) ? eg : 0.f) - acc[r];
                u32x2 wh, wl; wh.x = pg8::cvt_pk_bf16(o[0], o[1]); wh.y = pg8::cvt_pk_bf16(o[2], o[3]);
                wl.x = pg8::cvt_pk_bf16(o[0] - bflo(wh.x), o[1] - bfhi(wh.x)); wl.y = pg8::cvt_pk_bf16(o[2] - bflo(wh.y), o[3] - bfhi(wh.y));
                const int pos = (16 * bt + li) * 64 + 32 * (at >> 1) + 8 * fq + 4 * (at & 1);
                *(u32x2*)(ACh + pos) = wh; *(u32x2*)(ACl + pos) = wl; } }
    } else {
        float* BCg = (float*)(C.ws + GDN_BCT) + (size_t)unit * 4096;
#pragma unroll 1
        for (int bt = 0; bt < 4; ++bt) { bf16x8v bfr[2];
#pragma unroll
            for (int ks = 0; ks < 2; ++ks) bfr[ks] = *(const LASQ bf16x8v*)(UT + (16 * bt + li) * (LT * 2) + (32 * ks + 8 * fq) * 2);
#pragma unroll
            for (int at = 0; at < 4; ++at) { f32x4 acc = {0.f, 0.f, 0.f, 0.f};
#pragma unroll
                for (int ks = 0; ks < 2; ++ks) { const bf16x8v af = *(const LASQ bf16x8v*)(KH + (16 * at + li) * (LT * 2) + (32 * ks + 8 * fq) * 2); acc = MFMA16(af, bfr[ks], acc); }
                *(f32x4*)(BCg + (16 * bt + li) * 64 + 16 * at + 4 * fq) = acc; } }
    }
#endif
    __syncthreads();
}
DI void bf_split(const f32x4 a, const f32x4 b, bf16x8v& hi, bf16x8v& lo) {
    u32x4 w; w.x = pg8::cvt_pk_bf16(a.x, a.y); w.y = pg8::cvt_pk_bf16(a.z, a.w); w.z = pg8::cvt_pk_bf16(b.x, b.y); w.w = pg8::cvt_pk_bf16(b.z, b.w);
    hi = __builtin_bit_cast(bf16x8v, w);
    const f32x4 ra = {a.x - bflo(w.x), a.y - bfhi(w.x), a.z - bflo(w.y), a.w - bfhi(w.y)}, rb = {b.x - bflo(w.z), b.y - bfhi(w.z), b.z - bflo(w.w), b.w - bfhi(w.w)};
    lo = cvt8(ra, rb);
}
DI void gdn_scan_item(Ctx& C, int l, int it) {
    const int lane = C.lane, li = lane & 15, fq = lane >> 4, b = it >> 4, h = (it >> 2) & 3, vs = it & 3, v = 16 * vs + li;
    const bf16* ACh = (const bf16*)(C.ws + GDN_AC); const bf16* ACl = ACh + (size_t)1024 * 4096; const float* BCT = (const float*)(C.ws + GDN_BCT); float* SC = (float*)(C.ws + GDN_SC);
    f32x4 S[4];
#pragma unroll
    for (int at = 0; at < 4; ++at) S[at] = (f32x4){0.f, 0.f, 0.f, 0.f};
    bf16x8v Ahn[4][2], Aln[4][2]; f32x4 Bn[4];
#define GDN_SCAN_LOAD(cc) do { const size_t u_ = (size_t)((b * 64 + (cc)) * 4 + h) * 4096; \
        _Pragma("unroll") for (int at = 0; at < 4; ++at) { Bn[at] = *(const f32x4*)(BCT + u_ + v * 64 + 16 * at + 4 * fq); \
            _Pragma("unroll") for (int ks = 0; ks < 2; ++ks) { Ahn[at][ks] = *(const bf16x8v*)(ACh + u_ + (16 * at + li) * 64 + 32 * ks + 8 * fq); Aln[at][ks] = *(const bf16x8v*)(ACl + u_ + (16 * at + li) * 64 + 32 * ks + 8 * fq); } } } while (0)
    GDN_SCAN_LOAD(0);
    for (int c = 0; c < 64; ++c) {
        bf16x8v Ah[4][2], Al[4][2]; f32x4 Bc[4];
#pragma unroll
        for (int at = 0; at < 4; ++at) { Bc[at] = Bn[at];
#pragma unroll
            for (int ks = 0; ks < 2; ++ks) { Ah[at][ks] = Ahn[at][ks]; Al[at][ks] = Aln[at][ks]; } }
        if (c + 1 < 64) GDN_SCAN_LOAD(c + 1);
        const size_t u = (size_t)((b * 64 + c) * 4 + h) * 4096;
#pragma unroll
        for (int at = 0; at < 4; ++at) *(f32x4*)(SC + u + v * 64 + 16 * at + 4 * fq) = S[at];
        bf16x8v sh[2], sl[2];
#pragma unroll
        for (int ks = 0; ks < 2; ++ks) bf_split(S[2 * ks], S[2 * ks + 1], sh[ks], sl[ks]);
#pragma unroll
        for (int at = 0; at < 4; ++at) { f32x4 acc = Bc[at];
#pragma unroll
            for (int ks = 0; ks < 2; ++ks) { acc = MFMA16(Ah[at][ks], sh[ks], acc); acc = MFMA16(Ah[at][ks], sl[ks], acc); acc = MFMA16(Al[at][ks], sh[ks], acc); }
            S[at] = acc; }
    }
#undef GDN_SCAN_LOAD
    float* so = C.out + O_PGDN + ((size_t)(l * NB + b) * 4 + h) * 4096 + v;
#pragma unroll
    for (int at = 0; at < 4; ++at)
#pragma unroll
        for (int r = 0; r < 4; ++r) so[(size_t)(16 * at + 4 * fq + r) * 64] = S[at][r];
}
constexpr int GO_HSZ = 512 + 4 * 64 * LT * 2;
DI void gdn_out_chunk(Ctx& C, int l, int b, int c) {
    const int lane = C.lane, wave = C.wave, hh = wave >> 2, qw = wave & 3, li = lane & 15, fq = lane >> 4;
    const size_t row0 = (size_t)b * SEQ + (size_t)c * 64;
    LASQ unsigned char* HB = C.lds + hh * GO_HSZ; constexpr int TB = 64 * LT * 2;
    LASQ float* GC = (LASQ float*)HB; LASQ float* BE = GC + 64; LASQ unsigned char* KH = HB + 512; LASQ unsigned char* WL = KH + TB; LASQ unsigned char* ST = WL + TB; LASQ unsigned char* UTL = ST + TB;
    const float* gnp = inF(C, 28) + l * 64;
#pragma unroll 1
    for (int pass = 0; pass < 2; ++pass) { const int h = 2 * pass + hh; const int unit = ((b * 64 + c) * 4 + h);
        {
            const int x = (qw << 6) | lane, r = x >> 2, qd = x & 3;
            const bf16* kg = (const bf16*)(C.ws + GDN_K) + (row0 + r) * 256 + h * 64 + 16 * qd; const bf16* wgp = (const bf16*)(C.ws + GDN_W) + (size_t)unit * 4096 + r * 64 + 16 * qd;
            const float* sg = (const float*)(C.ws + GDN_SC) + (size_t)unit * 4096 + r * 64 + 16 * qd;
#pragma unroll
            for (int e = 0; e < 2; ++e) { *(LASQ u32x4*)(KH + r * (LT * 2) + (16 * qd + 8 * e) * 2) = *(const u32x4*)(kg + 8 * e); *(LASQ u32x4*)(WL + r * (LT * 2) + (16 * qd + 8 * e) * 2) = *(const u32x4*)(wgp + 8 * e);
                const f32x4 s0 = *(const f32x4*)(sg + 8 * e), s1 = *(const f32x4*)(sg + 8 * e + 4); *(LASQ bf16x8v*)(ST + r * (LT * 2) + (16 * qd + 8 * e) * 2) = cvt8(s0, s1); }
            if (x < 64) { GC[x] = ((const float*)(C.ws + GDN_GC))[(size_t)unit * 64 + x]; BE[x] = ((const float*)(C.ws + GDN_BE))[(size_t)unit * 64 + x]; }
        }
        __syncthreads();
        {
            bf16x8v af[2];
#pragma unroll
            for (int ks = 0; ks < 2; ++ks) af[ks] = *(const LASQ bf16x8v*)(WL + (16 * qw + li) * (LT * 2) + (32 * ks + 8 * fq) * 2);
            const float* Ug = (const float*)(C.ws + GDN_UT) + (size_t)unit * 4096;
#pragma unroll
            for (int bt = 0; bt < 4; ++bt) { f32x4 acc = {0.f, 0.f, 0.f, 0.f};
#pragma unroll
                for (int ks = 0; ks < 2; ++ks) { const bf16x8v bfr = *(const LASQ bf16x8v*)(ST + (16 * bt + li) * (LT * 2) + (32 * ks + 8 * fq) * 2); acc = MFMA16(af[ks], bfr, acc); }
                const f32x4 uu = *(const f32x4*)(Ug + (16 * bt + li) * 64 + 16 * qw + 4 * fq) - acc;
                u32x2 w; w.x = pg8::cvt_pk_bf16(uu.x, uu.y); w.y = pg8::cvt_pk_bf16(uu.z, uu.w);
                *(LASQ u32x2*)(UTL + (16 * bt + li) * (LT * 2) + (16 * qw + 4 * fq) * 2) = w; }
        }
        __syncthreads();
        {   const int iq = 16 * qw + li; const size_t row = row0 + iq;
            bf16x8v qf[2];
#pragma unroll
            for (int ks = 0; ks < 2; ++ks) qf[ks] = *(const bf16x8v*)((const bf16*)(C.ws + GDN_Q) + row * 256 + h * 64 + 32 * ks + 8 * fq);
            const float gi = GC[iq]; f32x4 s[4];
#pragma unroll
            for (int jt = 0; jt < 4; ++jt) { s[jt] = (f32x4){0.f, 0.f, 0.f, 0.f};
#pragma unroll
                for (int ks = 0; ks < 2; ++ks) { const bf16x8v kf = *(const LASQ bf16x8v*)(KH + (16 * jt + li) * (LT * 2) + (32 * ks + 8 * fq) * 2); s[jt] = MFMA16(kf, qf[ks], s[jt]); }
#pragma unroll
                for (int r = 0; r < 4; ++r) { const int j = 16 * jt + 4 * fq + r; s[jt][r] = (j <= iq) ? s[jt][r] * __expf(gi - GC[j]) * BE[j] : 0.f; } }
            bf16x8v pf[2];
#pragma unroll
            for (int ks = 0; ks < 2; ++ks) pf[ks] = cvt8(s[2 * ks], s[2 * ks + 1]);
            const float eg = __expf(gi); f32x4 o[4]; float ss = 0.f;
#pragma unroll
            for (int vt = 0; vt < 4; ++vt) { f32x4 a1 = {0.f, 0.f, 0.f, 0.f}, a2 = {0.f, 0.f, 0.f, 0.f};
#pragma unroll
                for (int ks = 0; ks < 2; ++ks) { const LASQ unsigned char* ur = UTL + (16 * vt + li) * (LT * 2);
                    const bf16x4v lo = *(const LASQ bf16x4v*)(ur + (32 * ks + 4 * fq) * 2), hi = *(const LASQ bf16x4v*)(ur + (32 * ks + 16 + 4 * fq) * 2);
                    a1 = MFMA16(__builtin_shufflevector(lo, hi, 0, 1, 2, 3, 4, 5, 6, 7), pf[ks], a1);
                    const bf16x8v sf = *(const LASQ bf16x8v*)(ST + (16 * vt + li) * (LT * 2) + (32 * ks + 8 * fq) * 2); a2 = MFMA16(sf, qf[ks], a2); }
                o[vt] = a1 + a2 * eg; ss += (o[vt][0] * o[vt][0] + o[vt][1] * o[vt][1]) + (o[vt][2] * o[vt][2] + o[vt][3] * o[vt][3]); }
            ss += __shfl_xor(ss, 16); ss += __shfl_xor(ss, 32);
            const float rinv = rsq_(ss * (1.f / 64.f) + 1e-6f);
            const float* zr = projp(C) + row * NP + C_DZ + h * 64; bf16* yc = ybuf(C, 2) + row * 256 + h * 64;
#pragma unroll
            for (int vt = 0; vt < 4; ++vt) { const f32x4 g = *(const f32x4*)(zr + 16 * vt + 4 * fq), gn = *(const f32x4*)(gnp + 16 * vt + 4 * fq);
                u32x2 w; w.x = pg8::cvt_pk_bf16(o[vt][0] * rinv * gn.x * silu_(g.x), o[vt][1] * rinv * gn.y * silu_(g.y)); w.y = pg8::cvt_pk_bf16(o[vt][2] * rinv * gn.z * silu_(g.z), o[vt][3] * rinv * gn.w * silu_(g.w));
                *(u32x2*)(yc + 16 * vt + 4 * fq) = w; }
        }
        __syncthreads();
    }
}

constexpr size_t WS_MB = WS_END4;
constexpr size_t MB_Q = WS_MB;
constexpr size_t MB_K = MB_Q + (size_t)MP * 256 * 2;
constexpr size_t MB_VT = MB_K + (size_t)MP * 256 * 2;
constexpr size_t MB_KSUM = MB_VT + (size_t)MP * 256 * 2;
constexpr size_t WS_END5 = MB_KSUM + (size_t)NB * 64 * 256 * 4;
DI void moba_prep_chunk(Ctx& C, int l, int b, int c, const float* ropetab) {
    const int tid = C.tid, lane = C.lane, wave = C.wave; const size_t row0 = (size_t)b * SEQ + (size_t)c * 64;
    LASQ unsigned char* VTL = C.lds; LASQ float* KS = (LASQ float*)(C.lds + 256 * LT * 2);
    const float qnv = inF(C, 29)[l * 64 + lane], knv = inF(C, 30)[l * 64 + lane]; const float qs = 0.125f * 1.4426950408889634f;
    float ks[4] = {0.f, 0.f, 0.f, 0.f};
    float* MQ = tmpbuf(C, T_MQ); bf16* QB = (bf16*)(C.ws + MB_Q); bf16* KB = (bf16*)(C.ws + MB_K); bf16* VB = (bf16*)(C.ws + MB_VT);
#pragma unroll 1
    for (int half = 0; half < 2; ++half) {
        float xq[4][4], xk[4][4], xv[4][4];
#pragma unroll
        for (int i = 0; i < 4; ++i) { const float* pr = projp(C) + (row0 + 8 * wave + 4 * half + i) * NP;
#pragma unroll
            for (int hh = 0; hh < 4; ++hh) { xq[i][hh] = pr[C_MQ + hh * 64 + lane]; xk[i][hh] = pr[C_MK + hh * 64 + lane]; xv[i][hh] = pr[C_MV + hh * 64 + lane]; } }
#pragma unroll
        for (int i = 0; i < 4; ++i) { const int t = 8 * wave + 4 * half + i; const size_t row = row0 + t;
            const float* rt = ropetab + (size_t)(c * 64 + t) * 16; const float cs = rt[lane & 7], sn = rt[8 + (lane & 7)];
            float* MK = C.out + O_PMK + ((size_t)l * MP + row) * 256; float* MV = C.out + O_PMV + ((size_t)l * MP + row) * 256;
#pragma unroll
            for (int hh = 0; hh < 4; ++hh) { float q = xq[i][hh], k = xk[i][hh];
                q = q * rsq_(wsum(q * q) * (1.f / 64.f) + 1e-6f) * qnv; k = k * rsq_(wsum(k * k) * (1.f / 64.f) + 1e-6f) * knv;
                const float pq = __shfl_xor(q, 8), pk = __shfl_xor(k, 8);
                if (lane < 8) { q = q * cs - pq * sn; k = k * cs - pk * sn; } else if (lane < 16) { q = q * cs + pq * sn; k = k * cs + pk * sn; }
                MQ[row * 256 + hh * 64 + lane] = q; QB[row * 256 + hh * 64 + lane] = (bf16)f2bf(q * qs);
                MK[hh * 64 + lane] = k; KB[row * 256 + hh * 64 + lane] = (bf16)f2bf(k); ks[hh] += k;
                MV[hh * 64 + lane] = xv[i][hh]; VB[row * 256 + hh * 64 + lane] = (bf16)f2bf(xv[i][hh]); } }
    }
#pragma unroll
    for (int hh = 0; hh < 4; ++hh) KS[wave * 256 + hh * 64 + lane] = ks[hh];
    __syncthreads();
    if (tid < 256) { float s = 0.f;
#pragma unroll
        for (int w = 0; w < 8; ++w) s += KS[w * 256 + tid];
        ((float*)(C.ws + MB_KSUM))[((size_t)b * 64 + c) * 256 + tid] = s; }
    if (c == 63) { for (int i = tid; i < 3 * 768; i += 512) { const int j = i / 768, ch = i - j * 768; C.out[O_PCONV + (((size_t)l * NB + b) * 3 + j) * 768 + ch] = projp(C)[(row0 + 61 + j) * NP + C_DQ + ch]; } }
    __syncthreads();
}

constexpr size_t WS_KMS2 = WS_END5;
constexpr size_t WS_END6 = WS_KMS2 + (size_t)2 * SB * 32 * 256 * 4;
DI void lds_barrier_() { asm volatile("s_waitcnt lgkmcnt(0)" ::: "memory"); __builtin_amdgcn_s_barrier(); asm volatile("" ::: "memory"); }
DI float skinny_core(const Ctx& C, const bf16* A, const bf16* Bt, int K, int n0, LASQ float* red) {
    const int lane = C.lane, wave = C.wave, li = lane & 15, fq = lane >> 4, kw = K >> 3, k0 = wave * kw + 8 * fq;
    f32x4 acc0 = {0.f, 0.f, 0.f, 0.f}, acc1 = {0.f, 0.f, 0.f, 0.f};
    const bf16* bp = Bt + (size_t)(n0 + li) * K + k0; const bf16* ap0 = A + (size_t)li * K + k0; const bf16* ap1 = A + (size_t)(16 + li) * K + k0;
#pragma unroll 8
    for (int ks = 0; ks < (kw >> 5); ++ks) { const bf16x8v bfr = *(const bf16x8v*)(bp + 32 * ks), a0 = *(const bf16x8v*)(ap0 + 32 * ks), a1 = *(const bf16x8v*)(ap1 + 32 * ks);
        acc0 = MFMA16(bfr, a0, acc0); acc1 = MFMA16(bfr, a1, acc1); }
    *(LASQ f32x4*)(red + wave * 512 + li * 16 + 4 * fq) = acc0; *(LASQ f32x4*)(red + wave * 512 + (16 + li) * 16 + 4 * fq) = acc1;
    __syncthreads();
    float v = 0.f;
#pragma unroll
    for (int w = 0; w < 8; ++w) v += red[w * 512 + C.tid];
    __syncthreads();
    return v;
}
DI void kmean_unit(Ctx& C, int l, int u) {
    const int tid = C.tid, cc = tid & 63, tg = tid >> 6; LASQ float* red = (LASQ float*)C.lds;
    const int r = u, bs = r >> 5, blk = r & 31; const int page = inI(C, 4)[bs * 64 + blk * 2 + (tg >> 2)];
    const float* src = inF(C, 2) + (((size_t)l * NPOOL + page) * 128 + (tg & 3) * 32) * 256; float* dst = (float*)(C.ws + WS_KMS2) + ((size_t)l * SB * 32 + r) * 256;
    f32x4 s = {0.f, 0.f, 0.f, 0.f};
#pragma unroll 8
    for (int j = 0; j < 32; ++j) s += __builtin_nontemporal_load((const f32x4*)(src + (size_t)j * 256 + 4 * cc));
    *(LASQ f32x4*)(red + tg * 256 + 4 * cc) = s;
    __syncthreads();
    if (tid < 256) { float t = 0.f;
#pragma unroll
        for (int g = 0; g < 8; ++g) t += red[g * 256 + tid];
        dst[tid] = t * (1.f / 256.f); }
    __syncthreads();
}
DI void moba_decode_unit(Ctx& C, int l, int bs, int h) {
    const int tid = C.tid, lane = C.lane, wave = C.wave; const size_t m = (size_t)MP + bs;
    LASQ float* QL = (LASQ float*)C.lds; LASQ float* GT = QL + 64; LASQ float* LG = QL + 128; LASQ float* PO = QL + 1024;
    const float q = tmpbuf(C, T_MQ)[m * 256 + h * 64 + lane];
    if (wave == 0) QL[lane] = q;
#pragma unroll
    for (int i = 0; i < 4; ++i) { const int n = 4 * wave + i; const float g = wsum(q * ((const float*)(C.ws + WS_KMS2))[(((size_t)l * SB + bs) * 32 + n) * 256 + h * 64 + lane]); if (lane == 0) GT[n] = g; }
    __syncthreads();
    int sel[3];
    { float myg = (lane < 32) ? GT[lane] : -3.0e38f;
#pragma unroll
      for (int r = 0; r < 3; ++r) { const float mx = wmaxf(myg); const unsigned long long bal = __ballot(myg == mx); const int idx = __ffsll((long long)bal) - 1; sel[r] = __builtin_amdgcn_readfirstlane(idx); if (lane == idx) myg = -3.0e38f; } }
    const int* pt = inI(C, 4) + bs * 64; const float* ck = inF(C, 2) + (size_t)l * NPOOL * 128 * 256 + h * 64; const float* cv = inF(C, 3) + (size_t)l * NPOOL * 128 * 256 + h * 64;
#pragma unroll
    for (int rep = 0; rep < 2; ++rep) { const int key = tid + 512 * rep;
        if (key <= 768) { const float* kr;
            if (key < 768) { const int r = key >> 8, kk = key & 255; const int sb = (r == 0) ? sel[0] : ((r == 1) ? sel[1] : sel[2]); const int kp = sb * 256 + kk; kr = ck + ((size_t)pt[kp >> 7] * 128 + (kp & 127)) * 256; }
            else kr = C.out + O_SMK + ((size_t)l * SB + bs) * 256 + h * 64;
            float dot = 0.f;
#pragma unroll
            for (int d4 = 0; d4 < 16; ++d4) { const f32x4 kv = *(const f32x4*)(kr + 4 * d4); const f32x4 qv = *(const LASQ f32x4*)(QL + 4 * d4); dot += (kv.x * qv.x + kv.y * qv.y) + (kv.z * qv.z + kv.w * qv.w); }
            LG[key] = dot * 0.125f; } }
    __syncthreads();
    float mx = -3.0e38f;
    for (int k = lane; k <= 768; k += 64) mx = fmaxf(mx, LG[k]);
    mx = wmaxf(mx);
    float sum = 0.f;
    for (int k = lane; k <= 768; k += 64) sum += __expf(LG[k] - mx);
    sum = wsum(sum);
    float o = 0.f;
    {   const float* vb[3]; float vv[3][32];
#pragma unroll
        for (int gi = 0; gi < 3; ++gi) { const int gk0 = 32 * (3 * wave + gi), r = gk0 >> 8, kk0 = gk0 & 255; const int sb = (r == 0) ? sel[0] : ((r == 1) ? sel[1] : sel[2]); const int kp0 = sb * 256 + kk0;
            vb[gi] = cv + ((size_t)pt[kp0 >> 7] * 128 + (kp0 & 127)) * 256 + lane; }
#pragma unroll
        for (int gi = 0; gi < 3; ++gi)
#pragma unroll
            for (int j = 0; j < 32; ++j) vv[gi][j] = vb[gi][(size_t)j * 256];
#pragma unroll
        for (int gi = 0; gi < 3; ++gi)
#pragma unroll
            for (int j = 0; j < 32; ++j) o += __expf(LG[32 * (3 * wave + gi) + j] - mx) * vv[gi][j]; }
    if (wave == 0) o += __expf(LG[768] - mx) * C.out[O_SMV + ((size_t)l * SB + bs) * 256 + h * 64 + lane];
    PO[wave * 64 + lane] = o;
    __syncthreads();
    if (wave == 0) { float t = 0.f;
#pragma unroll
        for (int w = 0; w < 8; ++w) t += PO[w * 64 + lane];
        ybuf(C, 3)[m * 256 + h * 64 + lane] = (bf16)f2bf(t / sum); }
    __syncthreads();
}

DI void skinny_merge_item(Ctx& C, int l, int n0, LASQ float* red) {
    const int lane = C.lane, wave = C.wave, li = lane & 15, fq = lane >> 4, br = wave >> 1, kh = wave & 1, k0 = 128 * kh + 8 * fq;
    const bf16* A = ybuf(C, br) + (size_t)MP * BW; const bf16* Bt = wptr(C, l, WO_WBR) + (size_t)br * D * BW;
    f32x4 acc0 = {0.f, 0.f, 0.f, 0.f}, acc1 = {0.f, 0.f, 0.f, 0.f};
    const bf16* bp = Bt + (size_t)(n0 + li) * BW + k0; const bf16* ap0 = A + (size_t)li * BW + k0; const bf16* ap1 = A + (size_t)(16 + li) * BW + k0;
#pragma unroll
    for (int ks = 0; ks < 4; ++ks) { const bf16x8v bfr = *(const bf16x8v*)(bp + 32 * ks), a0 = *(const bf16x8v*)(ap0 + 32 * ks), a1 = *(const bf16x8v*)(ap1 + 32 * ks);
        acc0 = MFMA16(bfr, a0, acc0); acc1 = MFMA16(bfr, a1, acc1); }
    *(LASQ f32x4*)(red + wave * 512 + li * 16 + 4 * fq) = acc0; *(LASQ f32x4*)(red + wave * 512 + (16 + li) * 16 + 4 * fq) = acc1;
    lds_barrier_();
    const int row = C.tid >> 4, col = C.tid & 15; float accm = 0.f;
#pragma unroll
    for (int b4 = 0; b4 < 4; ++b4) accm += (red[(2 * b4) * 512 + C.tid] + red[(2 * b4 + 1) * 512 + C.tid]) * bflo((unsigned)gatep(C)[(size_t)(MP + row) * NGATE + b4 * D + n0 + col]);
    lds_barrier_();
    mrgp(C)[(size_t)(MP + row) * D + n0 + col] = (bf16)f2bf(accm);
}

constexpr int MG_AB = 256 * LT * 2, MG_BB = 128 * LT * 2, MG_STAGE = MG_AB + MG_BB;
DI void merge_unit(Ctx& C, int l, int m0, int n0) {
    const int tid = C.tid, lane = C.lane, wave = C.wave, li = lane & 15, fq = lane >> 4, wr = wave >> 1, wc = wave & 1;
    LASQ unsigned char* L = C.lds;
    f32x4 acc[4][4]; u32x2 tot[4][4];
#pragma unroll
    for (int mt = 0; mt < 4; ++mt)
#pragma unroll
        for (int nt = 0; nt < 4; ++nt) { acc[mt][nt] = (f32x4){0.f, 0.f, 0.f, 0.f}; tot[mt][nt] = (u32x2){0u, 0u}; }
    u32x4 ra[4], ra2[4], rb[2], rb2[2];
    const int srow = tid >> 3, sseg = tid & 7;
    const int psrow = (((srow >> 2) & 3) << 4) | (((srow >> 4) & 3) << 2) | (srow & 3);
#define MG_LOADA(s, dst) do { const int br_ = (s) >> 2, kt_ = (s) & 3; const bf16* yb_ = ybuf(C, br_) + (size_t)m0 * BW + kt_ * 64 + 8 * sseg; \
        _Pragma("unroll") for (int j = 0; j < 4; ++j) dst[j] = *(const u32x4*)(yb_ + (size_t)(srow + 64 * j) * BW); } while (0)
#define MG_LOADB(s, bdst) do { const int br_ = (s) >> 2, kt_ = (s) & 3; const bf16* wb_ = wptr(C, l, WO_WBR) + (size_t)br_ * D * BW + (size_t)n0 * BW + kt_ * 64 + 8 * sseg; \
        _Pragma("unroll") for (int j = 0; j < 2; ++j) bdst[j] = *(const u32x4*)(wb_ + (size_t)(srow + 64 * j) * BW); } while (0)
#define MG_STORE(buf, src, bsrc) do { LASQ unsigned char* sb_ = L + (buf) * MG_STAGE; \
        _Pragma("unroll") for (int j = 0; j < 4; ++j) *(LASQ u32x4*)(sb_ + (srow + 64 * j) * (LT * 2) + sseg * 16) = src[j]; \
        _Pragma("unroll") for (int j = 0; j < 2; ++j) *(LASQ u32x4*)(sb_ + MG_AB + (psrow + 64 * j) * (LT * 2) + sseg * 16) = bsrc[j]; } while (0)
    u32x2 gv[4][4];
#define MG_STEP(s, RCUR, RPRE, BCUR, BPRE) do { const int buf = (s) & 1, br = (s) >> 2, kt = (s) & 3; \
        if (kt == 3) { const bf16* gp = gatep(C) + (size_t)(m0 + 64 * wr + li) * NGATE + br * D + n0 + 64 * wc + 16 * fq; \
            _Pragma("unroll") for (int mt = 0; mt < 4; ++mt) { const u32x4 g0_ = *(const u32x4*)(gp + (size_t)(16 * mt) * NGATE), g1_ = *(const u32x4*)(gp + (size_t)(16 * mt) * NGATE + 8); \
                gv[mt][0] = (u32x2){g0_.x, g0_.y}; gv[mt][1] = (u32x2){g0_.z, g0_.w}; gv[mt][2] = (u32x2){g1_.x, g1_.y}; gv[mt][3] = (u32x2){g1_.z, g1_.w}; } } \
        if ((s) + 2 < 16) MG_LOADB((s) + 2, BPRE); \
        if (kt != 3 && (s) + 2 < 16) MG_LOADA((s) + 2, RPRE); \
        const LASQ unsigned char* AL = L + buf * MG_STAGE; const LASQ unsigned char* BL = AL + MG_AB; \
        _Pragma("unroll 1") for (int ks = 0; ks < 2; ++ks) { bf16x8v af[4], bfr[4]; \
            _Pragma("unroll") for (int mt = 0; mt < 4; ++mt) af[mt] = *(const LASQ bf16x8v*)(AL + (64 * wr + 16 * mt + li) * (LT * 2) + (32 * ks + 8 * fq) * 2); \
            _Pragma("unroll") for (int nt = 0; nt < 4; ++nt) bfr[nt] = *(const LASQ bf16x8v*)(BL + (64 * wc + 16 * nt + li) * (LT * 2) + (32 * ks + 8 * fq) * 2); \
            _Pragma("unroll") for (int mt = 0; mt < 4; ++mt) _Pragma("unroll") for (int nt = 0; nt < 4; ++nt) acc[mt][nt] = MFMA16(bfr[nt], af[mt], acc[mt][nt]); } \
        if (kt == 3) { \
            _Pragma("unroll") for (int mt = 0; mt < 4; ++mt) _Pragma("unroll") for (int nt = 0; nt < 4; ++nt) { const u32x2 g = gv[mt][nt]; const u32x2 t_ = tot[mt][nt]; const f32x4 a = acc[mt][nt]; u32x2 o_; \
                    o_.x = pg8::cvt_pk_bf16(bflo(t_.x) + a[0] * bflo(g.x), bfhi(t_.x) + a[1] * bfhi(g.x)); o_.y = pg8::cvt_pk_bf16(bflo(t_.y) + a[2] * bflo(g.y), bfhi(t_.y) + a[3] * bfhi(g.y)); \
                    tot[mt][nt] = o_; acc[mt][nt] = (f32x4){0.f, 0.f, 0.f, 0.f}; } \
            if ((s) + 2 < 16) MG_LOADA((s) + 2, RPRE); }     \
        if ((s) + 1 < 16) MG_STORE(buf ^ 1, RCUR, BCUR); \
        lds_barrier_(); } while (0)
    MG_LOADB(0, rb); MG_LOADA(0, ra); MG_STORE(0, ra, rb); MG_LOADB(1, rb); MG_LOADA(1, ra); lds_barrier_();
#pragma unroll 1
    for (int s2 = 0; s2 < 16; s2 += 2) { MG_STEP(s2, ra, ra2, rb, rb2); MG_STEP(s2 + 1, ra2, ra, rb2, rb); }
#undef MG_STEP
#undef MG_LOADA
#undef MG_LOADB
#undef MG_STORE
    bf16* op = mrgp(C) + (size_t)(m0 + 64 * wr + li) * D + n0 + 64 * wc + 16 * fq;
#pragma unroll
    for (int mt = 0; mt < 4; ++mt) { *(u32x4*)(op + (size_t)(16 * mt) * D) = (u32x4){tot[mt][0].x, tot[mt][0].y, tot[mt][1].x, tot[mt][1].y}; *(u32x4*)(op + (size_t)(16 * mt) * D + 8) = (u32x4){tot[mt][2].x, tot[mt][2].y, tot[mt][3].x, tot[mt][3].y}; }
}

DI void small_proj_chunk(Ctx& C, int l, int b, int c) {
    const int lane = C.lane, wave = C.wave, li = lane & 15, fq = lane >> 4, mt = wave & 3, kh = wave >> 2; const size_t row0 = (size_t)b * SEQ + (size_t)c * 64;
    LASQ float* red = (LASQ float*)C.lds;
    const bf16* wp = wptr(C, l, WO_WIN) + (size_t)(3072 + li) * D + 512 * kh + 8 * fq; const bf16* hp = Hp(C) + (row0 + 16 * mt + li) * D + 512 * kh + 8 * fq;
    f32x4 acc[2] = {{0.f, 0.f, 0.f, 0.f}, {0.f, 0.f, 0.f, 0.f}};
    const f32x4* sq = (const f32x4*)((const float*)(C.ws + WS_SSQ) + (row0 + 16 * mt + li) * 16); const f32x4 q0 = sq[0], q1 = sq[1], q2 = sq[2], q3 = sq[3];
#pragma unroll 4
    for (int ks = 0; ks < 16; ++ks) { const bf16x8v hb = *(const bf16x8v*)(hp + 32 * ks), w0 = *(const bf16x8v*)(wp + 32 * ks), w1 = *(const bf16x8v*)(wp + (size_t)16 * D + 32 * ks);
        acc[0] = MFMA16(w0, hb, acc[0]); acc[1] = MFMA16(w1, hb, acc[1]); }
    if (kh == 1) { *(LASQ f32x4*)(red + ((mt * 2 + 0) * 64 + lane) * 4) = acc[0]; *(LASQ f32x4*)(red + ((mt * 2 + 1) * 64 + lane) * 4) = acc[1]; }
    __syncthreads();
    if (kh == 0) { float* pr = projp(C) + (row0 + 16 * mt + li) * NP + 3072 + 4 * fq;
        const f32x4 qs = (q0 + q1) + (q2 + q3); const float rs = rsq_(((qs.x + qs.y) + (qs.z + qs.w)) * (1.f / D) + 1e-6f);
#pragma unroll
        for (int nt = 0; nt < 2; ++nt) *(f32x4*)(pr + 16 * nt) = (acc[nt] + *(const LASQ f32x4*)(red + ((mt * 2 + nt) * 64 + lane) * 4)) * rs; }
    __syncthreads();
}

#include <hip/hip_bf16.h>
#include <cmath>
namespace attn_body {
using bf16=__hip_bfloat16;
using bf16x8=__attribute__((ext_vector_type(8)))short;
using s16x4=__attribute__((ext_vector_type(4)))short;
using f32x16=__attribute__((ext_vector_type(16)))float;
using u32x4=__attribute__((ext_vector_type(4)))unsigned;
constexpr int BATCH=4,NHEAD=4,SEQ=4096,D=64,DM=NHEAD*D;
constexpr int NW=8,QBLK=32,QB=QBLK*NW,KVBLK=64,NQB=SEQ/QB;
constexpr int ATTN_PITCH=DM, ATTN_UNIT_ROWS=QB;
__device__ __forceinline__ int crow(int r,int hi){return (r&3)+8*(r>>2)+4*hi;}
#define SBAR() __builtin_amdgcn_sched_barrier(0)
__device__ __forceinline__ void cmask(f32x16&p0,f32x16&p1,int jb,int qrel,int hi){
  const float NEG=-INFINITY; int kb=64*jb+4*hi;
  #pragma unroll
  for(int r=0;r<16;++r){int kv=kb+(r&3)+8*(r>>2); if(kv>qrel)p0[r]=NEG; if(kv+32>qrel)p1[r]=NEG;}
}

constexpr int NSLOT=3, SLOTB=8192;
constexpr int LDS_K=0, LDS_V=NSLOT*SLOTB, LDS_WS=2*NSLOT*SLOTB, LDS_OST=LDS_WS+NW*64*4, LDS_BYTES=LDS_OST+NW*4096;
constexpr float C2=0.125f*1.4426950408889634f;
__device__ __forceinline__ void glds16(const void*gsrc,unsigned lds_dst){unsigned keep;
  asm volatile("s_mov_b32 %0, m0\n\ts_mov_b32 m0, %2\n\ts_nop 0\n\tglobal_load_lds_dwordx4 %1, off\n\ts_mov_b32 m0, %0":"=&s"(keep):"v"(gsrc),"s"(lds_dst):"memory");}
__device__ __forceinline__ float max3f(float a,float b,float c){float r;asm("v_max3_f32 %0, %1, %2, %3":"=v"(r):"v"(a),"v"(b),"v"(c));return r;}
__device__ __forceinline__ float max2f(float a,float b){float r;asm("v_max_f32_e32 %0, %1, %2":"=v"(r):"v"(a),"v"(b));return r;}
__device__ __forceinline__ float fadd_s(float a,float b){float r;asm("v_add_f32_e32 %0, %1, %2":"=v"(r):"v"(a),"v"(b));return r;}
__device__ __forceinline__ float fsub_s(float a,float b){float r;asm("v_sub_f32_e32 %0, %1, %2":"=v"(r):"v"(a),"v"(b));return r;}
typedef float f32x2_t __attribute__((ext_vector_type(2))); typedef __bf16 bf16x2_t __attribute__((ext_vector_type(2)));
__device__ __forceinline__ unsigned cvtpk_s(float lo,float hi){f32x2_t v={lo,hi};bf16x2_t b=__builtin_convertvector(v,bf16x2_t);return __builtin_bit_cast(unsigned,b);}
#define WAIT_BAR(N) asm volatile("s_waitcnt vmcnt(" #N ") lgkmcnt(0)\n\ts_barrier":::"memory")

__device__ __forceinline__ void qkt(f32x16&p0,f32x16&p1,const char*Kslot,const bf16x8*qr,const f32x16&negm,int r32,int hi){
  const char*kb=Kslot+hi*1024+r32*16;
  #pragma unroll
  for(int d0=0;d0<4;++d0){
    const bf16x8 b0=*reinterpret_cast<const bf16x8*>(kb+d0*2048);
    const bf16x8 b1=*reinterpret_cast<const bf16x8*>(kb+d0*2048+512);
    if(d0==0){p0=__builtin_amdgcn_mfma_f32_32x32x16_bf16(b0,qr[0],negm,0,0,0);p1=__builtin_amdgcn_mfma_f32_32x32x16_bf16(b1,qr[0],negm,0,0,0);}
    else{p0=__builtin_amdgcn_mfma_f32_32x32x16_bf16(b0,qr[d0],p0,0,0,0);p1=__builtin_amdgcn_mfma_f32_32x32x16_bf16(b1,qr[d0],p1,0,0,0);}}
}
typedef __attribute__((address_space(3))) const char* lds_cptr;
typedef short v4i16_t __attribute__((ext_vector_type(4)));
__device__ __forceinline__ void kload8(bf16x8*kf,lds_cptr kp){
  kf[0]=*(const __attribute__((address_space(3))) bf16x8*)(kp);      kf[1]=*(const __attribute__((address_space(3))) bf16x8*)(kp+512);
  kf[2]=*(const __attribute__((address_space(3))) bf16x8*)(kp+2048); kf[3]=*(const __attribute__((address_space(3))) bf16x8*)(kp+2560);
  kf[4]=*(const __attribute__((address_space(3))) bf16x8*)(kp+4096); kf[5]=*(const __attribute__((address_space(3))) bf16x8*)(kp+4608);
  kf[6]=*(const __attribute__((address_space(3))) bf16x8*)(kp+6144); kf[7]=*(const __attribute__((address_space(3))) bf16x8*)(kp+6656);
}
__device__ __forceinline__ void kload2(bf16x8*kf,lds_cptr kp,int j){ kf[2*j]=*(const __attribute__((address_space(3))) bf16x8*)(kp+j*2048); kf[2*j+1]=*(const __attribute__((address_space(3))) bf16x8*)(kp+j*2048+512); }
__device__ __forceinline__ s16x4 vtr(lds_cptr p){ return __builtin_bit_cast(s16x4,__builtin_amdgcn_ds_read_tr16_b64_v4i16((__attribute__((address_space(3))) v4i16_t*)p)); }
__device__ __forceinline__ float rowmax(const f32x16&p0,const f32x16&p1){
  float a=max3f(p0[0],p0[1],p1[0]),b=max3f(p0[2],p0[3],p1[1]);a=max3f(a,p1[2],p1[3]);
  #pragma unroll
  for(int r=4;r<16;r+=4){a=max3f(a,p0[r],p0[r+1]);b=max3f(b,p0[r+2],p0[r+3]);a=max3f(a,p1[r],p1[r+1]);b=max3f(b,p1[r+2],p1[r+3]);}
  const float m=max2f(a,b);
  auto rr=__builtin_amdgcn_permlane32_swap(__float_as_uint(m),__float_as_uint(m),false,false);
  return max2f(__uint_as_float(rr[0]),__uint_as_float(rr[1]));
}
__device__ __forceinline__ void pv(f32x16*o,int vb,bf16x8 pa0,bf16x8 pa1,bf16x8 pa2,bf16x8 pa3){
  #pragma unroll
  for(int d0=0;d0<2;++d0){s16x4 lo[4],hi[4];
    #pragma unroll
    for(int ks=0;ks<4;++ks){
      asm volatile("ds_read_b64_tr_b16 %0,%1 offset:%c2":"=&v"(lo[ks]):"v"(vb),"i"(d0*4096+ks*1024):"memory");
      asm volatile("ds_read_b64_tr_b16 %0,%1 offset:%c2":"=&v"(hi[ks]):"v"(vb),"i"(d0*4096+ks*1024+512):"memory");}
    asm volatile("s_waitcnt lgkmcnt(0)":::"memory");SBAR();
    #define PK(k) (bf16x8){lo[k][0],lo[k][1],lo[k][2],lo[k][3],hi[k][0],hi[k][1],hi[k][2],hi[k][3]}
    o[d0]=__builtin_amdgcn_mfma_f32_32x32x16_bf16(pa0,PK(0),o[d0],0,0,0);
    o[d0]=__builtin_amdgcn_mfma_f32_32x32x16_bf16(pa1,PK(1),o[d0],0,0,0);
    o[d0]=__builtin_amdgcn_mfma_f32_32x32x16_bf16(pa2,PK(2),o[d0],0,0,0);
    o[d0]=__builtin_amdgcn_mfma_f32_32x32x16_bf16(pa3,PK(3),o[d0],0,0,0);
    #undef PK
  }
}

#ifndef ATTN_STORE16
#define ATTN_STORE16(p,v) (*(u32x4*)(p)=(v))
#endif
template<int THRL> __device__ __forceinline__ void attn_unit(int b,int h,int qb,const bf16*Q,const bf16*__restrict__ K,const bf16*__restrict__ V,bf16*O,char*shm,unsigned selmask){
  int tid_o=threadIdx.x; asm volatile("":"+v"(tid_o));
  const int tid=tid_o,lane=tid&63,r32=lane&31,hi=lane>>5; const int wid=__builtin_amdgcn_readfirstlane(tid>>6);
  const long rowbase=(long)b*SEQ; const int q0=qb*QB;
  const bf16*Qw=Q+(rowbase+q0+wid*QBLK)*DM+h*D;
  const bf16*Kh=K+rowbase*DM+h*D,*Vh=V+rowbase*DM+h*D;
  const unsigned lds0=(unsigned)(uintptr_t)shm;
  float*wsf=(float*)(shm+LDS_WS)+wid*64;
  const bf16*ksrc=Kh+(long)lane*DM+wid*8;
  const bf16*vsrc=Vh+(long)(16*(wid&3)+(lane>>2))*DM+(wid>>2)*32+(lane&3)*8;
  const unsigned kdst=lds0+LDS_K+wid*1024, vdst=lds0+LDS_V+wid*1024;
  #define DMA_K(t,slot) glds16(ksrc+(long)(t)*KVBLK*DM,(unsigned)__builtin_amdgcn_readfirstlane(kdst+(slot)))
  #define DMA_V(t,slot) glds16(vsrc+(long)(t)*KVBLK*DM,(unsigned)__builtin_amdgcn_readfirstlane(vdst+(slot)))
  const int vb0=(int)(lds0+LDS_V)+((lane>>4)&1)*32+(lane&3)*8+(4*hi+((lane&15)>>2))*64;
  const char*Kbase=shm+LDS_K; bf16x8 kf[8];
  const lds_cptr shm3=(lds_cptr)shm; const lds_cptr kp0=shm3+LDS_K+hi*1024+r32*16; const lds_cptr vp0=shm3+LDS_V+((lane>>4)&1)*32+(lane&3)*8+(4*hi+((lane&15)>>2))*64;
  const int NT=(q0+QB)/KVBLK;
  DMA_K(0,0);DMA_V(0,0);DMA_K(1,SLOTB);
  bf16x8 qr[4];
  #pragma unroll
  for(int d0=0;d0<4;++d0)qr[d0]=*reinterpret_cast<const bf16x8*>(&Qw[(long)r32*DM+d0*16+hi*8]);
  float mhat=0.f,l_reg=0.f;f32x16 o[2];o[0]=f32x16{};o[1]=f32x16{};const f32x16 negm=f32x16{};
  const int qrel=wid*QBLK+r32;
  #define CMASK(P0,P1,t) do{int jb_=(t)-(NT-4); if(jb_>=0)cmask(P0,P1,jb_,qrel,hi); else if(!((selmask>>((t)>>2))&1u)){ _Pragma("unroll") for(int r_=0;r_<16;++r_){P0[r_]=-INFINITY;P1[r_]=-INFINITY;} } }while(0)
  bool resc=false;
  #define START(P0,P1) do{ const float rm=rowmax(P0,P1); resc=false; \
    { const float dl=(rm>-1.0e30f)?rm:0.f; mhat=fadd_s(mhat,dl); \
      _Pragma("unroll") for(int r=0;r<16;++r){P0[r]=fsub_s(P0[r],dl);P1[r]=fsub_s(P1[r],dl);} \
      } \
    _Pragma("unroll") for(int r=0;r<16;++r)P0[r]=__builtin_amdgcn_exp2f(P0[r]); }while(0)
  #define RESC() do{ if(resc){ asm volatile("s_waitcnt lgkmcnt(0)":::"memory"); \
      _Pragma("unroll") for(int d_=0;d_<2;++d_) _Pragma("unroll") for(int r=0;r<16;++r)o[d_][r]*=wsf[crow(r,hi)]; } }while(0)
  f32x16 pA0,pA1,pB0,pB1;
  int sl_prev=0,sl_cur=0,sl_next=SLOTB;
  #define ROT() do{sl_prev=sl_cur;sl_cur=sl_next;sl_next=(sl_next==(NSLOT-1)*SLOTB)?0:sl_next+SLOTB;}while(0)
  DMA_K(2,2*SLOTB);
  WAIT_BAR(3);
  qkt(pA0,pA1,Kbase,qr,negm,r32,hi);asm volatile("s_nop 15\n\ts_nop 7":"+v"(pA0),"+v"(pA1));CMASK(pA0,pA1,0);
  START(pA0,pA1);
  _Pragma("unroll") for(int r=0;r<16;++r)pA1[r]=__builtin_amdgcn_exp2f(pA1[r]);
  WAIT_BAR(0);
  DMA_K(3,0);DMA_V(1,SLOTB);
  ROT();
  kload8(kf,kp0+sl_cur);
  WAIT_BAR(2);
  s16x4 vlo[8],vhi[8]; u32x4 pw0,pw1,pw2,pw3;
  #define PKW(P,B) cvtpk_s(P[B],P[B+1])
  #define PAF(k) __builtin_bit_cast(bf16x8,pw##k)
  #define VFR(i) (bf16x8){vlo[i][0],vlo[i][1],vlo[i][2],vlo[i][3],vhi[i][0],vhi[i][1],vhi[i][2],vhi[i][3]}
  #define PIN(x) asm volatile("":"+v"(x))
  #define MX3(a,b,c) __builtin_fmaxf(__builtin_fmaxf((a),(b)),(c))
  #define GAPA(MF,A0,A1,A2,A3,W0,W1,PW) do{ MF; sacc+=A0; sacc+=A1; sacc+=A2; sacc+=A3; PIN(sacc); W0; W1; PIN(PW); SBAR(); }while(0)
  #define EX(v) __builtin_amdgcn_exp2f(v)
  #define GAPB(MF,X,B) do{ MF; X[B]=EX(X[B]); X[B+1]=EX(X[B+1]); X[B+2]=EX(X[B+2]); X[B+3]=EX(X[B+3]); PIN(X); SBAR(); }while(0)
  #define VRD(i) do{ vlo[i]=vtr(vp_+(((i)>>2)*4096+((i)&3)*1024)); vhi[i]=vtr(vp_+(((i)>>2)*4096+((i)&3)*1024+512)); }while(0)
  #define KRD(G,j) do{ if(G){ kload2(kf,kp0+sl_next,j); SBAR(); } }while(0)
  #define STEP(C0,C1,P0,P1,t,GK,GV,GL) do{ SBAR(); \
    const lds_cptr vp_=vp0+sl_prev; \
    VRD(0); SBAR(); float sacc=(P0[0]+P0[1]); \
    GAPA(C0=__builtin_amdgcn_mfma_f32_32x32x16_bf16(kf[0],qr[0],negm,0,0,0), P0[2],P0[3],P0[4],P0[5],     pw0[0]=PKW(P0,0), pw0[1]=PKW(P0,2), pw0); \
    VRD(4); SBAR(); GAPA(C1=__builtin_amdgcn_mfma_f32_32x32x16_bf16(kf[1],qr[0],negm,0,0,0), P0[6],P0[7],P0[8],P0[9],     pw0[2]=PKW(P0,4), pw0[3]=PKW(P0,6), pw0); \
    VRD(1); SBAR(); GAPA(C0=__builtin_amdgcn_mfma_f32_32x32x16_bf16(kf[2],qr[1],C0,0,0,0),   P0[10],P0[11],P0[12],P0[13], pw1[0]=PKW(P0,8), pw1[1]=PKW(P0,10), pw1); \
    VRD(5); SBAR(); GAPA(C1=__builtin_amdgcn_mfma_f32_32x32x16_bf16(kf[3],qr[1],C1,0,0,0),   P0[14],P0[15],P1[0],P1[1],   pw1[2]=PKW(P0,12),pw1[3]=PKW(P0,14), pw1); \
    VRD(2); SBAR(); GAPA(C0=__builtin_amdgcn_mfma_f32_32x32x16_bf16(kf[4],qr[2],C0,0,0,0),   P1[2],P1[3],P1[4],P1[5],     pw2[0]=PKW(P1,0), pw2[1]=PKW(P1,2), pw2); \
    VRD(6); SBAR(); GAPA(C1=__builtin_amdgcn_mfma_f32_32x32x16_bf16(kf[5],qr[2],C1,0,0,0),   P1[6],P1[7],P1[8],P1[9],     pw2[2]=PKW(P1,4), pw2[3]=PKW(P1,6), pw2); \
    VRD(3); SBAR(); GAPA(C0=__builtin_amdgcn_mfma_f32_32x32x16_bf16(kf[6],qr[3],C0,0,0,0),   P1[10],P1[11],P1[12],P1[13], pw3[0]=PKW(P1,8), pw3[1]=PKW(P1,10), pw3); \
    VRD(7); SBAR(); GAPA(C1=__builtin_amdgcn_mfma_f32_32x32x16_bf16(kf[7],qr[3],C1,0,0,0),   P1[14],P1[15],0.f,0.f,       pw3[2]=PKW(P1,12),pw3[3]=PKW(P1,14), pw3); \
    l_reg+=sacc; \
    if(GK){DMA_K((t)+3,sl_cur);} if(GV){DMA_V((t)+1,sl_next);} \
    _Pragma("unroll") for(int r=0;r<16;++r){C0[r]-=mhat;C1[r]-=mhat;} \
    CMASK(C0,C1,t); \
    { float a=MX3(C0[0],C0[1],C1[0]),b=MX3(C0[2],C0[3],C1[1]); a=MX3(a,C1[2],C1[3]); \
      _Pragma("unroll") for(int r=4;r<16;r+=4){a=MX3(a,C0[r],C0[r+1]);b=MX3(b,C0[r+2],C0[r+3]);a=MX3(a,C1[r],C1[r+1]);b=MX3(b,C1[r+2],C1[r+3]);} \
      float rm=__builtin_fmaxf(a,b); { auto rr=__builtin_amdgcn_permlane32_swap(__float_as_uint(rm),__float_as_uint(rm),false,false); rm=__builtin_fmaxf(__uint_as_float(rr[0]),__uint_as_float(rr[1])); } \
      resc=false; \
      if(__builtin_expect(__any(rm>(float)THRL),0)){ const float dl=__builtin_fmaxf(rm,0.f); mhat+=dl; \
        _Pragma("unroll") for(int r=0;r<16;++r){C0[r]-=dl;C1[r]-=dl;} \
        \
        const float f=__builtin_amdgcn_exp2f(-dl); l_reg*=f; if(hi==0)wsf[r32]=f; resc=true; } } \
    SBAR(); \
    GAPB(o[0]=__builtin_amdgcn_mfma_f32_32x32x16_bf16(PAF(0),VFR(0),o[0],0,0,0), C0,0); \
    GAPB(o[1]=__builtin_amdgcn_mfma_f32_32x32x16_bf16(PAF(0),VFR(4),o[1],0,0,0), C0,4); \
    KRD(GL,0); GAPB(o[0]=__builtin_amdgcn_mfma_f32_32x32x16_bf16(PAF(1),VFR(1),o[0],0,0,0), C0,8); \
    KRD(GL,1); GAPB(o[1]=__builtin_amdgcn_mfma_f32_32x32x16_bf16(PAF(1),VFR(5),o[1],0,0,0), C0,12); \
    KRD(GL,2); GAPB(o[0]=__builtin_amdgcn_mfma_f32_32x32x16_bf16(PAF(2),VFR(2),o[0],0,0,0), C1,0); \
    KRD(GL,3); GAPB(o[1]=__builtin_amdgcn_mfma_f32_32x32x16_bf16(PAF(2),VFR(6),o[1],0,0,0), C1,4); \
    GAPB(o[0]=__builtin_amdgcn_mfma_f32_32x32x16_bf16(PAF(3),VFR(3),o[0],0,0,0), C1,8); \
    GAPB(o[1]=__builtin_amdgcn_mfma_f32_32x32x16_bf16(PAF(3),VFR(7),o[1],0,0,0), C1,12); \
    }while(0)
  int t=1;
  #undef CMASK
  #define CMASK(P0,P1,t) do{ if(!((selmask>>((t)>>2))&1u)){ _Pragma("unroll") for(int r_=0;r_<16;++r_){P0[r_]=-INFINITY;P1[r_]=-INFINITY;} } }while(0)
  for(;t+5<NT;t+=2){
    STEP(pB0,pB1,pA0,pA1,t,true,true,true);     WAIT_BAR(2); RESC(); ROT();
    STEP(pA0,pA1,pB0,pB1,t+1,true,true,true);   WAIT_BAR(2); RESC(); ROT();
  }
  #undef CMASK
  #define CMASK(P0,P1,t) do{int jb_=(t)-(NT-4); if(jb_>=0)cmask(P0,P1,jb_,qrel,hi); else if(!((selmask>>((t)>>2))&1u)){ _Pragma("unroll") for(int r_=0;r_<16;++r_){P0[r_]=-INFINITY;P1[r_]=-INFINITY;} } }while(0)
  #define ENDW(tt) do{ if((tt)+3<NT){WAIT_BAR(2);} else if((tt)+2<NT){WAIT_BAR(1);} else {WAIT_BAR(0);} }while(0)
  for(;t+1<NT;t+=2){
    STEP(pB0,pB1,pA0,pA1,t,(t+3<NT),(t+1<NT),(t+1<NT));       ENDW(t);   RESC(); ROT();
    STEP(pA0,pA1,pB0,pB1,t+1,(t+4<NT),(t+2<NT),(t+2<NT));     ENDW(t+1); RESC(); ROT();
  }
  STEP(pB0,pB1,pA0,pA1,NT-1,false,false,false); RESC();
  { float sacc=pB0[0]+pB0[1]; _Pragma("unroll") for(int r=2;r<16;++r)sacc+=pB0[r]; _Pragma("unroll") for(int r=0;r<16;++r)sacc+=pB1[r]; l_reg+=sacc;
    pw0=(u32x4){PKW(pB0,0),PKW(pB0,2),PKW(pB0,4),PKW(pB0,6)};pw1=(u32x4){PKW(pB0,8),PKW(pB0,10),PKW(pB0,12),PKW(pB0,14)};pw2=(u32x4){PKW(pB1,0),PKW(pB1,2),PKW(pB1,4),PKW(pB1,6)};pw3=(u32x4){PKW(pB1,8),PKW(pB1,10),PKW(pB1,12),PKW(pB1,14)};
    SBAR(); pv(o,vb0+sl_cur,PAF(0),PAF(1),PAF(2),PAF(3)); }
  #undef PKW
  #undef PAF
  #undef VFR
  #undef PIN
  #undef MX3
  #undef GAPA
  #undef GAPB
  #undef EX
  #undef VRD
  #undef KRD
  #undef STEP
  #undef ENDW
  {auto rr=__builtin_amdgcn_permlane32_swap(__float_as_uint(l_reg),__float_as_uint(l_reg),false,false);l_reg=__uint_as_float(rr[0])+__uint_as_float(rr[1]);}
  if(hi==0)wsf[32+r32]=l_reg;asm volatile("s_waitcnt lgkmcnt(0)":::"memory");
  float rli[16];
  #pragma unroll
  for(int r=0;r<16;++r)rli[r]=__builtin_amdgcn_rcpf(wsf[32+crow(r,hi)]);
  bf16*Ow=O+(rowbase+q0+wid*QBLK)*DM+h*D;
  { bf16*stg=(bf16*)(shm+LDS_OST)+wid*2048;
    #pragma unroll
    for(int r=0;r<16;++r){const int orow=crow(r,hi);
      #pragma unroll
      for(int d0=0;d0<2;++d0)stg[orow*64+d0*32+r32]=__float2bfloat16(o[d0][r]*rli[r]);}
    asm volatile("s_waitcnt lgkmcnt(0)":::"memory");
    #pragma unroll
    for(int i=0;i<4;++i){const int row=i*8+(lane>>3),ch=lane&7; const u32x4 v=*(const u32x4*)(stg+row*64+ch*8); ATTN_STORE16(Ow+(long)row*DM+ch*8,v);} }
  asm volatile("s_waitcnt lgkmcnt(0)\n\ts_barrier":::"memory");
  #undef DMA_K
  #undef DMA_V
  #undef CMASK
  #undef START
  #undef RESC
  #undef ROT
}
constexpr int ATTN_LDS_BYTES=LDS_BYTES;
#undef SBAR
#undef WAIT_BAR
}

DI void moba_attn_unit256(Ctx& C, int l, int b, int h, int qb) {
    const int lane = C.lane, wave = C.wave, r32 = lane & 31, hi = lane >> 5;
    unsigned selmask = 0u;
    if (qb > 0) {
        LASQ float* KML = (LASQ float*)(C.lds + 90112);
        const float* ksum = (const float*)(C.ws + MB_KSUM) + (size_t)b * 64 * 256 + h * 64;
        for (int idx = C.tid; idx < qb * 64; idx += 512) { const int n = idx >> 6, d = idx & 63; const float* kp = ksum + (size_t)(4 * n) * 256 + d;
            KML[idx] = (kp[0] + kp[256]) + (kp[512] + kp[768]); }
        const size_t rowq = (size_t)b * SEQ + qb * 256 + wave * 32 + r32;
        const float* mq = tmpbuf(C, T_MQ) + rowq * 256 + h * 64 + 32 * hi;
        f32x4 qg[8];
#pragma unroll
        for (int j = 0; j < 8; ++j) qg[j] = *(const f32x4*)(mq + 4 * j);
        __syncthreads();
        float v1 = -3.0e38f, v2 = -3.0e38f, v3 = -3.0e38f; int i1 = -1, i2 = -1, i3 = -1;
        for (int n = 0; n < qb; ++n) { float g = 0.f;
#pragma unroll
            for (int j = 0; j < 8; ++j) { const f32x4 kv = *(const LASQ f32x4*)(KML + n * 64 + 32 * hi + 4 * j); g += (qg[j].x * kv.x + qg[j].y * kv.y) + (qg[j].z * kv.z + qg[j].w * kv.w); }
            g += __shfl_xor(g, 32);
            if (g > v1) { v3 = v2; i3 = i2; v2 = v1; i2 = i1; v1 = g; i1 = n; } else if (g > v2) { v3 = v2; i3 = i2; v2 = g; i2 = n; } else if (g > v3) { v3 = g; i3 = n; } }
        if (i1 >= 0) selmask |= 1u << i1; if (i2 >= 0) selmask |= 1u << i2; if (i3 >= 0) selmask |= 1u << i3;
        __syncthreads();
    }
    attn_body::attn_unit<8>(b, h, qb, (const attn_body::bf16*)(C.ws + MB_Q), (const attn_body::bf16*)(C.ws + MB_K), (const attn_body::bf16*)(C.ws + MB_VT), (attn_body::bf16*)ybuf(C, 3), (char*)C.lds, selmask);
}

constexpr size_t WS_TOTAL = WS_END6;

constexpr int PH_PER_LAYER = 8, N_PHASES = 1 + 2 * PH_PER_LAYER;
#ifndef MK_ONE_LAUNCH
#define MK_ONE_LAUNCH 1
#endif

__global__ void __launch_bounds__(512, 2) fwd(Args a) {
    extern __shared__ __attribute__((aligned(16))) unsigned char lds_raw[];
    Ctx C;
    C.out = a.out; C.ws = a.ws; C.outb = a.out; C.wsb = a.ws; C.lds = (LASQ unsigned char*)lds_raw;
    C.tid = threadIdx.x; C.lane = C.tid & 63; C.wave = __builtin_amdgcn_readfirstlane(C.tid >> 6);
    C.G = gridDim.x; { const int bx = blockIdx.x; C.vcu = (C.G % 8 == 0) ? (bx % 8) * (C.G / 8) + bx / 8 : bx; }
    C.gw = C.wave * C.G + C.vcu; C.NGW = C.G * 8;
    volatile LASQ unsigned* MISC = (volatile LASQ unsigned*)(C.lds + MISC_OFF);
    if (C.tid < 32) MISC[C.tid] = 0u;
    if (C.tid < 40) *(LASQ unsigned long long*)(C.lds + PTAB_OFF + 8 * C.tid) = (unsigned long long)a.in[C.tid];
    __syncthreads();
    unsigned* ctl = (unsigned*)(a.ws + WS_CTL);
    XcdBarrier bar = xcd_barrier_post(ctl + CW_BAR + a.li * XCD_BAR_WORDS, (volatile LAS unsigned*)(MISC + 8));
    const int lo = a.ph_lo, hi = a.ph_hi; int ph = 0;
    LASQ unsigned char* ring = C.lds;
    const int bid = (int)blockIdx.x;
#ifndef REP_MASK
#define REP_MASK 0
#endif
#define PH_BEGIN(slot) if (ph >= lo && ph < hi) { constexpr int nrep_ = ((REP_MASK >> (slot)) & 1) ? 2 : 1; for (int rep_ = 0; rep_ < nrep_; ++rep_) { refresh(C);
#define PH_END   if (rep_ + 1 < nrep_) xcd_barrier(bar); } if (ph + 1 < hi) xcd_barrier(bar); } ++ph;

    PH_BEGIN(0)
#if !defined(SKIP_PH0)
        if (C.vcu & 1) { for (int u = C.vcu; u < 2 * SB * 32; u += C.G) kmean_unit(C, u / (SB * 32), u % (SB * 32)); }
        prologue(C);
        __syncthreads();
        if (!(C.vcu & 1)) { for (int u = C.vcu; u < 2 * SB * 32; u += C.G) kmean_unit(C, u / (SB * 32), u % (SB * 32)); }
        if (FAST_S5) { LASQ float* scr = (LASQ float*)(C.lds + C.wave * 16384);
            for (int it = C.gw; it < 32 + 64 + (SEQ / 4 + 1); it += C.NGW) { if (it < 32) s5_param_item(C, it);
                else if (it >= 96) rope_item(C, it - 96);
                else { const int r = it - 32, l2 = r >> 5; tr_item<false>(inF(C, 20) + (size_t)l2 * 256 * 256, 256, 256, 256, (bf16*)(C.ws + S5_WGT) + (size_t)l2 * 256 * 256, scr, r & 31, C.lane); } } }
    #endif
    PH_END

    for (int l = 0; l < 2; ++l) {
        PH_BEGIN(1)
#if !defined(SKIP_PH1)
            pg8::StaticOrder S1; S1.init(MP, 3072, C.G, bid); pg8::StaticOrder S2; S2.init(MP, NGATE, C.G, C.G - 1 - bid);
            const int n1 = (MP / 256 * 12 + C.G - 1) / C.G;
            fill_rs(C, S1, 0); fill_rs(C, S2, n1);
            {   LASQ float* red = (LASQ float*)C.lds; const bf16* As = Hp(C) + (size_t)MP * D; const int row = C.tid >> 4, col = C.tid & 15; const float rss = sample_rs(C);
                for (int it = C.vcu; it < NP / 16 + NGATE / 16; it += C.G) {
                    if (it < NP / 16) { const float v = skinny_core(C, As, wptr(C, l, WO_WIN), D, 16 * it, red) * rss; projp(C)[(size_t)(MP + row) * NP + 16 * it + col] = v; }
                    else { const int n0 = 16 * (it - NP / 16); const float v = skinny_core(C, As, wptr(C, l, WO_WG), D, n0, red) * rss; gatep(C)[(size_t)(MP + row) * NGATE + n0 + col] = (bf16)f2bf(sigmoid_(v)); } } }
            { __syncthreads();
              { pg8::Gemm g{Hp(C), wptr(C, l, WO_WIN), MP, 3072, D};     pg8::EpiStoreF32<NP> E{projp(C), (const LASQ float*)(C.lds + RS_OFF), 0};
                pg8::gemm_phase<pg8::EpiStoreF32<NP>, pg8::StaticOrder>(ring, g, S1, E, nullptr); }
              { pg8::Gemm g{Hp(C), wptr(C, l, WO_WG), MP, NGATE, D}; pg8::EpiActBf16<0, NGATE> E{gatep(C), (const LASQ float*)(C.lds + RS_OFF) + n1 * 256, 0};
                pg8::gemm_phase<pg8::EpiActBf16<0, NGATE>, pg8::StaticOrder>(ring, g, S2, E, nullptr); } }
        #endif
    PH_END
        PH_BEGIN(2)
#if !defined(SKIP_PH2)
            for (int m = MP + C.vcu; m < MR; m += C.G) pre_row(C, l, m, (const float*)(C.ws + ROPE_TAB), C.wave);
            __syncthreads();
#ifndef REPS
#define REPS 0
#endif
#define RPT(bit) for (int rr_ = 0; rr_ < (((REPS) >> (bit)) & 1 ? 3 : 1); ++rr_)
            refresh(C);
            for (int u = C.vcu; u < 256; u += C.G) small_proj_chunk(C, l, u >> 6, u & 63);
            refresh(C);
            RPT(1) for (int u = C.vcu; u < 256; u += C.G) moba_prep_chunk(C, l, u >> 6, u & 63, (const float*)(C.ws + ROPE_TAB));
            refresh(C);
            for (int u = C.vcu; u < 256; u += C.G) s5_pass1_chunk(C, l, u >> 6, u & 63);
            refresh(C);
            for (int u = C.vcu; u < 256; u += C.G) gla_prep_chunk(C, l, u >> 6, u & 63);
            refresh(C);
            for (int u = C.vcu; u < 256; u += C.G) gdn_prep_chunk(C, l, u >> 6, u & 63);
            refresh(C);
            refresh(C);

        #endif
    PH_END
        PH_BEGIN(3)
#if !defined(SKIP_PH4)
            {
                constexpr int nD = SB * 16, nShort = SB * 16 + SB * 32 + SB * 32;
                const bool full = (C.G == 256);
                const int qb0 = C.vcu & 15; const bool light = !full || qb0 < 12; const int lidx = full ? (C.vcu >> 4) * 12 + qb0 : C.vcu, nl = full ? 192 : C.G;
                if (light) {
                    if (full) {
                        constexpr int nGen = NB * 256 + NB * 16 + nShort, nWav = 192 * 7 + 128;
                        if (C.wave == 0 && qb0 < 4) gdn_scan_item(C, l, (C.vcu >> 4) * 4 + qb0);
                        else { const int gi = (C.wave >= 1) ? (C.wave - 1) * 192 + lidx : 192 * 7 + (C.vcu >> 4) * 8 + (qb0 - 4);
                            for (int it = gi; it < nGen; it += nWav) { int r = it;
                                if (r < NB * 256) { gla_scan_item(C, l, r); continue; } r -= NB * 256;
                                if (r < NB * 16) { s5_carry_item(C, l, r); continue; } r -= NB * 16;
                                if (r < 512) { gla_naive(C, l, NB + (r >> 5), (r >> 3) & 3, r & 7); continue; } r -= 512;
                                if (r < nD) { s5_naive(C, l, NB + (r >> 4), r & 15, (const float*)(C.ws + S5_P), (bf16*)(C.ws + S5_YSB)); continue; } r -= nD;
                                if (r < 512) { r += 512; gla_naive(C, l, NB + (r >> 5), (r >> 3) & 3, r & 7); continue; } r -= 512;
                                gdn_naive(C, l, NB + (r >> 5), (r >> 3) & 3, r & 7); } }
                    } else {
                        for (int it = C.wave * nl + lidx; it < NB * 16; it += nl * 8) gdn_scan_item(C, l, it);
                        for (int it = lidx * 8 + C.wave; it < NB * 16; it += nl * 8) s5_carry_item(C, l, it);
                        for (int it = lidx * 8 + C.wave; it < NB * 256; it += nl * 8) gla_scan_item(C, l, it);
                        for (int it = C.wave * nl + lidx; it < nShort; it += nl * 8) { int r = it;
                            if (r < 512) { gla_naive(C, l, NB + (r >> 5), (r >> 3) & 3, r & 7); continue; } r -= 512;
                            if (r < nD) { s5_naive(C, l, NB + (r >> 4), r & 15, (const float*)(C.ws + S5_P), (bf16*)(C.ws + S5_YSB)); continue; } r -= nD;
                            if (r < 512) { r += 512; gla_naive(C, l, NB + (r >> 5), (r >> 3) & 3, r & 7); continue; } r -= 512;
                            gdn_naive(C, l, NB + (r >> 5), (r >> 3) & 3, r & 7); }
                    }
                }
                __syncthreads(); refresh(C);
                for (int p = C.vcu; p < 256; p += C.G) { const int qb = p & 15;
                    const int dslot = (qb == 0) ? 0 : (qb == 1) ? 1 : (qb >= 4 && qb <= 8) ? qb - 2 : (qb == 12) ? 7 : -1;
                    if (dslot >= 0) { const int u = (p >> 4) * 8 + dslot; moba_decode_unit(C, l, u >> 2, u & 3); refresh(C); }
                    moba_attn_unit256(C, l, p >> 6, (p >> 4) & 3, qb); }
            }
#endif
    PH_END
        PH_BEGIN(4)
#if !defined(SKIP_PH5)
            for (int m = MP + C.vcu; m < MR; m += C.G) post_row(C, l, m, C.wave);
            {   LASQ float* red = (LASQ float*)C.lds; const int row = C.tid >> 4, col = C.tid & 15;
                for (int it = C.vcu; it < BW / 16; it += C.G) { const float v = skinny_core(C, (const bf16*)(C.ws + S5_YSB), (const bf16*)(C.ws + S5_WGT) + (size_t)l * 256 * 256, BW, 16 * it, red);
                    const int n = 16 * it + col; ybuf(C, 0)[(size_t)(MP + row) * 256 + n] = (bf16)f2bf(tmpbuf(C, T_YPRE)[(size_t)(MP + row) * 256 + n] * sigmoid_(v + inF(C, 21)[l * 256 + n])); } }
            refresh(C);
            if (FAST_S5) { for (int u = C.vcu; u < 256; u += C.G) s5_out_chunk(C, l, u >> 6, u & 63); }
            refresh(C);
            if (FAST_GLA) { for (int u = C.vcu; u < 256; u += C.G) gla_out_chunk(C, l, u >> 6, u & 63); }
            refresh(C);
            if (FAST_GDN) { for (int u = C.vcu; u < 256; u += C.G) gdn_out_chunk(C, l, u >> 6, u & 63); }
        #endif
    PH_END
        PH_BEGIN(5)
#if !defined(SKIP_PH6)
            {   LASQ float* red = (LASQ float*)C.lds; const int row = C.tid >> 4, col = C.tid & 15;
                for (int it = C.vcu; it < D / 16; it += C.G) skinny_merge_item(C, l, 16 * it, red); (void)row; (void)col; }
            refresh(C);
            for (int u = C.vcu; u < (MP / 256) * (D / 128); u += C.G) merge_unit(C, l, (u >> 3) * 256, (u & 7) * 128);
#endif
    PH_END
        PH_BEGIN(6)
#if !defined(SKIP_PH7)
            { const float* xin_p = (l == 0) ? inF(C, 0) : X2p(C); const float* xin_s = (l == 0) ? inF(C, 1) : X2p(C) + (size_t)MP * D;
              {   LASQ float* red = (LASQ float*)C.lds; const int row = C.tid >> 4, col = C.tid & 15;
                  for (int it = C.vcu; it < D / 16; it += C.G) { const float v = xin_s[(size_t)row * D + 16 * it + col] + skinny_core(C, mrgp(C) + (size_t)MP * D, wptr(C, l, WO_WOUT), D, 16 * it, red);
                      X1p(C)[(size_t)(MP + row) * D + 16 * it + col] = v; Hp(C)[(size_t)(MP + row) * D + 16 * it + col] = (bf16)f2bf(v);
                      float s = v * v; s += __shfl_xor(s, 1); s += __shfl_xor(s, 2); s += __shfl_xor(s, 4); s += __shfl_xor(s, 8); if (col == 0) ((float*)(C.ws + WS_SSQS))[row * 64 + it] = s; } }
              pg8::Gemm g{mrgp(C), wptr(C, l, WO_WOUT), MP, D, D}; pg8::StaticOrder S; S.init(MP, D, C.G, bid); pg8::EpiRes E{xin_p, X1p(C), (pg8::bf16_t*)Hp(C), (float*)(C.ws + WS_SSQ)};
              pg8::gemm_phase<pg8::EpiRes, pg8::StaticOrder>(ring, g, S, E, nullptr); }
        #endif
    PH_END
        PH_BEGIN(7)
#if !defined(SKIP_PH9)
            pg8::StaticOrder SH; SH.init(MP, DFF, C.G, bid); fill_rs(C, SH, 0);
            {   LASQ float* red = (LASQ float*)C.lds; const int row = C.tid >> 4, col = C.tid & 15; const float rss = sample_rs(C);
                for (int it = C.vcu; it < DFF / 16; it += C.G) { const float v = fmaxf(skinny_core(C, Hp(C) + (size_t)MP * D, wptr(C, l, WO_FF1), D, 16 * it, red) * rss, 0.f);
                    Zp(C)[(size_t)(MP + row) * DFF + 16 * it + col] = (bf16)f2bf(v * v); } }
            { pg8::Gemm g{Hp(C), wptr(C, l, WO_FF1), MP, DFF, D}; const pg8::StaticOrder& S = SH; __syncthreads();
              pg8::EpiActBf16<1, DFF> E{Zp(C), (const LASQ float*)(C.lds + RS_OFF), 0};
              pg8::gemm_phase<pg8::EpiActBf16<1, DFF>, pg8::StaticOrder>(ring, g, S, E, nullptr); }
        #endif
    PH_END
        PH_BEGIN(8)
#if !defined(SKIP_PH10)
            { float* xout_p = (l == 0) ? X2p(C) : C.out + O_YP; float* xout_s = (l == 0) ? X2p(C) + (size_t)MP * D : C.out + O_YS;
              {   LASQ float* red = (LASQ float*)C.lds; const int row = C.tid >> 4, col = C.tid & 15;
                  for (int it = C.vcu; it < D / 16; it += C.G) { const float v = X1p(C)[(size_t)(MP + row) * D + 16 * it + col] + skinny_core(C, Zp(C) + (size_t)MP * DFF, wptr(C, l, WO_FF2), DFF, 16 * it, red);
                      xout_s[(size_t)row * D + 16 * it + col] = v;
                      if (l == 0) { Hp(C)[(size_t)(MP + row) * D + 16 * it + col] = (bf16)f2bf(v);
                          float s = v * v; s += __shfl_xor(s, 1); s += __shfl_xor(s, 2); s += __shfl_xor(s, 4); s += __shfl_xor(s, 8); if (col == 0) ((float*)(C.ws + WS_SSQS))[row * 64 + it] = s; } } }
              pg8::Gemm g{Zp(C), wptr(C, l, WO_FF2), MP, D, DFF}; pg8::StaticOrder S; S.init(MP, D, C.G, bid); pg8::EpiRes E{X1p(C), xout_p, (l == 0) ? (pg8::bf16_t*)Hp(C) : (pg8::bf16_t*)nullptr, (float*)(C.ws + WS_SSQ)};
              pg8::gemm_phase<pg8::EpiRes, pg8::StaticOrder>(ring, g, S, E, nullptr); }
        #endif
    PH_END
    }
#undef PH_BEGIN
#undef PH_END
}

extern "C" void kernel_launch(void* const* d_in, const int* in_sizes, int n_in, void* d_out, int out_size, void* d_ws, size_t ws_size, hipStream_t stream) {
    static int grid = 0;
    if (grid == 0) {
        if (n_in != 40 || out_size != (int)O_END || ws_size < WS_TOTAL) { fprintf(stderr, "kernel_launch: unexpected shapes: n_in %d out %d ws %zu (need %zu)\n", n_in, out_size, ws_size, (size_t)WS_TOTAL); grid = -1; return; }
        int dev = 0, cus = 0, per_cu = 0;
        if (hipGetDevice(&dev) != hipSuccess || hipDeviceGetAttribute(&cus, hipDeviceAttributeMultiprocessorCount, dev) != hipSuccess) { grid = -1; return; }
        if (hipFuncSetAttribute((const void*)fwd, hipFuncAttributeMaxDynamicSharedMemorySize, LDS_BYTES) != hipSuccess) { fprintf(stderr, "kernel_launch: hipFuncSetAttribute failed\n"); grid = -1; return; }
        if (hipOccupancyMaxActiveBlocksPerMultiprocessor(&per_cu, (const void*)fwd, 512, LDS_BYTES) != hipSuccess || per_cu < 1) fprintf(stderr, "kernel_launch: occupancy query reports %d\n", per_cu);
        (void)hipGetLastError();
        grid = cus;
    }
    if (grid < 0) return;
    if (hipMemsetAsync((char*)d_ws + WS_CTL, 0, MK_ONE_LAUNCH ? (size_t)32768 : CTL_BYTES, stream) != hipSuccess) return;
    Args a{};
    for (int i = 0; i < 40; ++i) a.in[i] = d_in[i];
    a.out = (float*)d_out; a.ws = (unsigned char*)d_ws; a.pad = 0;
#if MK_ONE_LAUNCH
    a.ph_lo = 0; a.ph_hi = N_PHASES; a.li = 0;
    hipLaunchKernelGGL(fwd, dim3(grid), dim3(512), LDS_BYTES, stream, a);
#else
    for (int p = 0; p < N_PHASES; ++p) { a.ph_lo = p; a.ph_hi = p + 1; a.li = p; hipLaunchKernelGGL(fwd, dim3(grid), dim3(512), LDS_BYTES, stream, a); }
#endif
}
```
